# Optimizing an MI355X kernel written in HIP

```python
import jax, jax.numpy as jnp
from jax import lax
import numpy as np

D_MODEL = 2048
BATCH = 4
SEQ = 8192
DEPTH = 1
DEC_BATCH = 32
DEC_SEQ = 32
PAST_LEN = 1024

CHUNK = 64
SB_HEAD_DIM = 128
SB_HEADS = D_MODEL // (2 * SB_HEAD_DIM)
SB_BLOCK = 128
GLA_HEADS = 4
GLA_DK = D_MODEL // (2 * GLA_HEADS)
GLA_DV = D_MODEL // GLA_HEADS
GLA_LOW_RANK = 16
GLA_GATE_NORM = 16.0
MEM_TOKENS = 256
MEM_HEADS = 4
MEM_HEAD_DIM = D_MODEL // (2 * MEM_HEADS)
D_FF = ((8 * D_MODEL // 3 + 255) // 256) * 256
N_BRANCH = 3
EPS = 1e-6

SB_W = SB_HEADS * SB_HEAD_DIM
GLA_KW = GLA_HEADS * GLA_DK
GLA_VW = GLA_HEADS * GLA_DV
MEM_W = MEM_HEADS * MEM_HEAD_DIM
IN_SPLIT = (SB_W, SB_W, SB_W, GLA_KW, GLA_KW, GLA_VW, GLA_VW, GLA_LOW_RANK, MEM_W)
IN_W = SB_W * 3 + GLA_KW * 2 + GLA_VW * 2 + GLA_LOW_RANK + MEM_W

kernel_name = 'streaming_sb_gla_mem_hybrid_step'


def rms_norm(x, g):
    x32 = x.astype(jnp.float32)
    y = x32 * lax.rsqrt(jnp.mean(x32 * x32, axis=-1, keepdims=True) + EPS)
    return (y * g.astype(jnp.float32)).astype(x.dtype)


def swiglu(x, w_gu, w_d):
    g, u = jnp.split(x @ w_gu, 2, axis=-1)
    return (jax.nn.silu(g) * u) @ w_d


def sb_attend(q, k, v, q_pos, k_pos):
    z = jnp.einsum('bqhd,bkhd->bhqk', q.astype(jnp.float32), k.astype(jnp.float32)) * SB_HEAD_DIM ** -0.5
    mask = k_pos[None, :] < q_pos[:, None]
    c = jnp.where(mask, jax.nn.log_sigmoid(-z), 0.0)
    log_a = z + lax.cumsum(c, axis=3, reverse=True)
    a = jnp.exp(jnp.where(mask, log_a, -jnp.inf))
    return jnp.einsum('bhqk,bkhd->bqhd', a, v.astype(jnp.float32))


def sb_prompt(q, k, v):
    B, T = q.shape[0], q.shape[1]
    nb = T // SB_BLOCK
    qb = q.reshape(B, nb, SB_BLOCK, SB_HEADS, SB_HEAD_DIM).swapaxes(0, 1)
    starts = jnp.arange(nb, dtype=jnp.int32) * SB_BLOCK
    k_pos = jnp.arange(T, dtype=jnp.int32)

    def one_block(args):
        qi, s0 = args
        return sb_attend(qi, k, v, s0 + jnp.arange(SB_BLOCK, dtype=jnp.int32), k_pos)

    o = lax.map(one_block, (qb, starts))
    return o.swapaxes(0, 1).reshape(B, T, SB_HEADS, SB_HEAD_DIM)


def gla_chunk(s, qc, kc, vc, gc):
    L = qc.shape[1]
    b = jnp.cumsum(gc, axis=1)
    o_inter = jnp.einsum('blhd,bhde->blhe', qc * jnp.exp(b), s)
    causal = jnp.tril(jnp.ones((L, L), dtype=bool))[None, :, :, None, None]
    diff = b[:, :, None] - b[:, None, :]
    decay = jnp.where(causal, jnp.exp(jnp.where(causal, diff, 0.0)), 0.0)
    att = jnp.einsum('bthd,bshd,btshd->bhts', qc, kc, decay)
    o_intra = jnp.einsum('bhts,bshe->bthe', att, vc)
    b_last = b[:, -1]
    s_new = jnp.exp(b_last)[..., None] * s + jnp.einsum('bshd,bshe->bhde', kc * jnp.exp(b_last[:, None] - b), vc)
    return s_new, o_inter + o_intra


def gla_prompt(q, k, v, g):
    B, T = q.shape[0], q.shape[1]
    n = T // CHUNK

    def to_chunks(a):
        return a.reshape(B, n, CHUNK, a.shape[2], a.shape[3]).swapaxes(0, 1)

    s0 = jnp.zeros((B, GLA_HEADS, GLA_DK, GLA_DV), jnp.float32)
    s_fin, o = lax.scan(lambda s, xs: gla_chunk(s, xs[0], xs[1], xs[2], xs[3]), s0,
                        (to_chunks(q), to_chunks(k), to_chunks(v), to_chunks(g)))
    return s_fin, o.swapaxes(0, 1).reshape(B, T, GLA_HEADS, GLA_DV)


def mem_attend(q, mk, mv):
    s = jnp.einsum('bthd,bmhd->bhtm', q.astype(jnp.float32), mk.astype(jnp.float32)) * MEM_HEAD_DIM ** -0.5
    p = jax.nn.softmax(s, axis=-1)
    return jnp.einsum('bhtm,bmhd->bthd', p, mv.astype(jnp.float32))


def mixer(u, p, mem_k, mem_v, sb_past_k, sb_past_v, gla_s0):
    B, T = u.shape[0], u.shape[1]
    dt = u.dtype
    cuts = [int(c) for c in np.cumsum(IN_SPLIT)[:-1]]
    sq, sk, sv, gq, gk, gv, gr, ga, mq = jnp.split(u @ p['w_in'], cuts, axis=-1)

    def heads(a, h):
        return a.reshape(B, T, h, a.shape[-1] // h)

    sq, sk, sv = heads(sq, SB_HEADS), heads(sk, SB_HEADS), heads(sv, SB_HEADS)
    if sb_past_k is None:
        o_sb = sb_prompt(sq, sk, sv)
    else:
        P = sb_past_k.shape[1]
        keys = jnp.concatenate([sb_past_k.astype(dt), sk], axis=1)
        vals = jnp.concatenate([sb_past_v.astype(dt), sv], axis=1)
        o_sb = sb_attend(sq, keys, vals, P + jnp.arange(T, dtype=jnp.int32), jnp.arange(P + T, dtype=jnp.int32))
    g_log = jax.nn.log_sigmoid((ga @ p['gla_w_a2'] + p['gla_b_a2']).astype(jnp.float32)) / GLA_GATE_NORM
    g_log = heads(g_log, GLA_HEADS)
    qg = heads(gq, GLA_HEADS).astype(jnp.float32) * GLA_DK ** -0.5
    kg = heads(gk, GLA_HEADS).astype(jnp.float32)
    vg = heads(gv, GLA_HEADS).astype(jnp.float32)
    if gla_s0 is None:
        s_new, o_gla = gla_prompt(qg, kg, vg, g_log)
    else:
        s_new, o_gla = gla_chunk(gla_s0.astype(jnp.float32), qg, kg, vg, g_log)
    o_gla = rms_norm(o_gla, p['gla_norm_g']) * jax.nn.silu(heads(gr, GLA_HEADS).astype(jnp.float32))
    o_mem = mem_attend(heads(mq, MEM_HEADS), mem_k, mem_v)
    br_sb = o_sb.reshape(B, T, SB_W).astype(dt) @ p['w_sb_br']
    br_gla = o_gla.reshape(B, T, GLA_VW).astype(dt) @ p['w_gla_br']
    br_mem = o_mem.reshape(B, T, MEM_W).astype(dt) @ p['w_mem_br']
    gates = jax.nn.sigmoid(u @ p['w_gate'] + p['b_gate']).reshape(B, T, N_BRANCH, D_MODEL)
    merged = gates[:, :, 0] * br_sb + gates[:, :, 1] * br_gla + gates[:, :, 2] * br_mem
    return merged @ p['w_out'], sk, sv, s_new.astype(dt)


def layer(x, p, mem_k, mem_v, sb_past_k, sb_past_v, gla_s0):
    h = x + 0.5 * rms_norm(swiglu(rms_norm(x, p['ffn1_pre_g']), p['ffn1_w_gu'], p['ffn1_w_d']), p['ffn1_post_g'])
    m, sk, sv, s_new = mixer(rms_norm(h, p['mix_pre_g']), p, mem_k, mem_v, sb_past_k, sb_past_v, gla_s0)
    h = h + rms_norm(m, p['mix_post_g'])
    h = h + 0.5 * rms_norm(swiglu(rms_norm(h, p['ffn2_pre_g']), p['ffn2_w_gu'], p['ffn2_w_d']), p['ffn2_post_g'])
    return h, sk, sv, s_new


def setup_inputs(seed: int = 0) -> dict:
    key = jax.random.key(seed)
    ks = jax.random.split(key, 32)
    f32 = jnp.float32

    def nrm(k, shape, scale):
        return jax.random.normal(k, shape, f32) * scale

    def gain(k, n):
        return 1.0 + 0.02 * jax.random.normal(k, (DEPTH, n), f32)

    return {
        'x_prompt': nrm(ks[0], (BATCH, SEQ, D_MODEL), 1.0),
        'x_sample': nrm(ks[1], (DEC_BATCH, DEC_SEQ, D_MODEL), 1.0),
        'mem_prompt': nrm(ks[2], (BATCH, MEM_TOKENS, D_MODEL), 1.0),
        'cache_sb_k': nrm(ks[3], (DEPTH, DEC_BATCH, PAST_LEN, SB_HEADS, SB_HEAD_DIM), 1.0),
        'cache_sb_v': nrm(ks[4], (DEPTH, DEC_BATCH, PAST_LEN, SB_HEADS, SB_HEAD_DIM), 1.0),
        'state_gla': nrm(ks[5], (DEPTH, DEC_BATCH, GLA_HEADS, GLA_DK, GLA_DV), 1.0),
        'cache_mem_k': nrm(ks[6], (DEPTH, DEC_BATCH, MEM_TOKENS, MEM_HEADS, MEM_HEAD_DIM), 1.0),
        'cache_mem_v': nrm(ks[7], (DEPTH, DEC_BATCH, MEM_TOKENS, MEM_HEADS, MEM_HEAD_DIM), 1.0),
        'ffn1_pre_g': gain(ks[8], D_MODEL),
        'ffn1_w_gu': nrm(ks[9], (DEPTH, D_MODEL, 2 * D_FF), D_MODEL ** -0.5),
        'ffn1_w_d': nrm(ks[10], (DEPTH, D_FF, D_MODEL), D_FF ** -0.5),
        'ffn1_post_g': gain(ks[11], D_MODEL),
        'mix_pre_g': gain(ks[12], D_MODEL),
        'w_in': nrm(ks[13], (DEPTH, D_MODEL, IN_W), D_MODEL ** -0.5),
        'gla_w_a2': nrm(ks[14], (DEPTH, GLA_LOW_RANK, GLA_KW), GLA_LOW_RANK ** -0.5),
        'gla_b_a2': nrm(ks[15], (DEPTH, GLA_KW), 0.1),
        'gla_norm_g': gain(ks[16], GLA_DV),
        'mem_norm_g': gain(ks[17], D_MODEL),
        'w_mem_kv': nrm(ks[18], (DEPTH, D_MODEL, 2 * MEM_W), D_MODEL ** -0.5),
        'w_sb_br': nrm(ks[19], (DEPTH, SB_W, D_MODEL), SB_W ** -0.5),
        'w_gla_br': nrm(ks[20], (DEPTH, GLA_VW, D_MODEL), GLA_VW ** -0.5),
        'w_mem_br': nrm(ks[21], (DEPTH, MEM_W, D_MODEL), MEM_W ** -0.5),
        'w_gate': nrm(ks[22], (DEPTH, D_MODEL, N_BRANCH * D_MODEL), D_MODEL ** -0.5),
        'b_gate': nrm(ks[23], (DEPTH, N_BRANCH * D_MODEL), 0.02),
        'w_out': nrm(ks[24], (DEPTH, D_MODEL, D_MODEL), D_MODEL ** -0.5),
        'mix_post_g': gain(ks[25], D_MODEL),
        'ffn2_pre_g': gain(ks[26], D_MODEL),
        'ffn2_w_gu': nrm(ks[27], (DEPTH, D_MODEL, 2 * D_FF), D_MODEL ** -0.5),
        'ffn2_w_d': nrm(ks[28], (DEPTH, D_FF, D_MODEL), D_FF ** -0.5),
        'ffn2_post_g': gain(ks[29], D_MODEL),
    }


def reference(x_prompt, x_sample, mem_prompt, cache_sb_k, cache_sb_v, state_gla, cache_mem_k, cache_mem_v,
              ffn1_pre_g, ffn1_w_gu, ffn1_w_d, ffn1_post_g, mix_pre_g, w_in, gla_w_a2, gla_b_a2, gla_norm_g,
              mem_norm_g, w_mem_kv, w_sb_br, w_gla_br, w_mem_br, w_gate, b_gate, w_out, mix_post_g,
              ffn2_pre_g, ffn2_w_gu, ffn2_w_d, ffn2_post_g):
    h_p, h_s = x_prompt, x_sample
    Bp = x_prompt.shape[0]
    sbk_p, sbv_p, gla_p, memk_p, memv_p = [], [], [], [], []
    sbk_s, sbv_s, gla_s = [], [], []
    for l in range(DEPTH):
        p = dict(ffn1_pre_g=ffn1_pre_g[l], ffn1_w_gu=ffn1_w_gu[l], ffn1_w_d=ffn1_w_d[l], ffn1_post_g=ffn1_post_g[l],
                 mix_pre_g=mix_pre_g[l], w_in=w_in[l], gla_w_a2=gla_w_a2[l], gla_b_a2=gla_b_a2[l],
                 gla_norm_g=gla_norm_g[l], w_sb_br=w_sb_br[l], w_gla_br=w_gla_br[l], w_mem_br=w_mem_br[l],
                 w_gate=w_gate[l], b_gate=b_gate[l], w_out=w_out[l], mix_post_g=mix_post_g[l],
                 ffn2_pre_g=ffn2_pre_g[l], ffn2_w_gu=ffn2_w_gu[l], ffn2_w_d=ffn2_w_d[l], ffn2_post_g=ffn2_post_g[l])
        mk, mv = jnp.split(rms_norm(mem_prompt, mem_norm_g[l]) @ w_mem_kv[l], 2, axis=-1)
        mk = mk.reshape(Bp, MEM_TOKENS, MEM_HEADS, MEM_HEAD_DIM)
        mv = mv.reshape(Bp, MEM_TOKENS, MEM_HEADS, MEM_HEAD_DIM)
        h_p, k_p, v_p, s_p = layer(h_p, p, mk, mv, None, None, None)
        h_s, k_s, v_s, s_s = layer(h_s, p, cache_mem_k[l], cache_mem_v[l], cache_sb_k[l], cache_sb_v[l], state_gla[l])
        sbk_p.append(k_p); sbv_p.append(v_p); gla_p.append(s_p); memk_p.append(mk); memv_p.append(mv)
        sbk_s.append(k_s); sbv_s.append(v_s); gla_s.append(s_s)
    return (h_p, h_s, jnp.stack(sbk_p), jnp.stack(sbv_p), jnp.stack(gla_p), jnp.stack(memk_p), jnp.stack(memv_p),
            jnp.stack(sbk_s), jnp.stack(sbv_s), jnp.stack(gla_s))
```

```cpp
#include <hip/hip_runtime.h>
#include <cstdio>
#include <cstdint>
namespace pg8 {
#define PG8_LAS __attribute__((address_space(3)))
typedef unsigned short bf16_t;
typedef short bf16x8 __attribute__((ext_vector_type(8)));
typedef float f32x4 __attribute__((ext_vector_type(4)));
typedef unsigned u32x4 __attribute__((ext_vector_type(4)));
constexpr int BM = 256, BK = 64, HALF = 128, HTB = HALF * BK * 2  , STAGE_BYTES = 8 * HTB, NXCD = 8, WGM = 8;

__host__ __device__ __forceinline__ int lds_byte(int r, int c) { const int st = (r >> 4) * 2 + (c >> 5), rr = r & 15, cc = c & 31, ob = rr * 64 + cc * 2; return st * 1024 + (ob ^ (((ob >> 9) & 1) << 5)); }
__host__ __device__ __forceinline__ void stage_rc(int b, int& R, int& C) { const int st = b / 1024, sb = b % 1024, swz = sb ^ (((sb >> 9) & 1) << 5); R = (st >> 1) * 16 + swz / 64; C = (st & 1) * 32 + (swz % 64) / 2; }
__host__ __device__ __forceinline__ int perm32(int rho) { const int n = rho >> 4, i = rho & 15; return 8 * (i >> 2) + 4 * n + (i & 3); }

struct Unit { int pm, pn; };
struct Gemm { const bf16_t* A; const bf16_t* Bt; int M, N, K; };

struct StaticOrder {
    int nM, nN, nwg, G, c;
    __host__ __device__ void init(int M, int N, int G_, int c_) { nM = M / BM; nN = N / BM; nwg = nM * nN; G = G_; c = c_; }
    __host__ __device__ bool next(int i, Unit& u) const {
        const long L = (long)i * G + c; if (L >= nwg) return false;
        int wgid = (int)L; { const int q = nwg / NXCD, r = nwg % NXCD, xcd = wgid % NXCD, off = wgid / NXCD; wgid = (xcd < r ? xcd * (q + 1) : r * (q + 1) + (xcd - r) * q) + off; }
        const int nig = WGM * nN, gid = wgid / nig, fm = gid * WGM, gsz = (nM - fm) < WGM ? (nM - fm) : WGM;
        u.pm = fm + ((wgid % nig) % gsz); u.pn = (wgid % nig) / gsz; return true;
    }
    __device__ __forceinline__ void a_ready(const Unit&) const {}
    __device__ __forceinline__ void done(const Unit&) const {}
};
__device__ __forceinline__ unsigned cvt_pk_bf16(float lo, float hi) { unsigned r; asm volatile("v_cvt_pk_bf16_f32 %0, %1, %2" : "=v"(r) : "v"(lo), "v"(hi)); return r; }
typedef float f32x2 __attribute__((ext_vector_type(2)));
template <class Epi, class Sched, bool ALIGN_EPI = false, bool SP2 = false>
__device__ __forceinline__ void gemm_phase(PG8_LAS unsigned char* lds, const Gemm g, const Sched& S, const Epi& E) {
    const int tid = threadIdx.x, wid = __builtin_amdgcn_readfirstlane(tid >> 6), lane = tid & 63, wr = wid >> 2, wc = wid & 3, fr = lane & 15, fq = lane >> 4;
    const int K = g.K, nt = K / BK;
    unsigned voffA[2], voffB[2];
#pragma unroll
    for (int i = 0; i < 2; ++i) { int R, C; stage_rc(tid * 16 + i * 8192, R, C); const int Rb = Epi::PERM ? ((R & ~31) + perm32(R & 31)) : R;
        voffA[i] = (unsigned)(R * K + C) * 2u; voffB[i] = (unsigned)(Rb * K + C) * 2u; }
    const size_t kstep = (size_t)(BK * 2);
    const size_t hstep = (size_t)HALF * K * 2;
    const size_t tstep = 2 * hstep;
    const unsigned ldsw = (unsigned)wid * 1024u;
    const int aoff = lds_byte(wr * 64 + fr, fq * 8), boff = lds_byte(wc * 32 + fr, fq * 8);
#define PG8_SA(b, h) (((b) * 2 + (h)) * HTB)
#define PG8_SB(b, h) ((4 + (b) * 2 + (h)) * HTB)
#define PG8_STAGE(bufoff, gbase, voff) do { _Pragma("unroll") for (int _i = 0; _i < 2; ++_i) \
        __builtin_amdgcn_global_load_lds((const unsigned*)((const char*)(gbase) + (voff)[_i]), (PG8_LAS unsigned*)(lds + (bufoff) + ldsw + _i * 8192), 16, 0, 0); } while (0)
#define PG8_LDA(dst, b, h) do { _Pragma("unroll") for (int m = 0; m < 4; ++m) _Pragma("unroll") for (int k = 0; k < 2; ++k) dst[m][k] = *(const PG8_LAS bf16x8*)(lds + PG8_SA(b, h) + aoff + m * 2048 + k * 1024); } while (0)
#define PG8_LDB(dst, b, h) do { _Pragma("unroll") for (int n = 0; n < 2; ++n) _Pragma("unroll") for (int k = 0; k < 2; ++k) dst[n][k] = *(const PG8_LAS bf16x8*)(lds + PG8_SB(b, h) + boff + n * 2048 + k * 1024); } while (0)
#define PG8_MMA(ai, bj, At, Bt) do { __builtin_amdgcn_s_setprio(1); _Pragma("unroll") for (int m = 0; m < 4; ++m) _Pragma("unroll") for (int n = 0; n < 2; ++n) _Pragma("unroll") for (int k = 0; k < 2; ++k) \
        acc[ai][bj][m][n] = __builtin_amdgcn_mfma_f32_16x16x32_bf16(Bt[n][k], At[m][k], acc[ai][bj][m][n], 0, 0, 0); __builtin_amdgcn_s_setprio(0); } while (0)
#define PG8_WAIT_V(n) asm volatile("s_waitcnt vmcnt(" #n ")" ::: "memory")
#define PG8_WAIT_L(n) asm volatile("s_waitcnt lgkmcnt(" #n ")" ::: "memory")
#define PG8_BAR __builtin_amdgcn_s_barrier()
#define PG8_SCHED __builtin_amdgcn_sched_barrier(0)
    Unit cur, nxt; int ui = 0;
    if (!S.next(0, cur)) return;
    f32x4 acc[2][2][4][2];
#pragma unroll
    for (int a = 0; a < 2; ++a)
#pragma unroll
        for (int b = 0; b < 2; ++b)
#pragma unroll
            for (int m = 0; m < 4; ++m)
#pragma unroll
                for (int n = 0; n < 2; ++n) acc[a][b][m][n] = (f32x4){0.f, 0.f, 0.f, 0.f};
    bf16x8 At[4][2], B0[2][2], B1[2][2];
    const char* cA = (const char*)g.A + (size_t)cur.pm * tstep; const char* cB = (const char*)g.Bt + (size_t)cur.pn * tstep;
    S.a_ready(cur);
    if constexpr (SP2) {
        PG8_STAGE(PG8_SB(0, 0), cB, voffB); PG8_STAGE(PG8_SB(0, 1), cB + hstep, voffB); PG8_STAGE(PG8_SA(0, 0), cA, voffA); PG8_STAGE(PG8_SA(0, 1), cA + hstep, voffA);
        if (wr == 1) PG8_BAR;
        PG8_WAIT_V(2); PG8_BAR;
        PG8_STAGE(PG8_SB(1, 0), cB + kstep, voffB); PG8_STAGE(PG8_SA(1, 0), cA + kstep, voffA); PG8_STAGE(PG8_SB(1, 1), cB + hstep + kstep, voffB);
        PG8_WAIT_V(6); PG8_BAR;
    } else {
        PG8_STAGE(PG8_SB(0, 0), cB, voffB); PG8_STAGE(PG8_SA(0, 0), cA, voffA); PG8_STAGE(PG8_SB(0, 1), cB + hstep, voffB); PG8_STAGE(PG8_SA(0, 1), cA + hstep, voffA);
        if (wr == 1) PG8_BAR;
        PG8_WAIT_V(4); PG8_BAR;
        PG8_STAGE(PG8_SB(1, 0), cB + kstep, voffB); PG8_STAGE(PG8_SA(1, 0), cA + kstep, voffA); PG8_STAGE(PG8_SB(1, 1), cB + hstep + kstep, voffB);
        PG8_WAIT_V(6); PG8_BAR;
    }
    for (;;) {
        const bool has_next = S.next(ui + 1, nxt);
        const char* nA = has_next ? (const char*)g.A + (size_t)nxt.pm * tstep : cA; const char* nB = has_next ? (const char*)g.Bt + (size_t)nxt.pn * tstep : cB;
        for (int t = 0; t < nt; t += 2) {
            const bool last = (t == nt - 2);
            const char* a1 = cA + (size_t)(t + 1) * kstep;
            const char* a2 = last ? nA : cA + (size_t)(t + 2) * kstep; const char* b2 = last ? nB : cB + (size_t)(t + 2) * kstep;
            const char* a3 = a2 + kstep; const char* b3 = b2 + kstep;
            if (last && has_next) S.a_ready(nxt);
            if constexpr (SP2) {
            PG8_LDB(B0, 0, 0); PG8_LDB(B1, 0, 1); PG8_SCHED; PG8_LDA(At, 0, 0); PG8_STAGE(PG8_SA(1, 1), a1 + hstep, voffA);
            PG8_WAIT_V(8); PG8_WAIT_L(0); PG8_BAR; PG8_MMA(0, 0, At, B0); PG8_MMA(0, 1, At, B1); PG8_BAR; PG8_SCHED;
            PG8_LDA(At, 0, 1); PG8_STAGE(PG8_SB(0, 0), b2, voffB); PG8_STAGE(PG8_SB(0, 1), b2 + hstep, voffB); PG8_STAGE(PG8_SA(0, 0), a2, voffA);
            PG8_WAIT_V(8); PG8_WAIT_L(0); PG8_BAR; PG8_MMA(1, 0, At, B0); PG8_MMA(1, 1, At, B1); PG8_BAR; PG8_SCHED;
            PG8_LDB(B0, 1, 0); PG8_LDB(B1, 1, 1); PG8_SCHED; PG8_LDA(At, 1, 0); PG8_STAGE(PG8_SA(0, 1), a2 + hstep, voffA);
            PG8_WAIT_V(8); PG8_WAIT_L(0); PG8_BAR; PG8_MMA(0, 0, At, B0); PG8_MMA(0, 1, At, B1); PG8_BAR; PG8_SCHED;
            PG8_LDA(At, 1, 1); PG8_STAGE(PG8_SB(1, 0), b3, voffB); PG8_STAGE(PG8_SB(1, 1), b3 + hstep, voffB); PG8_STAGE(PG8_SA(1, 0), a3, voffA);
            PG8_WAIT_V(8); PG8_WAIT_L(0); PG8_BAR; PG8_MMA(1, 0, At, B0); PG8_MMA(1, 1, At, B1); PG8_BAR; PG8_SCHED;
            } else {
            PG8_LDB(B0, 0, 0); PG8_SCHED; PG8_LDA(At, 0, 0); PG8_STAGE(PG8_SA(1, 1), a1 + hstep, voffA);
            PG8_WAIT_L(8); PG8_BAR; PG8_WAIT_L(0); PG8_MMA(0, 0, At, B0); PG8_BAR; PG8_SCHED;
            PG8_LDB(B1, 0, 1); PG8_STAGE(PG8_SB(0, 0), b2, voffB);
            PG8_BAR; PG8_WAIT_L(0); PG8_MMA(0, 1, At, B1); PG8_BAR;
            PG8_LDA(At, 0, 1); PG8_STAGE(PG8_SA(0, 0), a2, voffA);
            PG8_BAR; PG8_WAIT_L(0); PG8_MMA(1, 0, At, B0); PG8_BAR; PG8_SCHED;
            PG8_STAGE(PG8_SB(0, 1), b2 + hstep, voffB);
            PG8_WAIT_V(6); PG8_BAR; PG8_MMA(1, 1, At, B1); PG8_BAR;
            PG8_LDB(B0, 1, 0); PG8_SCHED; PG8_LDA(At, 1, 0); PG8_STAGE(PG8_SA(0, 1), a2 + hstep, voffA);
            PG8_WAIT_L(8); PG8_BAR; PG8_WAIT_L(0); PG8_MMA(0, 0, At, B0); PG8_BAR; PG8_SCHED;
            PG8_LDB(B1, 1, 1); PG8_STAGE(PG8_SB(1, 0), b3, voffB);
            PG8_BAR; PG8_WAIT_L(0); PG8_MMA(0, 1, At, B1); PG8_BAR;
            PG8_LDA(At, 1, 1); PG8_STAGE(PG8_SA(1, 0), a3, voffA);
            PG8_BAR; PG8_WAIT_L(0); PG8_MMA(1, 0, At, B0); PG8_BAR; PG8_SCHED;
            PG8_STAGE(PG8_SB(1, 1), b3 + hstep, voffB);
            PG8_WAIT_V(6); PG8_BAR; PG8_MMA(1, 1, At, B1); PG8_BAR;
            }
        }
        if constexpr (ALIGN_EPI) { if (wr == 0) PG8_BAR; }
        if constexpr (!Epi::AFTER_DRAIN) { E(acc, cur, wr, wc, fr, fq); S.done(cur); }
        if (!has_next) break;
#pragma unroll
        for (int a = 0; a < 2; ++a)
#pragma unroll
            for (int b = 0; b < 2; ++b)
#pragma unroll
                for (int m = 0; m < 4; ++m)
#pragma unroll
                    for (int n = 0; n < 2; ++n) acc[a][b][m][n] = (f32x4){0.f, 0.f, 0.f, 0.f};
        cur = nxt; cA = nA; cB = nB; ++ui;
        if constexpr (ALIGN_EPI) { if (wr == 1) PG8_BAR; }
    }
    PG8_WAIT_V(0);
    if constexpr (!ALIGN_EPI) { if (wr == 0) PG8_BAR; }
    PG8_BAR;
    if constexpr (Epi::AFTER_DRAIN) { E.fused(acc, cur, wr, wc, fr, fq, lds, wid, lane); S.done(cur); }
#undef PG8_SA
#undef PG8_SB
#undef PG8_STAGE
#undef PG8_LDA
#undef PG8_LDB
#undef PG8_MMA
#undef PG8_WAIT_V
#undef PG8_WAIT_L
#undef PG8_BAR
#undef PG8_SCHED
}
}
#define GAS __attribute__((address_space(1)))
#define LAS __attribute__((address_space(3)))
typedef unsigned short bf16;
typedef unsigned v4u __attribute__((ext_vector_type(4)));
typedef float f32x4 __attribute__((ext_vector_type(4)));
typedef short bf16x8 __attribute__((ext_vector_type(8)));
typedef GAS unsigned gu32;
typedef GAS unsigned long long gu64;
#define RLX_AGENT __ATOMIC_RELAXED, __HIP_MEMORY_SCOPE_AGENT
#define LDS_WAIT() asm volatile("s_waitcnt lgkmcnt(0)" ::: "memory")
#define VM_WAIT() asm volatile("s_waitcnt vmcnt(0)" ::: "memory")
__device__ __forceinline__ unsigned long long rt() { return __builtin_amdgcn_s_memrealtime(); }
__device__ __forceinline__ unsigned f2bf(float f) { unsigned u = __builtin_bit_cast(unsigned, f); return (u + 0x7fffu + ((u >> 16) & 1u)) >> 16; }
__device__ __forceinline__ unsigned pk2(float lo, float hi) { return f2bf(lo) | (f2bf(hi) << 16); }

#define XB_TMO      128
#define XB_XCNT(j)  (256  + 64 * (j))
#define XB_XSUB(j)  (1280 + 64 * (j))
#define XB_XGEN(j)  (2304 + 64 * (j))
#define XB_TOP      3328
#define XB_TOPGEN   3392
#define XCD_BAR_WORDS 3456
#define XB_SPIN_CAP (1u << 18)

__device__ __forceinline__ unsigned xb_ld(unsigned* p)              { return __hip_atomic_load(p, __ATOMIC_RELAXED, __HIP_MEMORY_SCOPE_AGENT); }
__device__ __forceinline__ unsigned xb_add(unsigned* p, unsigned v) { return __hip_atomic_fetch_add(p, v, __ATOMIC_RELAXED, __HIP_MEMORY_SCOPE_AGENT); }
__device__ __forceinline__ unsigned xb_xcc_id() { return (unsigned)__builtin_amdgcn_s_getreg((3 << 11) | 20) & 0xFu; }
#define XB_SPIN(cond, bar) do { unsigned _sp = 0; while (cond) { __builtin_amdgcn_s_sleep(1); \
    if ((++_sp & 255u) == 0u) { if (xb_ld(&(bar)[XB_TMO])) break; if (_sp > XB_SPIN_CAP) { atomicAdd(&(bar)[XB_TMO], 1u); break; } } } } while (0)

struct XcdBarrier {
    unsigned* bar; unsigned x;
    volatile LAS unsigned* st;
};

__device__ __forceinline__ XcdBarrier xcd_barrier_post(unsigned* bar, volatile LAS unsigned* st) {
    XcdBarrier b; b.bar = bar; b.x = xb_xcc_id(); b.st = st;
    if (threadIdx.x == 0) (void)xb_add(&bar[XB_XCNT(b.x)], 1u);
    return b;
}
__device__ __forceinline__ void xcd_barrier_complete(unsigned* bar, unsigned x, unsigned& nloc, unsigned& nx) {
    const unsigned G = gridDim.x * gridDim.y * gridDim.z;
    unsigned sum, cnt, mine, sp = 0u;
    for (;;) {
        sum = 0u; cnt = 0u; mine = 0u;
#pragma unroll
        for (unsigned j = 0; j < 16; ++j) { const unsigned c = xb_ld(&bar[XB_XCNT(j)]); sum += c; cnt += (c > 0u) ? 1u : 0u; mine = (j == x) ? c : mine; }
        if (sum == G) break;
        __builtin_amdgcn_s_sleep(1);
        if ((++sp & 255u) == 0u) { if (xb_ld(&bar[XB_TMO])) break; if (sp > XB_SPIN_CAP) { atomicAdd(&bar[XB_TMO], 1u); break; } }
    }
    nloc = mine > 0u ? mine : 1u; nx = cnt > 0u ? cnt : 1u;
}

__device__ __forceinline__ void xcd_barrier(const XcdBarrier& b) {
    asm volatile("s_waitcnt vmcnt(0)" ::: "memory");
    __syncthreads();
    if (threadIdx.x == 0) {
        unsigned* bar = b.bar;
        __builtin_amdgcn_s_waitcnt(0);
        unsigned nloc = b.st[0], nx = b.st[1];
        if (nloc == 0u) { xcd_barrier_complete(bar, b.x, nloc, nx); b.st[0] = nloc; b.st[1] = nx; }
        const unsigned old = xb_add(&bar[XB_XSUB(b.x)], 1u);
        const unsigned gen = old / nloc;
        if (old + 1u == (gen + 1u) * nloc) {
            __builtin_amdgcn_fence(__ATOMIC_RELEASE, "agent");
            asm volatile("s_waitcnt vmcnt(0)" ::: "memory");
            const unsigned og = xb_add(&bar[XB_TOP], 1u);
            const unsigned tg = og / nx;
            if (og + 1u == (tg + 1u) * nx) xb_add(&bar[XB_TOPGEN], 1u);
            else XB_SPIN(xb_ld(&bar[XB_TOPGEN]) == tg, bar);
            __builtin_amdgcn_fence(__ATOMIC_ACQUIRE, "agent");
            xb_add(&bar[XB_XGEN(b.x)], 1u);
            asm volatile("s_waitcnt vmcnt(0)" ::: "memory");
        } else {
            XB_SPIN(xb_ld(&bar[XB_XGEN(b.x)]) == gen, bar);
            __builtin_amdgcn_fence(__ATOMIC_ACQUIRE, "agent");
            asm volatile("s_waitcnt vmcnt(0)" ::: "memory");
        }
    }
    __syncthreads();
}

typedef float f32x16 __attribute__((ext_vector_type(16)));
typedef float f32x2v __attribute__((ext_vector_type(2)));
typedef short s16x4 __attribute__((ext_vector_type(4)));
typedef short v4i16_t __attribute__((ext_vector_type(4)));
typedef unsigned u32x2 __attribute__((ext_vector_type(2)));
typedef LAS unsigned char* ldsp;
typedef const LAS unsigned char* ldscp;

constexpr int NWAVES = 8, NTHR = 512;
#ifndef MK_ONE_LAUNCH
#define MK_ONE_LAUNCH 1
#endif

constexpr int DM = 2048, DFF = 5632, SEQ = 8192, NBP = 4, NPT = NBP * SEQ, NBS = 32, DSEQ = 32, NST = NBS * DSEQ, PAST = 1024;
constexpr int MT = NPT + NST;
constexpr int MEMR = 1024, MA = MT + MEMR;
constexpr int INW = 10256;
constexpr int NCHUNK = NPT / 64 + NBS;
constexpr float EPS = 1e-6f, LOG2E = 1.4426950408889634f, LN2 = 0.6931471805599453f;
constexpr float C_SB = 0.08838834764831845f * LOG2E;
constexpr float C_MEM = 0.0625f * LOG2E;
constexpr float C_GQ = 0.0625f;
constexpr float SB_THR = 8.470329472543003e-22f;

enum { I_XP = 0, I_XS, I_MEMP, I_CSBK, I_CSBV, I_SGLA, I_CMK, I_CMV, I_F1PRE, I_F1GU, I_F1D, I_F1POST, I_MIXPRE, I_WIN, I_WA2, I_BA2, I_GLANG, I_MEMNG,
       I_WMEMKV, I_WSB, I_WGLA, I_WMEM, I_WGATE, I_BGATE, I_WOUT, I_MIXPOST, I_F2PRE, I_F2GU, I_F2D, I_F2POST, N_IN };
constexpr size_t O_Y = 0, O_SBK_P = (size_t)MT * DM, O_SBV_P = O_SBK_P + (size_t)NPT * 1024, O_GLA_P = O_SBV_P + (size_t)NPT * 1024,
                 O_MEMK_P = O_GLA_P + (size_t)NBP * 4 * 256 * 512, O_MEMV_P = O_MEMK_P + (size_t)MEMR * 1024, O_SBK_S = O_MEMV_P + (size_t)MEMR * 1024,
                 O_SBV_S = O_SBK_S + (size_t)NST * 1024, O_GLA_S = O_SBV_S + (size_t)NST * 1024, O_END = O_GLA_S + (size_t)NBS * 4 * 256 * 512;
static_assert(O_END == 159383552ull, "d_out size");

constexpr size_t MiB = 1ull << 20;
constexpr size_t WS_CTL = 0, CTL_ZERO_BYTES = 1 * MiB;
constexpr size_t WS_WGU = 1 * MiB;
constexpr size_t WS_WD = 45 * MiB;
constexpr size_t WS_WIN = 67 * MiB;
constexpr size_t WS_WGATE = 116 * MiB;
constexpr size_t WS_WSB = 140 * MiB, WS_WGLA = 144 * MiB, WS_WMEM = 152 * MiB, WS_WOUT = 156 * MiB;
constexpr size_t WS_A = 164 * MiB;
constexpr size_t WS_HID = 300 * MiB;
constexpr size_t WS_F = 663 * MiB;
constexpr size_t WS_OINTRA = 300 * MiB;
constexpr size_t WS_SBQ = 432 * MiB, WS_SBK = 498 * MiB, WS_SBV = 564 * MiB, WS_GQ = 630 * MiB, WS_GK = 696 * MiB, WS_GV = 762 * MiB, WS_GR = 894 * MiB, WS_MQ = 1026 * MiB;
constexpr size_t WS_GA = 1092 * MiB;
constexpr size_t WS_EB = 1095 * MiB;
constexpr size_t WS_MKB = 1098 * MiB, WS_MVB = 1100 * MiB, WS_END = 1102 * MiB;
constexpr size_t WS_MRG = 164 * MiB;
constexpr size_t WS_G0 = WS_SBK, WS_G1 = WS_GQ, WS_G2 = WS_GV;
constexpr size_t WS_MERGED = WS_GQ;
constexpr size_t WS_FO = 762 * MiB;
static_assert(WS_A + (size_t)MA * DM * 2 <= WS_HID && WS_HID + (size_t)MT * DFF * 2 <= WS_F && WS_F + (size_t)MT * DM * 4 <= WS_GA, "ws map 1");
static_assert(WS_OINTRA + (size_t)MT * DM * 2 <= WS_SBQ && WS_MQ + (size_t)MT * 1024 * 2 <= WS_GA && WS_GA + (size_t)MT * 64 <= WS_EB && WS_EB + (size_t)NCHUNK * 4096 <= WS_MKB, "ws map 2");
static_assert(WS_MRG + (size_t)MT * DM * 4 <= WS_SBQ && WS_FO + (size_t)MT * DM * 4 <= WS_MQ && WS_WIN + 12544ull * 4096 <= WS_WGATE && WS_WGU + 11264ull * 4096 <= WS_WD && WS_WD + 2048ull * 11264 <= WS_WIN, "ws map 3");
constexpr int CW_TMO = 0, CW_BAR = 4096;

constexpr int LDS_BYTES = 155648;
constexpr int LDSCTL_OFF = 151552;
constexpr int MISC_OFF = LDSCTL_OFF + 320;

__device__ __forceinline__ float wave_sum(float v) {
#pragma unroll
    for (int o = 1; o < 64; o <<= 1) v += __shfl_xor(v, o);
    return v;
}
__device__ __forceinline__ float fexp2(float x) { return __builtin_amdgcn_exp2f(x); }
__device__ __forceinline__ float flog2(float x) { return __builtin_amdgcn_logf(x); }
__device__ __forceinline__ float frcp(float x) { return __builtin_amdgcn_rcpf(x); }
__device__ __forceinline__ float sigmoidf_(float x) { return frcp(1.0f + fexp2(-x * LOG2E)); }
typedef __bf16 bf16x2_t __attribute__((ext_vector_type(2)));
__device__ __forceinline__ unsigned cvtpk(float lo, float hi) { f32x2v v = {lo, hi}; bf16x2_t b = __builtin_convertvector(v, bf16x2_t); return __builtin_bit_cast(unsigned, b); }
__device__ __forceinline__ float bf2f(unsigned short b) { return __uint_as_float(((unsigned)b) << 16); }
__device__ __forceinline__ float bflo(unsigned w) { return __uint_as_float(w << 16); }
__device__ __forceinline__ float bfhi(unsigned w) { return __uint_as_float(w & 0xffff0000u); }
__device__ __forceinline__ s16x4 vtr(ldscp p) { return __builtin_bit_cast(s16x4, __builtin_amdgcn_ds_read_tr16_b64_v4i16((LAS v4i16_t*)p)); }
__device__ __forceinline__ int crow(int r, int hi) { return (r & 3) + 8 * (r >> 2) + 4 * hi; }
__device__ __forceinline__ bf16x8 ld8_bf(const bf16* p) { return *(const bf16x8*)p; }
__device__ __forceinline__ bf16x8 ld8_f32(const float* p) { const f32x4 a = *(const f32x4*)p, b = *(const f32x4*)(p + 4); v4u w = {cvtpk(a.x, a.y), cvtpk(a.z, a.w), cvtpk(b.x, b.y), cvtpk(b.z, b.w)}; return __builtin_bit_cast(bf16x8, w); }
#define PK4(P, BASE, OUT) do { unsigned a0_ = cvtpk(P[BASE + 0], P[BASE + 1]), a1_ = cvtpk(P[BASE + 2], P[BASE + 3]); \
    unsigned b0_ = cvtpk(P[BASE + 4], P[BASE + 5]), b1_ = cvtpk(P[BASE + 6], P[BASE + 7]); \
    auto r0_ = __builtin_amdgcn_permlane32_swap(a0_, b0_, false, false); auto r1_ = __builtin_amdgcn_permlane32_swap(a1_, b1_, false, false); \
    v4u w_ = {r0_[0], r1_[0], r0_[1], r1_[1]}; OUT = __builtin_bit_cast(bf16x8, w_); } while (0)

__device__ __forceinline__ void cvt_block(const float* W, int ldw, int k0, int srccol, int nvalid, bf16* WT, int K, int dstrow, LAS float* scr, int lane) {
    const int n = lane & 31;
#pragma unroll 8
    for (int i = 0; i < 32; ++i) { const int kk = 2 * i + (lane >> 5); scr[kk * 33 + n] = (n < nvalid) ? W[(size_t)(k0 + kk) * ldw + srccol + n] : 0.f; }
    LDS_WAIT(); asm volatile("" ::: "memory");
    const int c = lane & 7;
#pragma unroll
    for (int j = 0; j < 4; ++j) { const int nn = (lane >> 3) + 8 * j; const LAS float* s = scr + (8 * c) * 33 + nn;
        v4u o; o.x = cvtpk(s[0 * 33], s[1 * 33]); o.y = cvtpk(s[2 * 33], s[3 * 33]); o.z = cvtpk(s[4 * 33], s[5 * 33]); o.w = cvtpk(s[6 * 33], s[7 * 33]);
        *(v4u*)(WT + (size_t)(dstrow + nn) * K + k0 + 8 * c) = o; }
    LDS_WAIT(); asm volatile("" ::: "memory");
}
__device__ __forceinline__ void cvt_item(const float* W, int K, int ldw, bf16* WT, int mode, int nblk, int item, LAS float* scr, int lane) {
    const int kb = item / nblk, db = item - kb * nblk; int src = 32 * db, nvalid = 32;
    if (mode == 1) { const int t = db >> 3, j = db & 7; src = (j < 4) ? 128 * t + 32 * j : DFF + 128 * t + 32 * (j - 4); }
    if (mode == 2) { if (db >= 288 && db < 320) src = 9232 + 32 * (db - 288); else if (db == 320) { src = 9216; nvalid = 16; } else if (db > 320) { src = 0; nvalid = 0; } }
    cvt_block(W, ldw, 64 * kb, src, nvalid, WT, K, 32 * db, scr, lane);
}

__device__ __forceinline__ void load_gain(const float* g, f32x4 (&v)[8], int lane) {
#pragma unroll
    for (int j = 0; j < 8; ++j) v[j] = *(const f32x4*)(g + 4 * lane + 256 * j);
}
template <bool HAS_F, bool ST_H, bool ST_A>
__device__ __forceinline__ void thin_row(const float* base, const float* f, float s, const f32x4 (&gpost)[8], float* hout, const f32x4 (&gpre)[8], bf16* aout, int lane) {
    f32x4 h[8];
#pragma unroll
    for (int j = 0; j < 8; ++j) h[j] = *(const f32x4*)(base + 4 * lane + 256 * j);
    if (HAS_F) {
        f32x4 fv[8]; float ss = 0.f;
#pragma unroll
        for (int j = 0; j < 8; ++j) { fv[j] = *(const f32x4*)(f + 4 * lane + 256 * j); ss += (fv[j].x * fv[j].x + fv[j].y * fv[j].y) + (fv[j].z * fv[j].z + fv[j].w * fv[j].w); }
        const float r = s * __builtin_amdgcn_rsqf(wave_sum(ss) * (1.0f / DM) + EPS);
#pragma unroll
        for (int j = 0; j < 8; ++j) h[j] = h[j] + fv[j] * gpost[j] * r;
    }
    if (ST_H) {
#pragma unroll
        for (int j = 0; j < 8; ++j) *(f32x4*)(hout + 4 * lane + 256 * j) = h[j];
    }
    if (ST_A) {
        float ss = 0.f;
#pragma unroll
        for (int j = 0; j < 8; ++j) ss += (h[j].x * h[j].x + h[j].y * h[j].y) + (h[j].z * h[j].z + h[j].w * h[j].w);
        const float r = __builtin_amdgcn_rsqf(wave_sum(ss) * (1.0f / DM) + EPS);
#pragma unroll
        for (int j = 0; j < 8; ++j) { const f32x4 a = h[j] * gpre[j] * r; u32x2 w; w.x = cvtpk(a.x, a.y); w.y = cvtpk(a.z, a.w); *(u32x2*)(aout + 4 * lane + 256 * j) = w; }
    }
}

struct EpiGU {
    static constexpr bool PERM = true, AFTER_DRAIN = false;
    bf16* H;
    __device__ __forceinline__ void operator()(const pg8::f32x4 (&acc)[2][2][4][2], const pg8::Unit& u, int wr, int wc, int fr, int fq) const {
        const int row0 = u.pm * 256 + wr * 64 + fr, col0 = u.pn * 128 + wc * 32 + 8 * fq;
#pragma unroll
        for (int ai = 0; ai < 2; ++ai)
#pragma unroll
            for (int m = 0; m < 4; ++m) {
                float o[8];
#pragma unroll
                for (int n = 0; n < 2; ++n)
#pragma unroll
                    for (int i = 0; i < 4; ++i) { const float g = acc[ai][0][m][n][i], uu = acc[ai][1][m][n][i]; o[4 * n + i] = g * uu * frcp(1.0f + fexp2(-g * LOG2E)); }
                v4u w; w.x = cvtpk(o[0], o[1]); w.y = cvtpk(o[2], o[3]); w.z = cvtpk(o[4], o[5]); w.w = cvtpk(o[6], o[7]);
                *(v4u*)(H + (size_t)(row0 + ai * 128 + m * 16) * DFF + col0) = w;
            }
    }
};
struct EpiF32 {
    static constexpr bool PERM = false, AFTER_DRAIN = false;
    float* C;
    __device__ __forceinline__ void operator()(const pg8::f32x4 (&acc)[2][2][4][2], const pg8::Unit& u, int wr, int wc, int fr, int fq) const {
        const int row0 = u.pm * 256 + wr * 64 + fr, col0 = u.pn * 256 + wc * 32 + 4 * fq;
#pragma unroll
        for (int ai = 0; ai < 2; ++ai)
#pragma unroll
            for (int m = 0; m < 4; ++m) { float* rowp = C + (size_t)(row0 + ai * 128 + m * 16) * DM + col0;
#pragma unroll
                for (int bj = 0; bj < 2; ++bj)
#pragma unroll
                    for (int n = 0; n < 2; ++n) *(pg8::f32x4*)(rowp + bj * 128 + n * 16) = acc[ai][bj][m][n]; }
    }
};
struct EpiIN {
    static constexpr bool PERM = true, AFTER_DRAIN = false;
    unsigned char* ws; float* out;
    __device__ __forceinline__ void operator()(const pg8::f32x4 (&acc)[2][2][4][2], const pg8::Unit& u, int wr, int wc, int fr, int fq) const {
        const int pn = u.pn, rowb = u.pm * 256 + wr * 64 + fr, cw = wc * 32 + 8 * fq;
        if (pn == 40) {
            if (wc == 0 && fq < 2) {
                float* GA = (float*)(ws + WS_GA);
#pragma unroll
                for (int ai = 0; ai < 2; ++ai)
#pragma unroll
                    for (int m = 0; m < 4; ++m) { float* p = GA + (size_t)(rowb + ai * 128 + m * 16) * 16 + 8 * fq; *(pg8::f32x4*)p = acc[ai][0][m][0]; *(pg8::f32x4*)(p + 4) = acc[ai][0][m][1]; }
            }
            return;
        }
        bf16* bb; int ld, c0; float sc = 1.0f; float* fo = nullptr; int act = 0;
        const bool samp = (u.pm >= 128);
        if (pn >= 41) {
            const int t = pn - 41; ld = 1024;
            if (t < 4) { bb = (bf16*)(ws + WS_MKB); c0 = t * 256; fo = out + O_MEMK_P; } else { bb = (bf16*)(ws + WS_MVB); c0 = (t - 4) * 256; fo = out + O_MEMV_P; }
        } else if (pn < 4) { bb = (bf16*)(ws + WS_SBQ); ld = 1024; c0 = pn * 256; sc = C_SB; }
        else if (pn < 8) { bb = (bf16*)(ws + WS_SBK); ld = 1024; c0 = (pn - 4) * 256; fo = samp ? out + O_SBK_S : out + O_SBK_P; }
        else if (pn < 12) { bb = (bf16*)(ws + WS_SBV); ld = 1024; c0 = (pn - 8) * 256; fo = samp ? out + O_SBV_S : out + O_SBV_P; }
        else if (pn < 16) { bb = (bf16*)(ws + WS_GQ); ld = 1024; c0 = (pn - 12) * 256; sc = C_GQ; }
        else if (pn < 20) { bb = (bf16*)(ws + WS_GK); ld = 1024; c0 = (pn - 16) * 256; }
        else if (pn < 28) { bb = (bf16*)(ws + WS_GV); ld = 2048; c0 = (pn - 20) * 256; }
        else if (pn < 36) { bb = (bf16*)(ws + WS_GR); ld = 2048; c0 = (pn - 28) * 256; act = 1; }
        else { bb = (bf16*)(ws + WS_MQ); ld = 1024; c0 = (pn - 36) * 256; sc = C_MEM; }
        const int rb_b = (pn >= 41) ? rowb - MT : rowb;
        const int rb_f = (pn >= 41) ? rowb - MT : (samp ? rowb - NPT : rowb);
#pragma unroll
        for (int ai = 0; ai < 2; ++ai)
#pragma unroll
            for (int m = 0; m < 4; ++m)
#pragma unroll
                for (int bj = 0; bj < 2; ++bj) {
                    pg8::f32x4 v0 = acc[ai][bj][m][0], v1 = acc[ai][bj][m][1];
                    const int cc = c0 + bj * 128 + cw; const int ro = ai * 128 + m * 16;
                    if (fo) { float* p = fo + (size_t)(rb_f + ro) * 1024 + cc; *(pg8::f32x4*)p = v0; *(pg8::f32x4*)(p + 4) = v1; }
                    if (act) {
#pragma unroll
                        for (int i = 0; i < 4; ++i) { v0[i] = v0[i] * frcp(1.0f + fexp2(-v0[i] * LOG2E)); v1[i] = v1[i] * frcp(1.0f + fexp2(-v1[i] * LOG2E)); }
                    }
                    v0 = v0 * sc; v1 = v1 * sc;
                    v4u w; w.x = cvtpk(v0[0], v0[1]); w.y = cvtpk(v0[2], v0[3]); w.z = cvtpk(v1[0], v1[1]); w.w = cvtpk(v1[2], v1[3]);
                    *(v4u*)(bb + (size_t)(rb_b + ro) * ld + cc) = w;
                }
    }
};
struct EpiGate {
    static constexpr bool PERM = true, AFTER_DRAIN = false;
    unsigned char* ws; const float* bias;
    __device__ __forceinline__ void operator()(const pg8::f32x4 (&acc)[2][2][4][2], const pg8::Unit& u, int wr, int wc, int fr, int fq) const {
        const int br = u.pn >> 3, rowb = u.pm * 256 + wr * 64 + fr, cw = wc * 32 + 8 * fq, c0 = (u.pn & 7) * 256;
        bf16* G = (bf16*)(ws + (br == 0 ? WS_G0 : (br == 1 ? WS_G1 : WS_G2)));
        pg8::f32x4 bv[2][2];
#pragma unroll
        for (int bj = 0; bj < 2; ++bj)
#pragma unroll
            for (int n = 0; n < 2; ++n) bv[bj][n] = *(const pg8::f32x4*)(bias + u.pn * 256 + bj * 128 + cw + 4 * n);
#pragma unroll
        for (int ai = 0; ai < 2; ++ai)
#pragma unroll
            for (int m = 0; m < 4; ++m)
#pragma unroll
                for (int bj = 0; bj < 2; ++bj) {
                    float o[8];
#pragma unroll
                    for (int n = 0; n < 2; ++n)
#pragma unroll
                        for (int i = 0; i < 4; ++i) o[4 * n + i] = sigmoidf_(acc[ai][bj][m][n][i] + bv[bj][n][i]);
                    v4u w; w.x = cvtpk(o[0], o[1]); w.y = cvtpk(o[2], o[3]); w.z = cvtpk(o[4], o[5]); w.w = cvtpk(o[6], o[7]);
                    *(v4u*)(G + (size_t)(rowb + ai * 128 + m * 16) * DM + c0 + bj * 128 + cw) = w;
                }
    }
};
template <int MODE> struct EpiBR {
    static constexpr bool PERM = false, AFTER_DRAIN = false;
    const bf16* G; float* MRG; bf16* OUTB;
    __device__ __forceinline__ void operator()(const pg8::f32x4 (&acc)[2][2][4][2], const pg8::Unit& u, int wr, int wc, int fr, int fq) const {
        const int row0 = u.pm * 256 + wr * 64 + fr, col0 = u.pn * 256 + wc * 32 + 4 * fq;
#pragma unroll
        for (int ai = 0; ai < 2; ++ai)
#pragma unroll
            for (int m = 0; m < 4; ++m) { const size_t ro = (size_t)(row0 + ai * 128 + m * 16) * DM + col0;
#pragma unroll
                for (int bj = 0; bj < 2; ++bj)
#pragma unroll
                    for (int n = 0; n < 2; ++n) { const size_t o = ro + bj * 128 + n * 16; const u32x2 gw = *(const u32x2*)(G + o);
                        pg8::f32x4 g = {bflo(gw.x), bfhi(gw.x), bflo(gw.y), bfhi(gw.y)}; pg8::f32x4 v = g * acc[ai][bj][m][n];
                        if (MODE >= 1) v = v + *(const pg8::f32x4*)(MRG + o);
                        if (MODE <= 1) *(pg8::f32x4*)(MRG + o) = v;
                        else { u32x2 w; w.x = cvtpk(v[0], v[1]); w.y = cvtpk(v[2], v[3]); *(u32x2*)(OUTB + o) = w; } }
            }
    }
};
struct OrderIN {
    pg8::StaticOrder S; int G, c;
    __device__ void init(int G_, int c_) { S.init(MT, 41 * 256, G_, c_); G = G_; c = c_; }
    __device__ bool next(int i, pg8::Unit& u) const {
        const long L = (long)i * G + c;
        if (L < S.nwg) return S.next(i, u);
        const int j = (int)(L - S.nwg); if (j >= 32) return false;
        u.pm = MT / 256 + (j & 3); u.pn = 41 + (j >> 2); return true;
    }
    __device__ __forceinline__ void a_ready(const pg8::Unit&) const {}
    __device__ __forceinline__ void done(const pg8::Unit&) const {}
};

constexpr int SB_KP = 272, SB_VP = 288, SB_VOFF = 64 * SB_KP, SB_FLAG = SB_VOFF + 64 * SB_VP;
__device__ __forceinline__ void sb_weights(f32x16& p0, f32x16& p1, float& Rin, int kpos0, int qpos, bool mask, int hi) {
#pragma unroll
    for (int r = 0; r < 16; ++r) { p0[r] = frcp(1.0f + fexp2(p0[r])); p1[r] = frcp(1.0f + fexp2(p1[r])); }
    if (mask) {
#pragma unroll
        for (int r = 0; r < 16; ++r) { const int kp = kpos0 + crow(r, hi); if (kp >= qpos) p0[r] = 1.0f; if (kp + 32 >= qpos) p1[r] = 1.0f; }
    }
    float TG[16];
#pragma unroll
    for (int i = 0; i < 4; ++i) {
        const float t0 = (p0[4 * i] * p0[4 * i + 1]) * (p0[4 * i + 2] * p0[4 * i + 3]), t1 = (p1[4 * i] * p1[4 * i + 1]) * (p1[4 * i + 2] * p1[4 * i + 3]);
        auto a = __builtin_amdgcn_permlane32_swap(__float_as_uint(t0), __float_as_uint(t0), false, false);
        auto b = __builtin_amdgcn_permlane32_swap(__float_as_uint(t1), __float_as_uint(t1), false, false);
        TG[2 * i] = __uint_as_float(a[0]); TG[2 * i + 1] = __uint_as_float(a[1]); TG[8 + 2 * i] = __uint_as_float(b[0]); TG[8 + 2 * i + 1] = __uint_as_float(b[1]);
    }
    float E[17]; E[16] = Rin;
#pragma unroll
    for (int g = 15; g >= 0; --g) E[g] = E[g + 1] * TG[g];
#pragma unroll
    for (int i = 0; i < 4; ++i) {
        { const float st = hi ? E[2 * i + 2] : E[2 * i + 1];
          const float R3 = st * p0[4 * i + 3], R2 = R3 * p0[4 * i + 2], R1 = R2 * p0[4 * i + 1], R0 = R1 * p0[4 * i];
          p0[4 * i + 3] = st - R3; p0[4 * i + 2] = R3 - R2; p0[4 * i + 1] = R2 - R1; p0[4 * i] = R1 - R0; }
        { const float st = hi ? E[8 + 2 * i + 2] : E[8 + 2 * i + 1];
          const float R3 = st * p1[4 * i + 3], R2 = R3 * p1[4 * i + 2], R1 = R2 * p1[4 * i + 1], R0 = R1 * p1[4 * i];
          p1[4 * i + 3] = st - R3; p1[4 * i + 2] = R3 - R2; p1[4 * i + 1] = R2 - R1; p1[4 * i] = R1 - R0; }
    }
    Rin = E[0];
}
template <bool SAMPLE>
__device__ __forceinline__ void sb_unit(ldsp lds, int b, int h, int qb, const bf16* SBQ, const bf16* SBK, const bf16* SBV, bf16* OSB, const float* cK, const float* cV, int tid, int wid, int lane) {
    const int r32 = lane & 31, hi = lane >> 5;
    const int nwv = SAMPLE ? 1 : 8;
    const size_t qrow0 = SAMPLE ? (size_t)NPT + b * 32 : (size_t)b * SEQ + qb * 256;
    const int qpos0 = SAMPLE ? PAST : qb * 256;
    const bool wact = wid < nwv;
    const int qmin = qpos0 + 32 * wid, qpos = qmin + r32, qmax = qmin + 31;
    bf16x8 qr[8];
    if (wact) {
        const bf16* qp = SBQ + (qrow0 + 32 * wid + r32) * 1024 + h * 128 + hi * 8;
#pragma unroll
        for (int d0 = 0; d0 < 8; ++d0) qr[d0] = ld8_bf(qp + d0 * 16);
    } else {
#pragma unroll
        for (int d0 = 0; d0 < 8; ++d0) qr[d0] = (bf16x8){0, 0, 0, 0, 0, 0, 0, 0};
    }
    f32x16 o[4];
#pragma unroll
    for (int d = 0; d < 4; ++d)
#pragma unroll
        for (int r = 0; r < 16; ++r) o[d][r] = 0.f;
    float Rin = 1.0f;
    const int sr = tid >> 4, sc = (tid & 15) * 8;
    volatile LAS int* flags = (volatile LAS int*)(lds + SB_FLAG);
    const int kt_last = SAMPLE ? (PAST + DSEQ - 1) / 64 : (qpos0 + 255) / 64;
    for (int kt = kt_last; kt >= 0; --kt) {
        bf16x8 k0v, k1v, v0v, v1v;
        if (!SAMPLE) {
            const size_t base = ((size_t)b * SEQ + kt * 64) * 1024 + h * 128 + sc;
            k0v = ld8_bf(SBK + base + (size_t)sr * 1024); k1v = ld8_bf(SBK + base + (size_t)(sr + 32) * 1024);
            v0v = ld8_bf(SBV + base + (size_t)sr * 1024); v1v = ld8_bf(SBV + base + (size_t)(sr + 32) * 1024);
        } else if (kt * 64 < PAST) {
            const size_t base = ((size_t)b * PAST + kt * 64) * 1024 + h * 128 + sc;
            k0v = ld8_f32(cK + base + (size_t)sr * 1024); k1v = ld8_f32(cK + base + (size_t)(sr + 32) * 1024);
            v0v = ld8_f32(cV + base + (size_t)sr * 1024); v1v = ld8_f32(cV + base + (size_t)(sr + 32) * 1024);
        } else {
            const size_t base = ((size_t)NPT + b * 32) * 1024 + h * 128 + sc;
            k0v = ld8_bf(SBK + base + (size_t)sr * 1024); v0v = ld8_bf(SBV + base + (size_t)sr * 1024);
            k1v = (bf16x8){0, 0, 0, 0, 0, 0, 0, 0}; v1v = k1v;
        }
        *(LAS bf16x8*)(lds + sr * SB_KP + sc * 2) = k0v; *(LAS bf16x8*)(lds + (sr + 32) * SB_KP + sc * 2) = k1v;
        *(LAS bf16x8*)(lds + SB_VOFF + sr * SB_VP + sc * 2) = v0v; *(LAS bf16x8*)(lds + SB_VOFF + (sr + 32) * SB_VP + sc * 2) = v1v;
        __syncthreads();
        int alive = 0;
        if (wact) {
            alive = 1;
            const int kpos0 = kt * 64;
            if (kpos0 < qmax && __any(Rin >= SB_THR)) {
                f32x16 p0, p1;
#pragma unroll
                for (int r = 0; r < 16; ++r) { p0[r] = 0.f; p1[r] = 0.f; }
#pragma unroll
                for (int d0 = 0; d0 < 8; ++d0) {
                    const bf16x8 a0 = *(const LAS bf16x8*)(lds + r32 * SB_KP + (d0 * 16 + hi * 8) * 2);
                    const bf16x8 a1 = *(const LAS bf16x8*)(lds + (32 + r32) * SB_KP + (d0 * 16 + hi * 8) * 2);
                    p0 = __builtin_amdgcn_mfma_f32_32x32x16_bf16(a0, qr[d0], p0, 0, 0, 0);
                    p1 = __builtin_amdgcn_mfma_f32_32x32x16_bf16(a1, qr[d0], p1, 0, 0, 0);
                }
                sb_weights(p0, p1, Rin, kpos0, qpos, kpos0 + 63 >= qmin, hi);
                bf16x8 pa[4]; PK4(p0, 0, pa[0]); PK4(p0, 8, pa[1]); PK4(p1, 0, pa[2]); PK4(p1, 8, pa[3]);
                const int vrow = 8 * hi + ((lane & 15) >> 2), vcol = 16 * ((lane >> 4) & 1) + 4 * (lane & 3);
#pragma unroll
                for (int d0 = 0; d0 < 4; ++d0)
#pragma unroll
                    for (int ks = 0; ks < 4; ++ks) {
                        ldscp vp = lds + SB_VOFF + (16 * ks + vrow) * SB_VP + (32 * d0 + vcol) * 2;
                        const s16x4 lo = vtr(vp), hh = vtr(vp + 4 * SB_VP);
                        const bf16x8 vb = {lo[0], lo[1], lo[2], lo[3], hh[0], hh[1], hh[2], hh[3]};
                        o[d0] = __builtin_amdgcn_mfma_f32_32x32x16_bf16(pa[ks], vb, o[d0], 0, 0, 0);
                    }
            }
            alive = __any(Rin >= SB_THR) ? 1 : 0;
        }
        if (lane == 0) flags[wid] = alive;
        __syncthreads();
        int any_alive = 0;
#pragma unroll
        for (int w = 0; w < 8; ++w) any_alive |= flags[w];
        if (!any_alive) break;
    }
    __syncthreads();
    if (wact) {
        bf16* op = OSB + (qrow0 + 32 * wid) * 1024 + h * 128 + r32;
#pragma unroll
        for (int r = 0; r < 16; ++r) { const int qq = crow(r, hi);
#pragma unroll
            for (int d0 = 0; d0 < 4; ++d0) op[(size_t)qq * 1024 + d0 * 32] = (bf16)(cvtpk(o[d0][r], 0.f) & 0xffffu); }
    }
}

constexpr int MEM_P = 544;
template <bool SAMPLE>
__device__ __forceinline__ void mem_unit(ldsp lds, int b, int h, int qblk, bf16* MQ, const bf16* MKB, const bf16* MVB, const float* cK, const float* cV, int tid, int wid, int lane) {
    const int l15 = lane & 15, g = lane >> 4;
    const size_t qrow0 = SAMPLE ? (size_t)NPT + b * 32 : (size_t)b * SEQ + qblk * 128;
    const bool wact = SAMPLE ? (wid < 2) : true;
    bf16x8 qf[8];
    if (wact) { const bf16* qp = MQ + (qrow0 + 16 * wid + l15) * 1024 + h * 256 + 8 * g;
#pragma unroll
        for (int s = 0; s < 8; ++s) qf[s] = ld8_bf(qp + 32 * s); }
    else {
#pragma unroll
        for (int s = 0; s < 8; ++s) qf[s] = (bf16x8){0, 0, 0, 0, 0, 0, 0, 0}; }
    f32x4 st[4][4];
#pragma unroll
    for (int a = 0; a < 4; ++a)
#pragma unroll
        for (int c = 0; c < 4; ++c) st[a][c] = (f32x4){0.f, 0.f, 0.f, 0.f};
    const int srow = tid >> 3, scol = (tid & 7) * 32;
    const size_t kvbase = (size_t)b * 256 * 1024 + h * 256 + scol;
#pragma unroll
    for (int kt = 0; kt < 4; ++kt) {
        __syncthreads();
        { const size_t so = kvbase + (size_t)(kt * 64 + srow) * 1024;
#pragma unroll
          for (int c = 0; c < 4; ++c) { const bf16x8 v = SAMPLE ? ld8_f32(cK + so + 8 * c) : ld8_bf(MKB + so + 8 * c); *(LAS bf16x8*)(lds + srow * MEM_P + (scol + 8 * c) * 2) = v; } }
        __syncthreads();
        if (wact) {
#pragma unroll
            for (int t4 = 0; t4 < 4; ++t4)
#pragma unroll
                for (int s = 0; s < 8; ++s) {
                    const bf16x8 a = *(const LAS bf16x8*)(lds + (16 * t4 + l15) * MEM_P + (32 * s + 8 * g) * 2);
                    st[kt][t4] = __builtin_amdgcn_mfma_f32_16x16x32_bf16(a, qf[s], st[kt][t4], 0, 0, 0);
                }
        }
    }
    float mx = -3.0e38f;
#pragma unroll
    for (int a = 0; a < 4; ++a)
#pragma unroll
        for (int c = 0; c < 4; ++c)
#pragma unroll
            for (int i = 0; i < 4; ++i) mx = fmaxf(mx, st[a][c][i]);
    mx = fmaxf(mx, __shfl_xor(mx, 16)); mx = fmaxf(mx, __shfl_xor(mx, 32));
    float sm = 0.f;
#pragma unroll
    for (int a = 0; a < 4; ++a)
#pragma unroll
        for (int c = 0; c < 4; ++c)
#pragma unroll
            for (int i = 0; i < 4; ++i) { st[a][c][i] = fexp2(st[a][c][i] - mx); sm += st[a][c][i]; }
    sm += __shfl_xor(sm, 16); sm += __shfl_xor(sm, 32);
    const float inv = 1.0f / sm;
    f32x4 o[16];
#pragma unroll
    for (int c = 0; c < 16; ++c) o[c] = (f32x4){0.f, 0.f, 0.f, 0.f};
#pragma unroll
    for (int kt = 0; kt < 4; ++kt) {
        __syncthreads();
        { const size_t so = kvbase + (size_t)(kt * 64 + srow) * 1024;
#pragma unroll
          for (int c = 0; c < 4; ++c) { const bf16x8 v = SAMPLE ? ld8_f32(cV + so + 8 * c) : ld8_bf(MVB + so + 8 * c); *(LAS bf16x8*)(lds + srow * MEM_P + (scol + 8 * c) * 2) = v; } }
        __syncthreads();
        if (wact) {
#pragma unroll
            for (int s2 = 0; s2 < 2; ++s2) {
                const f32x4 x0 = st[kt][2 * s2] * inv, x1 = st[kt][2 * s2 + 1] * inv;
                v4u pw = {cvtpk(x0[0], x0[1]), cvtpk(x0[2], x0[3]), cvtpk(x1[0], x1[1]), cvtpk(x1[2], x1[3])};
                const bf16x8 pa = __builtin_bit_cast(bf16x8, pw);
#pragma unroll
                for (int cb = 0; cb < 16; ++cb) {
                    ldscp vp = lds + (32 * s2 + 4 * g + (l15 >> 2)) * MEM_P + (16 * cb + 4 * (lane & 3)) * 2;
                    const s16x4 lo = vtr(vp), hh = vtr(vp + 16 * MEM_P);
                    const bf16x8 vb = {lo[0], lo[1], lo[2], lo[3], hh[0], hh[1], hh[2], hh[3]};
                    o[cb] = __builtin_amdgcn_mfma_f32_16x16x32_bf16(pa, vb, o[cb], 0, 0, 0);
                }
            }
        }
    }
    if (wact) {
        bf16* op = MQ + (qrow0 + 16 * wid + 4 * g) * 1024 + h * 256 + l15;
#pragma unroll
        for (int cb = 0; cb < 16; ++cb)
#pragma unroll
            for (int i = 0; i < 4; ++i) op[(size_t)i * 1024 + cb * 16] = (bf16)(cvtpk(o[cb][i], 0.f) & 0xffffu);
    }
    __syncthreads();
}

constexpr int GP_VP = 1056, GP_QP = 528, GP_QE = 67584, GP_KD = 101376, GP_ATT = 135168, GP_AP = 144;
__device__ __forceinline__ void gla_pre_item(ldsp lds, int cid, int h, unsigned char* ws, const float* wa2, const float* ba2, int tid, int wid, int lane) {
    const bool samp = cid >= NPT / 64; const int L = samp ? 32 : 64;
    const size_t row0 = samp ? (size_t)NPT + (cid - NPT / 64) * 32 : (size_t)cid * 64;
    bf16* GQ = (bf16*)(ws + WS_GQ); bf16* GK = (bf16*)(ws + WS_GK); const bf16* GV = (const bf16*)(ws + WS_GV); const float* GA = (const float*)(ws + WS_GA);
    float* EB = (float*)(ws + WS_EB); bf16* OI = (bf16*)(ws + WS_OINTRA);
    LAS float* bl = (LAS float*)lds; LAS float* gal = (LAS float*)(lds + GP_ATT);
    const int dk = tid & 255, half = tid >> 8;
    __syncthreads();
    for (int i = tid; i < 64 * 16; i += NTHR) { const int t = i >> 4; gal[i] = (t < L) ? GA[(row0 + t) * 16 + (i & 15)] : 0.f; }
    float w[16];
#pragma unroll
    for (int r = 0; r < 16; ++r) w[r] = wa2[r * 1024 + h * 256 + dk];
    const float bias = ba2[h * 256 + dk];
    __syncthreads();
    float cum = 0.f;
    for (int tt = 0; tt < 32; ++tt) {
        const int t = half * 32 + tt; float x = bias;
#pragma unroll
        for (int r = 0; r < 16; ++r) x += gal[t * 16 + r] * w[r];
        const float ls = fminf(x, 0.f) - LN2 * flog2(1.0f + fexp2(-fabsf(x) * LOG2E));
        if (t < L) cum += ls * (1.0f / 16.0f);
        bl[t * 256 + dk] = cum;
    }
    __syncthreads();
    const float add = half ? bl[31 * 256 + dk] : 0.f;
    __syncthreads();
    if (half) {
        for (int tt = 0; tt < 32; ++tt) bl[(32 + tt) * 256 + dk] += add;
    }
    __syncthreads();
    const float bL = bl[63 * 256 + dk];
    if (half == 0) EB[(size_t)cid * 1024 + h * 256 + dk] = fexp2(bL * LOG2E);
    for (int tt = 0; tt < 32; ++tt) {
        const int t = half * 32 + tt; const float bb = bl[t * 256 + dk] * LOG2E;
        float q = 0.f, k = 0.f;
        if (t < L) { q = bf2f(GQ[(row0 + t) * 1024 + h * 256 + dk]); k = bf2f(GK[(row0 + t) * 1024 + h * 256 + dk]); }
        const float qe = q * fexp2(bb), kd = k * fexp2(-bb), ke = k * fexp2(bL * LOG2E - bb);
        const bf16 qeb = (bf16)(cvtpk(qe, 0.f) & 0xffffu);
        *(LAS bf16*)(lds + GP_QE + t * GP_QP + dk * 2) = qeb;
        *(LAS bf16*)(lds + GP_KD + t * GP_QP + dk * 2) = (bf16)(cvtpk(kd, 0.f) & 0xffffu);
        if (t < L) { GQ[(row0 + t) * 1024 + h * 256 + dk] = qeb; GK[(row0 + t) * 1024 + h * 256 + dk] = (bf16)(cvtpk(ke, 0.f) & 0xffffu); }
    }
    __syncthreads();
    { const int vr = tid >> 3, vc = (tid & 7) * 64;
#pragma unroll
      for (int c = 0; c < 8; ++c) { bf16x8 v = (bf16x8){0, 0, 0, 0, 0, 0, 0, 0}; if (vr < L) v = ld8_bf(GV + (row0 + vr) * 2048 + h * 512 + vc + 8 * c); *(LAS bf16x8*)(lds + vr * GP_VP + (vc + 8 * c) * 2) = v; } }
    const int r32 = lane & 31, hi = lane >> 5;
    if (wid < 3) {
        const int sb = (wid == 2) ? 1 : 0, tb = (wid >= 1) ? 1 : 0;
        f32x16 p;
#pragma unroll
        for (int r = 0; r < 16; ++r) p[r] = 0.f;
#pragma unroll
        for (int ks = 0; ks < 16; ++ks) {
            const bf16x8 a = *(const LAS bf16x8*)(lds + GP_KD + (32 * sb + r32) * GP_QP + (16 * ks + 8 * hi) * 2);
            const bf16x8 bq = *(const LAS bf16x8*)(lds + GP_QE + (32 * tb + r32) * GP_QP + (16 * ks + 8 * hi) * 2);
            p = __builtin_amdgcn_mfma_f32_32x32x16_bf16(a, bq, p, 0, 0, 0);
        }
        const int t = 32 * tb + r32;
#pragma unroll
        for (int i = 0; i < 4; ++i) {
            float v[4];
#pragma unroll
            for (int j = 0; j < 4; ++j) { const int s = 32 * sb + 8 * i + 4 * hi + j; v[j] = (s <= t) ? p[4 * i + j] : 0.f; }
            u32x2 wv; wv.x = cvtpk(v[0], v[1]); wv.y = cvtpk(v[2], v[3]);
            *(LAS u32x2*)(lds + GP_ATT + t * GP_AP + (32 * sb + 8 * i + 4 * hi) * 2) = wv;
        }
    } else if (wid == 3) {
        for (int i = lane; i < 32 * 4; i += 64) { const int t = i >> 2, c = i & 3; *(LAS v4u*)(lds + GP_ATT + t * GP_AP + 64 + c * 16) = (v4u){0u, 0u, 0u, 0u}; }
    }
    __syncthreads();
    {
        bf16x8 af[2][4];
#pragma unroll
        for (int tb = 0; tb < 2; ++tb)
#pragma unroll
            for (int ks = 0; ks < 4; ++ks) af[tb][ks] = *(const LAS bf16x8*)(lds + GP_ATT + (32 * tb + r32) * GP_AP + (16 * ks + 8 * hi) * 2);
        const int vrow = 8 * hi + ((lane & 15) >> 2), vcol = 16 * ((lane >> 4) & 1) + 4 * (lane & 3);
#pragma unroll
        for (int cbi = 0; cbi < 2; ++cbi) {
            const int cb = 2 * wid + cbi;
            f32x16 o0, o1;
#pragma unroll
            for (int r = 0; r < 16; ++r) { o0[r] = 0.f; o1[r] = 0.f; }
#pragma unroll
            for (int ks = 0; ks < 4; ++ks) {
                ldscp vp = lds + (16 * ks + vrow) * GP_VP + (32 * cb + vcol) * 2;
                const s16x4 lo = vtr(vp), hh = vtr(vp + 4 * GP_VP);
                const bf16x8 vb = {lo[0], lo[1], lo[2], lo[3], hh[0], hh[1], hh[2], hh[3]};
                if (ks < 2) o0 = __builtin_amdgcn_mfma_f32_32x32x16_bf16(af[0][ks], vb, o0, 0, 0, 0);
                o1 = __builtin_amdgcn_mfma_f32_32x32x16_bf16(af[1][ks], vb, o1, 0, 0, 0);
            }
            bf16* op = OI + row0 * 2048 + h * 512 + 32 * cb + r32;
#pragma unroll
            for (int r = 0; r < 16; ++r) { const int t = crow(r, hi);
                if (t < L) op[(size_t)t * 2048] = (bf16)(cvtpk(o0[r], 0.f) & 0xffffu);
                if (t + 32 < L) op[(size_t)(t + 32) * 2048] = (bf16)(cvtpk(o1[r], 0.f) & 0xffffu); }
        }
    }
    __syncthreads();
}

constexpr int GC_KP = 576, GC_V = 36864, GC_RED = 40960;
__device__ __forceinline__ void gla_chain_step(ldsp lds, f32x16& S, size_t row0, int L, int cid, int h, int sl, unsigned char* ws, int tid, int wid, int lane) {
    const bf16* QE = (const bf16*)(ws + WS_GQ); const bf16* KE = (const bf16*)(ws + WS_GK); const bf16* GV = (const bf16*)(ws + WS_GV);
    const float* EB = (const float*)(ws + WS_EB); bf16* OI = (bf16*)(ws + WS_OINTRA);
    const int r32 = lane & 31, hi = lane >> 5;
    { const int kr = tid >> 3, kc = (tid & 7) * 32;
      bf16x8 kv[4];
#pragma unroll
      for (int c = 0; c < 4; ++c) { kv[c] = (bf16x8){0, 0, 0, 0, 0, 0, 0, 0}; if (kr < L) kv[c] = ld8_bf(KE + (row0 + kr) * 1024 + h * 256 + kc + 8 * c); }
      bf16x8 vv = (bf16x8){0, 0, 0, 0, 0, 0, 0, 0};
      if (tid < 256) { const int vr = tid >> 2, vc = (tid & 3) * 8; if (vr < L) vv = ld8_bf(GV + (row0 + vr) * 2048 + h * 512 + sl * 32 + vc); }
      __syncthreads();
#pragma unroll
      for (int c = 0; c < 4; ++c) *(LAS bf16x8*)(lds + kr * GC_KP + (kc + 8 * c) * 2) = kv[c];
      if (tid < 256) { const int vr = tid >> 2, vc = (tid & 3) * 8; *(LAS bf16x8*)(lds + GC_V + vr * 64 + vc * 2) = vv; }
    }
    bf16x8 qa[2][2];
#pragma unroll
    for (int tb = 0; tb < 2; ++tb)
#pragma unroll
        for (int s = 0; s < 2; ++s) { qa[tb][s] = (bf16x8){0, 0, 0, 0, 0, 0, 0, 0}; if (32 * tb + r32 < L) qa[tb][s] = ld8_bf(QE + (row0 + 32 * tb + r32) * 1024 + h * 256 + 32 * wid + 16 * s + 8 * hi); }
    f32x4 eb[4];
#pragma unroll
    for (int i = 0; i < 4; ++i) eb[i] = *(const f32x4*)(EB + (size_t)cid * 1024 + h * 256 + 32 * wid + 8 * i + 4 * hi);
    bf16x8 sb0, sb1; PK4(S, 0, sb0); PK4(S, 8, sb1);
    f32x16 po0, po1;
#pragma unroll
    for (int r = 0; r < 16; ++r) { po0[r] = 0.f; po1[r] = 0.f; }
    po0 = __builtin_amdgcn_mfma_f32_32x32x16_bf16(qa[0][0], sb0, po0, 0, 0, 0); po0 = __builtin_amdgcn_mfma_f32_32x32x16_bf16(qa[0][1], sb1, po0, 0, 0, 0);
    po1 = __builtin_amdgcn_mfma_f32_32x32x16_bf16(qa[1][0], sb0, po1, 0, 0, 0); po1 = __builtin_amdgcn_mfma_f32_32x32x16_bf16(qa[1][1], sb1, po1, 0, 0, 0);
    { LAS float* red = (LAS float*)(lds + GC_RED) + wid * 2048;
#pragma unroll
      for (int r = 0; r < 16; ++r) { red[crow(r, hi) * 32 + r32] = po0[r]; red[(32 + crow(r, hi)) * 32 + r32] = po1[r]; } }
#pragma unroll
    for (int i = 0; i < 4; ++i)
#pragma unroll
        for (int j = 0; j < 4; ++j) S[4 * i + j] *= eb[i][j];
    __syncthreads();
    { const int trow = 8 * hi + ((lane & 15) >> 2), tcol = 16 * ((lane >> 4) & 1) + 4 * (lane & 3);
#pragma unroll
      for (int ks = 0; ks < 4; ++ks) {
          ldscp kp = lds + (16 * ks + trow) * GC_KP + (32 * wid + tcol) * 2;
          const s16x4 kl = vtr(kp), kh = vtr(kp + 4 * GC_KP);
          const bf16x8 ka = {kl[0], kl[1], kl[2], kl[3], kh[0], kh[1], kh[2], kh[3]};
          ldscp vp = lds + GC_V + (16 * ks + trow) * 64 + tcol * 2;
          const s16x4 vl = vtr(vp), vh = vtr(vp + 4 * 64);
          const bf16x8 vb = {vl[0], vl[1], vl[2], vl[3], vh[0], vh[1], vh[2], vh[3]};
          S = __builtin_amdgcn_mfma_f32_32x32x16_bf16(ka, vb, S, 0, 0, 0);
      } }
    { const int t = 8 * wid + (lane >> 3), c4 = 4 * (lane & 7);
      if (t < L) {
          f32x4 acc = (f32x4){0.f, 0.f, 0.f, 0.f};
#pragma unroll
          for (int w = 0; w < 8; ++w) acc = acc + *(const LAS f32x4*)(lds + GC_RED + w * 8192 + (t * 32 + c4) * 4);
          bf16* op = OI + (row0 + t) * 2048 + h * 512 + sl * 32 + c4;
          const u32x2 oi = *(const u32x2*)op;
          acc[0] += bflo(oi.x); acc[1] += bfhi(oi.x); acc[2] += bflo(oi.y); acc[3] += bfhi(oi.y);
          u32x2 wv; wv.x = cvtpk(acc[0], acc[1]); wv.y = cvtpk(acc[2], acc[3]); *(u32x2*)op = wv;
      } }
}

struct Args { const float* in[N_IN]; float* out; unsigned char* ws; int ph_lo, ph_hi; };
static_assert(sizeof(Args) == N_IN * 8 + 8 + 8 + 8, "Args has no padding");
constexpr int N_PHASES = 16;

__global__ void __launch_bounds__(NTHR, 2) fwd_kernel(Args args) {
    extern __shared__ __attribute__((aligned(16))) unsigned char lds_raw[];
    const ldsp lds = (ldsp)lds_raw;
    volatile LAS unsigned* MISC = (volatile LAS unsigned*)(lds + MISC_OFF);
    const int tid = threadIdx.x, lane = tid & 63, wid = __builtin_amdgcn_readfirstlane(tid >> 6);
    const int G = gridDim.x, cu = blockIdx.x;
    const int gw = cu * NWAVES + wid, NGW = G * NWAVES;
    unsigned char* ws = args.ws; float* out = args.out;
    gu32* ctl = (gu32*)(ws + WS_CTL);
    for (int u = tid; u < (LDS_BYTES - LDSCTL_OFF) / 4; u += NTHR) ((LAS unsigned*)(lds + LDSCTL_OFF))[u] = 0u;
    __syncthreads();
    XcdBarrier bar; bar.bar = (unsigned*)(ctl + CW_BAR); bar.x = 0; bar.st = nullptr;
    const int lo = args.ph_lo, hi_ph = args.ph_hi;
    const bool multi = (hi_ph - lo) > 1;
    if (multi) bar = xcd_barrier_post((unsigned*)(ctl + CW_BAR), MISC + 8);
#define IN(k) (lo <= (k) && (k) < hi_ph)
#define SEAM(k) do { if (IN(k) && IN((k) + 1)) xcd_barrier(bar); } while (0)

    bf16* const A = (bf16*)(ws + WS_A);
    float* const H = out + O_Y;

    if (IN(0)) {
        LAS float* scr = (LAS float*)(lds + wid * 8448);
        constexpr int I0 = 32 * 352, I1 = 88 * 64, I2 = 32 * 328, I3 = 32 * 64, I4 = 32 * 192, I5 = 16 * 64, I6 = 32 * 64, I7 = 16 * 64, I8 = 32 * 64;
        constexpr int NIT = I0 + I1 + I2 + I3 + I4 + I5 + I6 + I7 + I8;
        for (int it = gw; it < NIT; it += NGW) {
            int r = it;
            if (r < I0) { cvt_item(args.in[I_F1GU], 2048, 2 * DFF, (bf16*)(ws + WS_WGU), 1, 352, r, scr, lane); continue; } r -= I0;
            if (r < I1) { cvt_item(args.in[I_F1D], DFF, DM, (bf16*)(ws + WS_WD), 0, 64, r, scr, lane); continue; } r -= I1;
            if (r < I2) { cvt_item(args.in[I_WIN], 2048, INW, (bf16*)(ws + WS_WIN), 2, 328, r, scr, lane); continue; } r -= I2;
            if (r < I3) { cvt_item(args.in[I_WMEMKV], 2048, 2048, (bf16*)(ws + WS_WIN) + (size_t)10496 * 2048, 0, 64, r, scr, lane); continue; } r -= I3;
            if (r < I4) { cvt_item(args.in[I_WGATE], 2048, 6144, (bf16*)(ws + WS_WGATE), 0, 192, r, scr, lane); continue; } r -= I4;
            if (r < I5) { cvt_item(args.in[I_WSB], 1024, 2048, (bf16*)(ws + WS_WSB), 0, 64, r, scr, lane); continue; } r -= I5;
            if (r < I6) { cvt_item(args.in[I_WGLA], 2048, 2048, (bf16*)(ws + WS_WGLA), 0, 64, r, scr, lane); continue; } r -= I6;
            if (r < I7) { cvt_item(args.in[I_WMEM], 1024, 2048, (bf16*)(ws + WS_WMEM), 0, 64, r, scr, lane); continue; } r -= I7;
            cvt_item(args.in[I_WOUT], 2048, 2048, (bf16*)(ws + WS_WOUT), 0, 64, r, scr, lane);
        }
        f32x4 g1[8], gm[8];
        load_gain(args.in[I_F1PRE], g1, lane); load_gain(args.in[I_MEMNG], gm, lane);
        for (int m = gw; m < MA; m += NGW) {
            if (m < MT) { const float* xr = (m < NPT) ? args.in[I_XP] + (size_t)m * DM : args.in[I_XS] + (size_t)(m - NPT) * DM;
                thin_row<false, false, true>(xr, nullptr, 0.f, g1, nullptr, g1, A + (size_t)m * DM, lane); }
            else thin_row<false, false, true>(args.in[I_MEMP] + (size_t)(m - MT) * DM, nullptr, 0.f, gm, nullptr, gm, A + (size_t)m * DM, lane);
        }
    }
    SEAM(0);
    if (IN(1)) {
        pg8::Gemm g{A, (const bf16*)(ws + WS_WGU), MT, 2 * DFF, DM}; pg8::StaticOrder S; S.init(MT, 2 * DFF, G, cu);
        EpiGU E{(bf16*)(ws + WS_HID)};
        pg8::gemm_phase<EpiGU, pg8::StaticOrder, true, true>(lds, g, S, E);
    }
    SEAM(1);
    if (IN(2)) {
        pg8::Gemm g{(const bf16*)(ws + WS_HID), (const bf16*)(ws + WS_WD), MT, DM, DFF}; pg8::StaticOrder S; S.init(MT, DM, G, cu);
        EpiF32 E{(float*)(ws + WS_F)};
        pg8::gemm_phase<EpiF32, pg8::StaticOrder, true, true>(lds, g, S, E);
    }
    SEAM(2);
    if (IN(3)) {
        f32x4 gp[8], gn[8];
        load_gain(args.in[I_F1POST], gp, lane); load_gain(args.in[I_MIXPRE], gn, lane);
        const float* F = (const float*)(ws + WS_F);
        for (int m = gw; m < MT; m += NGW) {
            const float* xr = (m < NPT) ? args.in[I_XP] + (size_t)m * DM : args.in[I_XS] + (size_t)(m - NPT) * DM;
            thin_row<true, true, true>(xr, F + (size_t)m * DM, 0.5f, gp, H + (size_t)m * DM, gn, A + (size_t)m * DM, lane);
        }
    }
    SEAM(3);
    if (IN(4)) {
        pg8::Gemm g{A, (const bf16*)(ws + WS_WIN), MA, 49 * 256, DM}; OrderIN S; S.init(G, cu);
        EpiIN E{ws, out};
        pg8::gemm_phase<EpiIN, OrderIN, true, true>(lds, g, S, E);
    }
    SEAM(4);
    if (IN(5)) {
        const bf16* SBQ = (const bf16*)(ws + WS_SBQ); const bf16* SBK = (const bf16*)(ws + WS_SBK); const bf16* SBV = (const bf16*)(ws + WS_SBV);
        constexpr int NSBP = NBP * 8 * 32, NSBS = NBS * 8;
        for (int it = cu; it < NSBP; it += G) { const int qb = 31 - (it & 31), bh = it >> 5; sb_unit<false>(lds, bh >> 3, bh & 7, qb, SBQ, SBK, SBV, (bf16*)(ws + WS_SBQ), nullptr, nullptr, tid, wid, lane); }
        for (int it = cu; it < NSBS; it += G) sb_unit<true>(lds, it >> 3, it & 7, 0, SBQ, SBK, SBV, (bf16*)(ws + WS_SBQ), args.in[I_CSBK], args.in[I_CSBV], tid, wid, lane);
        constexpr int NMP = NBP * 4 * 64, NMS = NBS * 4;
        for (int it = cu; it < NMP; it += G) { const int blk = it & 63, bh = it >> 6; mem_unit<false>(lds, bh >> 2, bh & 3, blk, (bf16*)(ws + WS_MQ), (const bf16*)(ws + WS_MKB), (const bf16*)(ws + WS_MVB), nullptr, nullptr, tid, wid, lane); }
        for (int it = cu; it < NMS; it += G) mem_unit<true>(lds, it >> 2, it & 3, 0, (bf16*)(ws + WS_MQ), nullptr, nullptr, args.in[I_CMK], args.in[I_CMV], tid, wid, lane);
        for (int it = cu; it < NCHUNK * 4; it += G) gla_pre_item(lds, it >> 2, it & 3, ws, args.in[I_WA2], args.in[I_BA2], tid, wid, lane);
    }
    SEAM(5);
    if (IN(6)) {
        const int r32 = lane & 31, hi = lane >> 5;
        for (int it = cu; it < NBP * 4 * 16; it += G) {
            const int sl = it & 15, h = (it >> 4) & 3, b = it >> 6;
            f32x16 S;
#pragma unroll
            for (int r = 0; r < 16; ++r) S[r] = 0.f;
            for (int c = 0; c < SEQ / 64; ++c) gla_chain_step(lds, S, (size_t)b * SEQ + c * 64, 64, b * (SEQ / 64) + c, h, sl, ws, tid, wid, lane);
            float* so = out + O_GLA_P + ((size_t)(b * 4 + h) * 256 + 32 * wid) * 512 + sl * 32 + r32;
#pragma unroll
            for (int r = 0; r < 16; ++r) so[(size_t)crow(r, hi) * 512] = S[r];
        }
        for (int it = cu; it < NBS * 4 * 16; it += G) {
            const int sl = it & 15, h = (it >> 4) & 3, b = it >> 6;
            const float* si = args.in[I_SGLA] + ((size_t)(b * 4 + h) * 256 + 32 * wid) * 512 + sl * 32 + r32;
            f32x16 S;
#pragma unroll
            for (int r = 0; r < 16; ++r) S[r] = si[(size_t)crow(r, hi) * 512];
            gla_chain_step(lds, S, (size_t)NPT + b * 32, 32, NPT / 64 + b, h, sl, ws, tid, wid, lane);
            float* so = out + O_GLA_S + ((size_t)(b * 4 + h) * 256 + 32 * wid) * 512 + sl * 32 + r32;
#pragma unroll
            for (int r = 0; r < 16; ++r) so[(size_t)crow(r, hi) * 512] = S[r];
        }
        __syncthreads();
    }
    SEAM(6);
    if (IN(7)) {
        const bf16* OI = (const bf16*)(ws + WS_OINTRA); bf16* GR = (bf16*)(ws + WS_GR);
        f32x4 gg0 = *(const f32x4*)(args.in[I_GLANG] + 8 * lane), gg1 = *(const f32x4*)(args.in[I_GLANG] + 8 * lane + 4);
        for (int m = gw; m < MT; m += NGW) {
#pragma unroll
            for (int hh = 0; hh < 4; ++hh) {
                const size_t o = (size_t)m * 2048 + hh * 512 + 8 * lane;
                const v4u ow = *(const v4u*)(OI + o), rw = *(const v4u*)(GR + o);
                float x[8] = {bflo(ow.x), bfhi(ow.x), bflo(ow.y), bfhi(ow.y), bflo(ow.z), bfhi(ow.z), bflo(ow.w), bfhi(ow.w)};
                const float rr[8] = {bflo(rw.x), bfhi(rw.x), bflo(rw.y), bfhi(rw.y), bflo(rw.z), bfhi(rw.z), bflo(rw.w), bfhi(rw.w)};
                float ss = 0.f;
#pragma unroll
                for (int i = 0; i < 8; ++i) ss += x[i] * x[i];
                const float rs = __builtin_amdgcn_rsqf(wave_sum(ss) * (1.0f / 512.0f) + EPS);
#pragma unroll
                for (int i = 0; i < 8; ++i) x[i] = x[i] * rs * (i < 4 ? gg0[i] : gg1[i - 4]) * rr[i];
                v4u w; w.x = cvtpk(x[0], x[1]); w.y = cvtpk(x[2], x[3]); w.z = cvtpk(x[4], x[5]); w.w = cvtpk(x[6], x[7]);
                *(v4u*)(GR + o) = w;
            }
        }
        pg8::Gemm g{A, (const bf16*)(ws + WS_WGATE), MT, 3 * DM, DM}; pg8::StaticOrder S; S.init(MT, 3 * DM, G, cu);
        EpiGate E{ws, args.in[I_BGATE]};
        pg8::gemm_phase<EpiGate, pg8::StaticOrder, true, true>(lds, g, S, E);
    }
    SEAM(7);
    if (IN(8)) {
        { pg8::Gemm g{(const bf16*)(ws + WS_GR), (const bf16*)(ws + WS_WGLA), MT, DM, 2048}; pg8::StaticOrder S; S.init(MT, DM, G, cu);
          EpiBR<0> E{(const bf16*)(ws + WS_G1), (float*)(ws + WS_MRG), nullptr};
          pg8::gemm_phase<EpiBR<0>, pg8::StaticOrder, true, true>(lds, g, S, E); }
        { pg8::Gemm g{(const bf16*)(ws + WS_SBQ), (const bf16*)(ws + WS_WSB), MT, DM, 1024}; pg8::StaticOrder S; S.init(MT, DM, G, cu);
          EpiBR<1> E{(const bf16*)(ws + WS_G0), (float*)(ws + WS_MRG), nullptr};
          pg8::gemm_phase<EpiBR<1>, pg8::StaticOrder, true, true>(lds, g, S, E); }
    }
    SEAM(8);
    if (IN(9)) {
        pg8::Gemm g{(const bf16*)(ws + WS_MQ), (const bf16*)(ws + WS_WMEM), MT, DM, 1024}; pg8::StaticOrder S; S.init(MT, DM, G, cu);
        EpiBR<2> E{(const bf16*)(ws + WS_G2), (float*)(ws + WS_MRG), (bf16*)(ws + WS_MERGED)};
        pg8::gemm_phase<EpiBR<2>, pg8::StaticOrder, true, true>(lds, g, S, E);
    }
    SEAM(9);
    if (IN(10)) {
        pg8::Gemm g{(const bf16*)(ws + WS_MERGED), (const bf16*)(ws + WS_WOUT), MT, DM, DM}; pg8::StaticOrder S; S.init(MT, DM, G, cu);
        EpiF32 E{(float*)(ws + WS_FO)};
        pg8::gemm_phase<EpiF32, pg8::StaticOrder, true, true>(lds, g, S, E);
    }
    SEAM(10);
    if (IN(11)) {
        LAS float* scr = (LAS float*)(lds + wid * 8448);
        constexpr int I0 = 32 * 352, I1 = 88 * 64;
        for (int it = gw; it < I0 + I1; it += NGW) {
            if (it < I0) cvt_item(args.in[I_F2GU], 2048, 2 * DFF, (bf16*)(ws + WS_WGU), 1, 352, it, scr, lane);
            else cvt_item(args.in[I_F2D], DFF, DM, (bf16*)(ws + WS_WD), 0, 64, it - I0, scr, lane);
        }
        f32x4 gp[8], gn[8];
        load_gain(args.in[I_MIXPOST], gp, lane); load_gain(args.in[I_F2PRE], gn, lane);
        const float* F = (const float*)(ws + WS_FO);
        for (int m = gw; m < MT; m += NGW) thin_row<true, true, true>(H + (size_t)m * DM, F + (size_t)m * DM, 1.0f, gp, H + (size_t)m * DM, gn, A + (size_t)m * DM, lane);
    }
    SEAM(11);
    if (IN(12)) {
        pg8::Gemm g{A, (const bf16*)(ws + WS_WGU), MT, 2 * DFF, DM}; pg8::StaticOrder S; S.init(MT, 2 * DFF, G, cu);
        EpiGU E{(bf16*)(ws + WS_HID)};
        pg8::gemm_phase<EpiGU, pg8::StaticOrder, true, true>(lds, g, S, E);
    }
    SEAM(12);
    if (IN(13)) {
        pg8::Gemm g{(const bf16*)(ws + WS_HID), (const bf16*)(ws + WS_WD), MT, DM, DFF}; pg8::StaticOrder S; S.init(MT, DM, G, cu);
        EpiF32 E{(float*)(ws + WS_F)};
        pg8::gemm_phase<EpiF32, pg8::StaticOrder, true, true>(lds, g, S, E);
    }
    SEAM(13);
    if (IN(14)) {
        f32x4 gp[8];
        load_gain(args.in[I_F2POST], gp, lane);
        const float* F = (const float*)(ws + WS_F);
        for (int m = gw; m < MT; m += NGW) thin_row<true, true, false>(H + (size_t)m * DM, F + (size_t)m * DM, 0.5f, gp, H + (size_t)m * DM, gp, nullptr, lane);
    }
#undef IN
#undef SEAM
}

extern "C" void kernel_launch(void* const* d_in, const int* in_sizes, int n_in, void* d_out, int out_size, void* d_ws, size_t ws_size, hipStream_t stream) {
    static int grid = 0;
    if (grid == 0) {
        if (n_in != N_IN || (size_t)out_size != O_END || ws_size < WS_END) { fprintf(stderr, "kernel_launch: unexpected sizes (n_in %d, out %d, ws %zu)\n", n_in, out_size, ws_size); grid = -1; return; }
        int dev = 0, cus = 0, per_cu = 0;
        if (hipGetDevice(&dev) != hipSuccess || hipDeviceGetAttribute(&cus, hipDeviceAttributeMultiprocessorCount, dev) != hipSuccess) { grid = -1; return; }
        if (hipFuncSetAttribute((const void*)fwd_kernel, hipFuncAttributeMaxDynamicSharedMemorySize, LDS_BYTES) != hipSuccess) { fprintf(stderr, "kernel_launch: hipFuncSetAttribute failed\n"); grid = -1; return; }
        if (hipOccupancyMaxActiveBlocksPerMultiprocessor(&per_cu, (const void*)fwd_kernel, NTHR, LDS_BYTES) != hipSuccess || per_cu < 1) fprintf(stderr, "kernel_launch: occupancy query says %d\n", per_cu);
        (void)hipGetLastError();
        grid = cus;
    }
    if (grid < 0) return;
    (void)hipMemsetAsync((char*)d_ws + WS_CTL, 0, CTL_ZERO_BYTES, stream);
    Args a{};
    for (int i = 0; i < N_IN; ++i) a.in[i] = (const float*)d_in[i];
    a.out = (float*)d_out; a.ws = (unsigned char*)d_ws;
#if MK_ONE_LAUNCH
    a.ph_lo = 0; a.ph_hi = N_PHASES;
    hipLaunchKernelGGL(fwd_kernel, dim3(grid), dim3(NTHR), LDS_BYTES, stream, a);
#else
    for (int p = 0; p < 15; ++p) { a.ph_lo = p; a.ph_hi = p + 1; hipLaunchKernelGGL(fwd_kernel, dim3(grid), dim3(NTHR), LDS_BYTES, stream, a); }
#endif
}
```

```cpp
#include <hip/hip_runtime.h>
#include <cstdio>
#include <cstdint>
#ifndef PROBE_EPI2
#define PROBE_EPI2 0
#endif
namespace pg8 {
#define PG8_LAS __attribute__((address_space(3)))
typedef unsigned short bf16_t;
typedef short bf16x8 __attribute__((ext_vector_type(8)));
typedef float f32x4 __attribute__((ext_vector_type(4)));
typedef unsigned u32x4 __attribute__((ext_vector_type(4)));
constexpr int BM = 256, BK = 64, HALF = 128, HTB = HALF * BK * 2  , STAGE_BYTES = 8 * HTB, NXCD = 8, WGM = 8;

__host__ __device__ __forceinline__ int lds_byte(int r, int c) { const int st = (r >> 4) * 2 + (c >> 5), rr = r & 15, cc = c & 31, ob = rr * 64 + cc * 2; return st * 1024 + (ob ^ (((ob >> 9) & 1) << 5)); }
__host__ __device__ __forceinline__ void stage_rc(int b, int& R, int& C) { const int st = b / 1024, sb = b % 1024, swz = sb ^ (((sb >> 9) & 1) << 5); R = (st >> 1) * 16 + swz / 64; C = (st & 1) * 32 + (swz % 64) / 2; }
__host__ __device__ __forceinline__ int perm32(int rho) { const int n = rho >> 4, i = rho & 15; return 8 * (i >> 2) + 4 * n + (i & 3); }

struct Unit { int pm, pn, kx = 0;
    __host__ __device__ int kt0() const { return kx & 0xfff; } __host__ __device__ int knt() const { return (kx >> 12) & 0xfff; } __host__ __device__ int sl() const { return ((kx >> 24) & 0x3f) - 1; } __host__ __device__ bool alt() const { return (kx >> 30) & 1; } };
struct Gemm { const bf16_t* A; const bf16_t* Bt; int M, N, K; const bf16_t* A2 = nullptr; const bf16_t* Bt2 = nullptr; };

struct StaticOrder {
    int nM, nN, nwg, G, c, wgm;
    __host__ __device__ void init(int M, int N, int G_, int c_, int wgm_ = WGM) { nM = M / BM; nN = N / BM; nwg = nM * nN; G = G_; c = c_; wgm = wgm_; }
    __host__ __device__ bool next(int i, Unit& u) const { return map((long)i * G + c, u); }
    __device__ __forceinline__ int total() const { return nwg; }
    __device__ __forceinline__ bool first(Unit& u) const { return next(0, u); }
    __device__ __forceinline__ bool peek(int i, Unit& u, bool& pend) const { pend = false; return next(i, u); }
    __device__ __forceinline__ bool fetch(Unit&) const { return false; }
    __host__ __device__ bool map(long L, Unit& u) const {
        if (L >= nwg) return false;
        int wgid = (int)L; { const int q = nwg / NXCD, r = nwg % NXCD, xcd = wgid % NXCD, off = wgid / NXCD; wgid = (xcd < r ? xcd * (q + 1) : r * (q + 1) + (xcd - r) * q) + off; }
        const int nig = wgm * nN, gid = wgid / nig, fm = gid * wgm, gsz = (nM - fm) < wgm ? (nM - fm) : wgm;
        u.pm = fm + ((wgid % nig) % gsz); u.pn = (wgid % nig) / gsz; u.kx = 0; return true;
    }
    __device__ __forceinline__ void a_ready(const Unit&) const {}
    __device__ __forceinline__ void done(const Unit&) const {}
};
__device__ __forceinline__ unsigned cvt_pk_bf16(float lo, float hi) { unsigned r; asm volatile("v_cvt_pk_bf16_f32 %0, %1, %2" : "=v"(r) : "v"(lo), "v"(hi)); return r; }
typedef float f32x2 __attribute__((ext_vector_type(2)));
template <class Epi, class Sched, bool ALIGN_EPI = false, bool SP2 = false>
__device__ __forceinline__ void gemm_phase(PG8_LAS unsigned char* lds, const Gemm g, const Sched& S, const Epi& E) {
    const int tid = threadIdx.x, wid = __builtin_amdgcn_readfirstlane(tid >> 6), lane = tid & 63, wr = wid >> 2, wc = wid & 3, fr = lane & 15, fq = lane >> 4;
    const int K = g.K;
    unsigned voffA[2], voffB[2];
#pragma unroll
    for (int i = 0; i < 2; ++i) { int R, C; stage_rc(tid * 16 + i * 8192, R, C); const int Rb = Epi::PERM ? ((R & ~31) + perm32(R & 31)) : R;
        voffA[i] = (unsigned)(R * K + C) * 2u; voffB[i] = (unsigned)(Rb * K + C) * 2u; }
    const size_t kstep = (size_t)(BK * 2);
    const size_t hstep = (size_t)HALF * K * 2;
    const size_t tstep = 2 * hstep;
    const unsigned ldsw = (unsigned)wid * 1024u;
    const int aoff = lds_byte(wr * 64 + fr, fq * 8), boff = lds_byte(wc * 32 + fr, fq * 8);
#define PG8_SA(b, h) (((b) * 2 + (h)) * HTB)
#define PG8_SB(b, h) ((4 + (b) * 2 + (h)) * HTB)
#define PG8_STAGE(bufoff, gbase, voff) do { _Pragma("unroll") for (int _i = 0; _i < 2; ++_i) \
        __builtin_amdgcn_global_load_lds((const unsigned*)((const char*)(gbase) + (voff)[_i]), (PG8_LAS unsigned*)(lds + (bufoff) + ldsw + _i * 8192), 16, 0, 0); } while (0)
#define PG8_LDA(dst, b, h) do { _Pragma("unroll") for (int m = 0; m < 4; ++m) _Pragma("unroll") for (int k = 0; k < 2; ++k) dst[m][k] = *(const PG8_LAS bf16x8*)(lds + PG8_SA(b, h) + aoff + m * 2048 + k * 1024); } while (0)
#define PG8_LDB(dst, b, h) do { _Pragma("unroll") for (int n = 0; n < 2; ++n) _Pragma("unroll") for (int k = 0; k < 2; ++k) dst[n][k] = *(const PG8_LAS bf16x8*)(lds + PG8_SB(b, h) + boff + n * 2048 + k * 1024); } while (0)
#define PG8_MMA(ai, bj, At, Bt) do { __builtin_amdgcn_s_setprio(1); _Pragma("unroll") for (int m = 0; m < 4; ++m) _Pragma("unroll") for (int n = 0; n < 2; ++n) _Pragma("unroll") for (int k = 0; k < 2; ++k) \
        acc[ai][bj][m][n] = __builtin_amdgcn_mfma_f32_16x16x32_bf16(Bt[n][k], At[m][k], acc[ai][bj][m][n], 0, 0, 0); __builtin_amdgcn_s_setprio(0); } while (0)
#define PG8_WAIT_V(n) asm volatile("s_waitcnt vmcnt(" #n ")" ::: "memory")
#define PG8_WAIT_L(n) asm volatile("s_waitcnt lgkmcnt(" #n ")" ::: "memory")
#define PG8_BAR __builtin_amdgcn_s_barrier()
#define PG8_SCHED __builtin_amdgcn_sched_barrier(0)
    Unit cur, nxt; int ui = 0;
    if (!S.first(cur)) return;
    f32x4 acc[2][2][4][2];
#pragma unroll
    for (int a = 0; a < 2; ++a)
#pragma unroll
        for (int b = 0; b < 2; ++b)
#pragma unroll
            for (int m = 0; m < 4; ++m)
#pragma unroll
                for (int n = 0; n < 2; ++n) acc[a][b][m][n] = (f32x4){0.f, 0.f, 0.f, 0.f};
    bf16x8 At[4][2], B0[2][2], B1[2][2];
#define PG8_ABASE(u) ((const char*)((u).alt() ? g.A2 : g.A) + (size_t)(u).pm * tstep + (size_t)(u).kt0() * (BK * 2))
#define PG8_BBASE(u) ((const char*)((u).alt() ? g.Bt2 : g.Bt) + (size_t)(u).pn * tstep + (size_t)(u).kt0() * (BK * 2))
#define PG8_NT(u) ((u).knt() ? (u).knt() : K / BK)
    const char* cA = PG8_ABASE(cur); const char* cB = PG8_BBASE(cur);
    int nt = PG8_NT(cur);
    S.a_ready(cur);
    if constexpr (SP2) {
        PG8_STAGE(PG8_SB(0, 0), cB, voffB); PG8_STAGE(PG8_SB(0, 1), cB + hstep, voffB); PG8_STAGE(PG8_SA(0, 0), cA, voffA); PG8_STAGE(PG8_SA(0, 1), cA + hstep, voffA);
        if (wr == 1) PG8_BAR;
        PG8_WAIT_V(2); PG8_BAR;
        PG8_STAGE(PG8_SB(1, 0), cB + kstep, voffB); PG8_STAGE(PG8_SA(1, 0), cA + kstep, voffA); PG8_STAGE(PG8_SB(1, 1), cB + hstep + kstep, voffB);
        PG8_WAIT_V(6); PG8_BAR;
    } else {
        PG8_STAGE(PG8_SB(0, 0), cB, voffB); PG8_STAGE(PG8_SA(0, 0), cA, voffA); PG8_STAGE(PG8_SB(0, 1), cB + hstep, voffB); PG8_STAGE(PG8_SA(0, 1), cA + hstep, voffA);
        if (wr == 1) PG8_BAR;
        PG8_WAIT_V(4); PG8_BAR;
        PG8_STAGE(PG8_SB(1, 0), cB + kstep, voffB); PG8_STAGE(PG8_SA(1, 0), cA + kstep, voffA); PG8_STAGE(PG8_SB(1, 1), cB + hstep + kstep, voffB);
        PG8_WAIT_V(6); PG8_BAR;
    }
    for (;;) {
        bool pend = false; bool has_next = S.peek(ui + 1, nxt, pend);
        const char* nA = has_next ? PG8_ABASE(nxt) : cA; const char* nB = has_next ? PG8_BBASE(nxt) : cB;
        const int tf = nt > 4 ? nt - 4 : 0;
        for (int t = 0; t < nt; t += 2) {
            if (pend && t == tf) {
                pend = false; has_next = S.fetch(nxt);
                if (has_next) { nA = PG8_ABASE(nxt); nB = PG8_BBASE(nxt); }
            }
            const bool last = (t == nt - 2);
            const char* a1 = cA + (size_t)(t + 1) * kstep;
            const char* a2 = last ? nA : cA + (size_t)(t + 2) * kstep; const char* b2 = last ? nB : cB + (size_t)(t + 2) * kstep;
            const char* a3 = a2 + kstep; const char* b3 = b2 + kstep;
            if (last && has_next) S.a_ready(nxt);
            if constexpr (SP2) {
            PG8_LDB(B0, 0, 0); PG8_LDB(B1, 0, 1); PG8_SCHED; PG8_LDA(At, 0, 0); PG8_STAGE(PG8_SA(1, 1), a1 + hstep, voffA);
            PG8_WAIT_V(8); PG8_WAIT_L(0); PG8_BAR; PG8_MMA(0, 0, At, B0); PG8_MMA(0, 1, At, B1); PG8_BAR; PG8_SCHED;
            PG8_LDA(At, 0, 1); PG8_STAGE(PG8_SB(0, 0), b2, voffB); PG8_STAGE(PG8_SB(0, 1), b2 + hstep, voffB); PG8_STAGE(PG8_SA(0, 0), a2, voffA);
            PG8_WAIT_V(8); PG8_WAIT_L(0); PG8_BAR; PG8_MMA(1, 0, At, B0); PG8_MMA(1, 1, At, B1); PG8_BAR; PG8_SCHED;
            PG8_LDB(B0, 1, 0); PG8_LDB(B1, 1, 1); PG8_SCHED; PG8_LDA(At, 1, 0); PG8_STAGE(PG8_SA(0, 1), a2 + hstep, voffA);
            PG8_WAIT_V(8); PG8_WAIT_L(0); PG8_BAR; PG8_MMA(0, 0, At, B0); PG8_MMA(0, 1, At, B1); PG8_BAR; PG8_SCHED;
            PG8_LDA(At, 1, 1); PG8_STAGE(PG8_SB(1, 0), b3, voffB); PG8_STAGE(PG8_SB(1, 1), b3 + hstep, voffB); PG8_STAGE(PG8_SA(1, 0), a3, voffA);
            PG8_WAIT_V(8); PG8_WAIT_L(0); PG8_BAR; PG8_MMA(1, 0, At, B0); PG8_MMA(1, 1, At, B1); PG8_BAR; PG8_SCHED;
            } else {
            PG8_LDB(B0, 0, 0); PG8_SCHED; PG8_LDA(At, 0, 0); PG8_STAGE(PG8_SA(1, 1), a1 + hstep, voffA);
            PG8_WAIT_L(8); PG8_BAR; PG8_WAIT_L(0); PG8_MMA(0, 0, At, B0); PG8_BAR; PG8_SCHED;
            PG8_LDB(B1, 0, 1); PG8_STAGE(PG8_SB(0, 0), b2, voffB);
            PG8_BAR; PG8_WAIT_L(0); PG8_MMA(0, 1, At, B1); PG8_BAR;
            PG8_LDA(At, 0, 1); PG8_STAGE(PG8_SA(0, 0), a2, voffA);
            PG8_BAR; PG8_WAIT_L(0); PG8_MMA(1, 0, At, B0); PG8_BAR; PG8_SCHED;
            PG8_STAGE(PG8_SB(0, 1), b2 + hstep, voffB);
            PG8_WAIT_V(6); PG8_BAR; PG8_MMA(1, 1, At, B1); PG8_BAR;
            PG8_LDB(B0, 1, 0); PG8_SCHED; PG8_LDA(At, 1, 0); PG8_STAGE(PG8_SA(0, 1), a2 + hstep, voffA);
            PG8_WAIT_L(8); PG8_BAR; PG8_WAIT_L(0); PG8_MMA(0, 0, At, B0); PG8_BAR; PG8_SCHED;
            PG8_LDB(B1, 1, 1); PG8_STAGE(PG8_SB(1, 0), b3, voffB);
            PG8_BAR; PG8_WAIT_L(0); PG8_MMA(0, 1, At, B1); PG8_BAR;
            PG8_LDA(At, 1, 1); PG8_STAGE(PG8_SA(1, 0), a3, voffA);
            PG8_BAR; PG8_WAIT_L(0); PG8_MMA(1, 0, At, B0); PG8_BAR; PG8_SCHED;
            PG8_STAGE(PG8_SB(1, 1), b3 + hstep, voffB);
            PG8_WAIT_V(6); PG8_BAR; PG8_MMA(1, 1, At, B1); PG8_BAR;
            }
        }
        if constexpr (ALIGN_EPI) { if (wr == 0) PG8_BAR; }
        if constexpr (!Epi::AFTER_DRAIN) { E(acc, cur, wr, wc, fr, fq);
#if PROBE_EPI2
            if constexpr (Epi::IDEMP) { asm volatile("" ::: "memory"); E(acc, cur, wr, wc, fr, fq); }
#endif
            S.done(cur); }
        if (!has_next) break;
#pragma unroll
        for (int a = 0; a < 2; ++a)
#pragma unroll
            for (int b = 0; b < 2; ++b)
#pragma unroll
                for (int m = 0; m < 4; ++m)
#pragma unroll
                    for (int n = 0; n < 2; ++n) acc[a][b][m][n] = (f32x4){0.f, 0.f, 0.f, 0.f};
        cur = nxt; cA = nA; cB = nB; ++ui; nt = PG8_NT(cur);
        if constexpr (ALIGN_EPI) { if (wr == 1) PG8_BAR; }
    }
    PG8_WAIT_V(0);
    if constexpr (!ALIGN_EPI) { if (wr == 0) PG8_BAR; }
    PG8_BAR;
    if constexpr (Epi::AFTER_DRAIN) { E.fused(acc, cur, wr, wc, fr, fq, lds, wid, lane); S.done(cur); }
#undef PG8_ABASE
#undef PG8_BBASE
#undef PG8_NT
#undef PG8_SA
#undef PG8_SB
#undef PG8_STAGE
#undef PG8_LDA
#undef PG8_LDB
#undef PG8_MMA
#undef PG8_WAIT_V
#undef PG8_WAIT_L
#undef PG8_BAR
#undef PG8_SCHED
}
}
#define GAS __attribute__((address_space(1)))
#define LAS __attribute__((address_space(3)))
typedef unsigned short bf16;
typedef unsigned v4u __attribute__((ext_vector_type(4)));
typedef float f32x4 __attribute__((ext_vector_type(4)));
typedef short bf16x8 __attribute__((ext_vector_type(8)));
typedef GAS unsigned gu32;
typedef GAS unsigned long long gu64;
#define RLX_AGENT __ATOMIC_RELAXED, __HIP_MEMORY_SCOPE_AGENT
#define LDS_WAIT() asm volatile("s_waitcnt lgkmcnt(0)" ::: "memory")
#define VM_WAIT() asm volatile("s_waitcnt vmcnt(0)" ::: "memory")
__device__ __forceinline__ unsigned long long rt() { return __builtin_amdgcn_s_memrealtime(); }
__device__ __forceinline__ unsigned f2bf(float f) { unsigned u = __builtin_bit_cast(unsigned, f); return (u + 0x7fffu + ((u >> 16) & 1u)) >> 16; }
__device__ __forceinline__ unsigned pk2(float lo, float hi) { return f2bf(lo) | (f2bf(hi) << 16); }

#define XB_TMO      128
#define XB_XCNT(j)  (256  + 64 * (j))
#define XB_XSUB(j)  (1280 + 64 * (j))
#define XB_XGEN(j)  (2304 + 64 * (j))
#define XB_TOP      3328
#define XB_TOPGEN   3392
#define XCD_BAR_WORDS 3456
#define XB_SPIN_CAP (1u << 18)

__device__ __forceinline__ unsigned xb_ld(unsigned* p)              { return __hip_atomic_load(p, __ATOMIC_RELAXED, __HIP_MEMORY_SCOPE_AGENT); }
__device__ __forceinline__ unsigned xb_add(unsigned* p, unsigned v) { return __hip_atomic_fetch_add(p, v, __ATOMIC_RELAXED, __HIP_MEMORY_SCOPE_AGENT); }
__device__ __forceinline__ unsigned xb_xcc_id() { return (unsigned)__builtin_amdgcn_s_getreg((3 << 11) | 20) & 0xFu; }
#define XB_SPIN(cond, bar) do { unsigned _sp = 0; while (cond) { __builtin_amdgcn_s_sleep(1); \
    if ((++_sp & 255u) == 0u) { if (xb_ld(&(bar)[XB_TMO])) break; if (_sp > XB_SPIN_CAP) { atomicAdd(&(bar)[XB_TMO], 1u); break; } } } } while (0)

struct XcdBarrier {
    unsigned* bar; unsigned x;
    volatile LAS unsigned* st;
};

__device__ __forceinline__ XcdBarrier xcd_barrier_post(unsigned* bar, volatile LAS unsigned* st) {
    XcdBarrier b; b.bar = bar; b.x = xb_xcc_id(); b.st = st;
    if (threadIdx.x == 0) (void)xb_add(&bar[XB_XCNT(b.x)], 1u);
    return b;
}
__device__ __forceinline__ void xcd_barrier_complete(unsigned* bar, unsigned x, unsigned& nloc, unsigned& nx) {
    const unsigned G = gridDim.x * gridDim.y * gridDim.z;
    unsigned sum, cnt, mine, sp = 0u;
    for (;;) {
        sum = 0u; cnt = 0u; mine = 0u;
#pragma unroll
        for (unsigned j = 0; j < 16; ++j) { const unsigned c = xb_ld(&bar[XB_XCNT(j)]); sum += c; cnt += (c > 0u) ? 1u : 0u; mine = (j == x) ? c : mine; }
        if (sum == G) break;
        __builtin_amdgcn_s_sleep(1);
        if ((++sp & 255u) == 0u) { if (xb_ld(&bar[XB_TMO])) break; if (sp > XB_SPIN_CAP) { atomicAdd(&bar[XB_TMO], 1u); break; } }
    }
    nloc = mine > 0u ? mine : 1u; nx = cnt > 0u ? cnt : 1u;
}

__device__ __forceinline__ void xcd_barrier(const XcdBarrier& b) {
    asm volatile("s_waitcnt vmcnt(0)" ::: "memory");
    __syncthreads();
    if (threadIdx.x == 0) {
        unsigned* bar = b.bar;
        __builtin_amdgcn_s_waitcnt(0);
        unsigned nloc = b.st[0], nx = b.st[1];
        if (nloc == 0u) { xcd_barrier_complete(bar, b.x, nloc, nx); b.st[0] = nloc; b.st[1] = nx; }
        const unsigned old = xb_add(&bar[XB_XSUB(b.x)], 1u);
        const unsigned gen = old / nloc;
        if (old + 1u == (gen + 1u) * nloc) {
            __builtin_amdgcn_fence(__ATOMIC_RELEASE, "agent");
            asm volatile("s_waitcnt vmcnt(0)" ::: "memory");
            const unsigned og = xb_add(&bar[XB_TOP], 1u);
            const unsigned tg = og / nx;
            if (og + 1u == (tg + 1u) * nx) xb_add(&bar[XB_TOPGEN], 1u);
            else XB_SPIN(xb_ld(&bar[XB_TOPGEN]) == tg, bar);
            __builtin_amdgcn_fence(__ATOMIC_ACQUIRE, "agent");
            xb_add(&bar[XB_XGEN(b.x)], 1u);
            asm volatile("s_waitcnt vmcnt(0)" ::: "memory");
        } else {
            XB_SPIN(xb_ld(&bar[XB_XGEN(b.x)]) == gen, bar);
            __builtin_amdgcn_fence(__ATOMIC_ACQUIRE, "agent");
            asm volatile("s_waitcnt vmcnt(0)" ::: "memory");
        }
    }
    __syncthreads();
}

typedef float f32x16 __attribute__((ext_vector_type(16)));
typedef float f32x2v __attribute__((ext_vector_type(2)));
typedef short s16x4 __attribute__((ext_vector_type(4)));
typedef short v4i16_t __attribute__((ext_vector_type(4)));
typedef unsigned u32x2 __attribute__((ext_vector_type(2)));
typedef LAS unsigned char* ldsp;
typedef const LAS unsigned char* ldscp;

constexpr int NWAVES = 8, NTHR = 512;
#ifndef MK_ONE_LAUNCH
#define MK_ONE_LAUNCH 1
#endif

constexpr int DM = 2048, DFF = 5632, SEQ = 8192, NBP = 4, NPT = NBP * SEQ, NBS = 32, DSEQ = 32, NST = NBS * DSEQ, PAST = 1024;
constexpr int MT = NPT + NST;
constexpr int MEMR = 1024, MA = MT + MEMR;
constexpr int INW = 10256;
constexpr int NCHUNK = NPT / 64 + NBS;
constexpr float EPS = 1e-6f, LOG2E = 1.4426950408889634f, LN2 = 0.6931471805599453f;
constexpr float C_SB = 0.08838834764831845f * LOG2E;
constexpr float C_MEM = 0.0625f * LOG2E;
constexpr float C_GQ = 0.0625f;
constexpr float SB_THR = 8.470329472543003e-22f;

enum { I_XP = 0, I_XS, I_MEMP, I_CSBK, I_CSBV, I_SGLA, I_CMK, I_CMV, I_F1PRE, I_F1GU, I_F1D, I_F1POST, I_MIXPRE, I_WIN, I_WA2, I_BA2, I_GLANG, I_MEMNG,
       I_WMEMKV, I_WSB, I_WGLA, I_WMEM, I_WGATE, I_BGATE, I_WOUT, I_MIXPOST, I_F2PRE, I_F2GU, I_F2D, I_F2POST, N_IN };
constexpr size_t O_Y = 0, O_SBK_P = (size_t)MT * DM, O_SBV_P = O_SBK_P + (size_t)NPT * 1024, O_GLA_P = O_SBV_P + (size_t)NPT * 1024,
                 O_MEMK_P = O_GLA_P + (size_t)NBP * 4 * 256 * 512, O_MEMV_P = O_MEMK_P + (size_t)MEMR * 1024, O_SBK_S = O_MEMV_P + (size_t)MEMR * 1024,
                 O_SBV_S = O_SBK_S + (size_t)NST * 1024, O_GLA_S = O_SBV_S + (size_t)NST * 1024, O_END = O_GLA_S + (size_t)NBS * 4 * 256 * 512;
static_assert(O_END == 159383552ull, "d_out size");

constexpr size_t MiB = 1ull << 20;
constexpr size_t WS_CTL = 0, CTL_ZERO_BYTES = 1 * MiB;
constexpr size_t WS_WGU = 1 * MiB;
constexpr size_t WS_WD = 45 * MiB;
constexpr size_t WS_WIN = 67 * MiB;
constexpr size_t WS_WGATE = 116 * MiB;
constexpr size_t WS_WSB = 140 * MiB, WS_WGLA = 144 * MiB, WS_WMEM = 152 * MiB, WS_WOUT = 156 * MiB;
constexpr size_t WS_A = 164 * MiB;
constexpr size_t WS_HID = 300 * MiB;
constexpr size_t WS_F = 663 * MiB;
constexpr size_t WS_OINTRA = 300 * MiB;
constexpr size_t WS_SBQ = 432 * MiB, WS_SBK = 498 * MiB, WS_SBV = 564 * MiB, WS_GQ = 630 * MiB, WS_GK = 696 * MiB, WS_GV = 762 * MiB, WS_GR = 894 * MiB, WS_MQ = 1026 * MiB;
constexpr size_t WS_GA = 1092 * MiB;
constexpr size_t WS_EB = 1095 * MiB;
constexpr size_t WS_MKB = 1098 * MiB, WS_MVB = 1100 * MiB, WS_END = 1110 * MiB;
constexpr size_t WS_MRG = 164 * MiB;
constexpr size_t WS_G0 = WS_SBK, WS_G1 = WS_GQ, WS_G2 = WS_GV;
constexpr size_t WS_MERGED = WS_OINTRA;
constexpr size_t WS_FO = 762 * MiB;
static_assert(WS_A + (size_t)MA * DM * 2 <= WS_HID && WS_HID + (size_t)MT * DFF * 2 <= WS_F && WS_F + (size_t)MT * DM * 4 <= WS_GA, "ws map 1");
static_assert(WS_OINTRA + (size_t)MT * DM * 2 <= WS_SBQ && WS_MQ + (size_t)MT * 1024 * 2 <= WS_GA && WS_GA + (size_t)MT * 64 <= WS_EB && WS_EB + (size_t)NCHUNK * 4096 <= WS_MKB, "ws map 2");
static_assert(WS_MRG + (size_t)MT * DM * 4 <= WS_SBQ && WS_FO + (size_t)MT * DM * 4 <= WS_MQ && WS_WIN + 12544ull * 4096 <= WS_WGATE && WS_WGU + 11264ull * 4096 <= WS_WD && WS_WD + 2048ull * 11264 <= WS_WIN, "ws map 3");
constexpr size_t FRAG_KETF = (size_t)MT * DM, FRAG_QEF = FRAG_KETF + 512ull * 4 * 16384;
constexpr size_t WS_KETF_S = 1102 * MiB, WS_QEF_S = 1106 * MiB;
static_assert((FRAG_QEF + 512ull * 4 * 16384) * 2 <= (size_t)MT * DM * 4, "fragment buffers fit in the y rows");
constexpr size_t WS_H2 = 894 * MiB;
constexpr size_t WS_SLAB_F = 1026 * MiB;
constexpr size_t WS_SLAB_O = 1026 * MiB;
static_assert(WS_SLAB_F + 8ull * NST * DM * 4 <= WS_GA && WS_SLAB_O + 8ull * NST * DM * 4 <= WS_GA && WS_F + (size_t)MT * DM * 2 <= WS_H2 && WS_FO + (size_t)MT * DM * 2 <= WS_H2 && WS_H2 + (size_t)MT * DM * 2 <= WS_SLAB_F && WS_HID + (size_t)MT * DFF * 2 <= WS_F, "slabs / H2");
constexpr int CW_TMO = 0, CW_BAR = 4096, CW_Q = 32768, CW_ITEM = 65536, CW_IRS0 = 98304, CW_IRS1 = 163840, CW_IRS2 = 198656;

constexpr int LDS_BYTES = 155648;
constexpr int LDSCTL_OFF = 151552;
constexpr int MISC_OFF = LDSCTL_OFF + 320;

__device__ __forceinline__ float wave_sum(float v) {
#pragma unroll
    for (int o = 1; o < 64; o <<= 1) v += __shfl_xor(v, o);
    return v;
}
__device__ __forceinline__ float fexp2(float x) { return __builtin_amdgcn_exp2f(x); }
__device__ __forceinline__ float flog2(float x) { return __builtin_amdgcn_logf(x); }
__device__ __forceinline__ float frcp(float x) { return __builtin_amdgcn_rcpf(x); }
__device__ __forceinline__ float sigmoidf_(float x) { return frcp(1.0f + fexp2(-x * LOG2E)); }
typedef __bf16 bf16x2_t __attribute__((ext_vector_type(2)));
__device__ __forceinline__ unsigned cvtpk(float lo, float hi) { f32x2v v = {lo, hi}; bf16x2_t b = __builtin_convertvector(v, bf16x2_t); return __builtin_bit_cast(unsigned, b); }
__device__ __forceinline__ float bf2f(unsigned short b) { return __uint_as_float(((unsigned)b) << 16); }
__device__ __forceinline__ float bflo(unsigned w) { return __uint_as_float(w << 16); }
__device__ __forceinline__ float bfhi(unsigned w) { return __uint_as_float(w & 0xffff0000u); }
__device__ __forceinline__ s16x4 vtr(ldscp p) { return __builtin_bit_cast(s16x4, __builtin_amdgcn_ds_read_tr16_b64_v4i16((LAS v4i16_t*)p)); }
__device__ __forceinline__ int crow(int r, int hi) { return (r & 3) + 8 * (r >> 2) + 4 * hi; }
__device__ __forceinline__ bf16x8 ld8_bf(const bf16* p) { return *(const bf16x8*)p; }
__device__ __forceinline__ bf16x8 ld8_f32(const float* p) { const f32x4 a = *(const f32x4*)p, b = *(const f32x4*)(p + 4); v4u w = {cvtpk(a.x, a.y), cvtpk(a.z, a.w), cvtpk(b.x, b.y), cvtpk(b.z, b.w)}; return __builtin_bit_cast(bf16x8, w); }
#define PK4(P, BASE, OUT) do { unsigned a0_ = cvtpk(P[BASE + 0], P[BASE + 1]), a1_ = cvtpk(P[BASE + 2], P[BASE + 3]); \
    unsigned b0_ = cvtpk(P[BASE + 4], P[BASE + 5]), b1_ = cvtpk(P[BASE + 6], P[BASE + 7]); \
    auto r0_ = __builtin_amdgcn_permlane32_swap(a0_, b0_, false, false); auto r1_ = __builtin_amdgcn_permlane32_swap(a1_, b1_, false, false); \
    v4u w_ = {r0_[0], r1_[0], r0_[1], r1_[1]}; OUT = __builtin_bit_cast(bf16x8, w_); } while (0)

__device__ __forceinline__ void cvt_block(const float* W, int ldw, int k0, int srccol, int nvalid, bf16* WT, int K, int dstrow, LAS float* scr, int lane, const float* kgain = nullptr) {
    const int n = lane & 31;
#pragma unroll 8
    for (int i = 0; i < 32; ++i) { const int kk = 2 * i + (lane >> 5); scr[kk * 33 + n] = (n < nvalid) ? __builtin_nontemporal_load(W + (size_t)(k0 + kk) * ldw + srccol + n) : 0.f; }
    LDS_WAIT(); asm volatile("" ::: "memory");
    const int c = lane & 7;
    f32x4 ga = {1.f, 1.f, 1.f, 1.f}, gb = ga;
    if (kgain) { ga = *(const f32x4*)(kgain + k0 + 8 * c); gb = *(const f32x4*)(kgain + k0 + 8 * c + 4); }
#pragma unroll
    for (int j = 0; j < 4; ++j) { const int nn = (lane >> 3) + 8 * j; const LAS float* s = scr + (8 * c) * 33 + nn;
        v4u o; o.x = cvtpk(s[0 * 33] * ga.x, s[1 * 33] * ga.y); o.y = cvtpk(s[2 * 33] * ga.z, s[3 * 33] * ga.w); o.z = cvtpk(s[4 * 33] * gb.x, s[5 * 33] * gb.y); o.w = cvtpk(s[6 * 33] * gb.z, s[7 * 33] * gb.w);
        *(v4u*)(WT + (size_t)(dstrow + nn) * K + k0 + 8 * c) = o; }
    LDS_WAIT(); asm volatile("" ::: "memory");
}
__device__ __forceinline__ void cvt_item(const float* W, int K, int ldw, bf16* WT, int mode, int nblk, int item, LAS float* scr, int lane, const float* kgain = nullptr) {
    const int kb = item / nblk, db = item - kb * nblk; int src = 32 * db, nvalid = 32;
    if (mode == 1) { const int t = db >> 3, j = db & 7; src = (j < 4) ? 128 * t + 32 * j : DFF + 128 * t + 32 * (j - 4); }
    if (mode == 2) { if (db >= 288 && db < 320) src = 9232 + 32 * (db - 288); else if (db == 320) { src = 9216; nvalid = 16; } else if (db > 320) { src = 0; nvalid = 0; } }
    cvt_block(W, ldw, 64 * kb, src, nvalid, WT, K, 32 * db, scr, lane, kgain);
}

__device__ __forceinline__ void load_gain(const float* g, f32x4 (&v)[8], int lane) {
#pragma unroll
    for (int j = 0; j < 8; ++j) v[j] = *(const f32x4*)(g + 4 * lane + 256 * j);
}
template <bool HAS_F, bool ST_H, bool ST_A, int NF = 1, bool BASE_BF = false, bool HOUT_BF = false, bool ST_N = false>
__device__ __forceinline__ void thin_row(const void* basev, const void* fsrc, float s, const f32x4 (&gpost)[8], void* houtv, const f32x4 (&gpre)[8], bf16* aout, int lane, bool wr = true, float* rout = nullptr, float bscale = 1.0f) {
    f32x4 h[8];
    if constexpr (BASE_BF) { const bf16* bb = (const bf16*)basev;
#pragma unroll
        for (int j = 0; j < 8; ++j) { const u32x2 w = __builtin_nontemporal_load((const u32x2*)(bb + 4 * lane + 256 * j)); h[j] = (f32x4){bflo(w.x), bfhi(w.x), bflo(w.y), bfhi(w.y)} * bscale; } }
    else { const float* base = (const float*)basev;
#pragma unroll
        for (int j = 0; j < 8; ++j) h[j] = __builtin_nontemporal_load((const f32x4*)(base + 4 * lane + 256 * j)); }
    if (HAS_F) {
        f32x4 fv[8]; float ss = 0.f;
        if constexpr (NF == 1) {
            const bf16* fb = (const bf16*)fsrc;
#pragma unroll
            for (int j = 0; j < 8; ++j) { const u32x2 w = __builtin_nontemporal_load((const u32x2*)(fb + 4 * lane + 256 * j)); fv[j] = (f32x4){bflo(w.x), bfhi(w.x), bflo(w.y), bfhi(w.y)}; }
        } else {
            const float* f = (const float*)fsrc;
#pragma unroll
            for (int j = 0; j < 8; ++j) fv[j] = __builtin_nontemporal_load((const f32x4*)(f + 4 * lane + 256 * j));
#pragma unroll 1
            for (int k = 1; k < NF; ++k) {
#pragma unroll
                for (int j = 0; j < 8; ++j) fv[j] = fv[j] + __builtin_nontemporal_load((const f32x4*)(f + (size_t)k * NST * DM + 4 * lane + 256 * j)); }
        }
#pragma unroll
        for (int j = 0; j < 8; ++j) ss += (fv[j].x * fv[j].x + fv[j].y * fv[j].y) + (fv[j].z * fv[j].z + fv[j].w * fv[j].w);
        const float r = s * __builtin_amdgcn_rsqf(wave_sum(ss) * (1.0f / DM) + EPS);
#pragma unroll
        for (int j = 0; j < 8; ++j) h[j] = h[j] + fv[j] * gpost[j] * r;
    }
    if (ST_H && wr) {
        if constexpr (HOUT_BF) { bf16* hb = (bf16*)houtv;
#pragma unroll
            for (int j = 0; j < 8; ++j) { u32x2 w; w.x = cvtpk(h[j].x, h[j].y); w.y = cvtpk(h[j].z, h[j].w); __builtin_nontemporal_store(w, (u32x2*)(hb + 4 * lane + 256 * j)); } }
        else { float* hout = (float*)houtv;
#pragma unroll
            for (int j = 0; j < 8; ++j) __builtin_nontemporal_store(h[j], (f32x4*)(hout + 4 * lane + 256 * j)); }
    }
    if constexpr (ST_N) {
        float ss = 0.f;
#pragma unroll
        for (int j = 0; j < 8; ++j) ss += (h[j].x * h[j].x + h[j].y * h[j].y) + (h[j].z * h[j].z + h[j].w * h[j].w);
        const float ms = wave_sum(ss) * (1.0f / DM) + EPS, r = __builtin_amdgcn_rsqf(ms);
        if (wr) {
#pragma unroll
            for (int j = 0; j < 8; ++j) { const f32x4 a = h[j] * r; u32x2 w; w.x = cvtpk(a.x, a.y); w.y = cvtpk(a.z, a.w); *(u32x2*)(aout + 4 * lane + 256 * j) = w; }
            if (lane == 0) *rout = ms * r;
        }
    }
    if (ST_A) {
        float ss = 0.f;
#pragma unroll
        for (int j = 0; j < 8; ++j) ss += (h[j].x * h[j].x + h[j].y * h[j].y) + (h[j].z * h[j].z + h[j].w * h[j].w);
        const float r = __builtin_amdgcn_rsqf(wave_sum(ss) * (1.0f / DM) + EPS);
#pragma unroll
        for (int j = 0; j < 8; ++j) { const f32x4 a = h[j] * gpre[j] * r; u32x2 w; w.x = cvtpk(a.x, a.y); w.y = cvtpk(a.z, a.w); *(u32x2*)(aout + 4 * lane + 256 * j) = w; }
    }
}

#ifndef PROBE_EPI2
#define PROBE_EPI2 0
#endif
struct EpiGU {
    static constexpr bool PERM = true, AFTER_DRAIN = false, IDEMP = (PROBE_EPI2 == 1);
    bf16* H;
    __device__ __forceinline__ void operator()(const pg8::f32x4 (&acc)[2][2][4][2], const pg8::Unit& u, int wr, int wc, int fr, int fq) const {
        const int row0 = u.pm * 256 + wr * 64 + fr, col0 = u.pn * 128 + wc * 32 + 8 * fq;
#pragma unroll
        for (int ai = 0; ai < 2; ++ai)
#pragma unroll
            for (int m = 0; m < 4; ++m) {
                float o[8];
#pragma unroll
                for (int n = 0; n < 2; ++n)
#pragma unroll
                    for (int i = 0; i < 4; ++i) { const float g = acc[ai][0][m][n][i], uu = acc[ai][1][m][n][i]; o[4 * n + i] = g * uu * frcp(1.0f + fexp2(-g * LOG2E)); }
                v4u w; w.x = cvtpk(o[0], o[1]); w.y = cvtpk(o[2], o[3]); w.z = cvtpk(o[4], o[5]); w.w = cvtpk(o[6], o[7]);
                *(v4u*)(H + (size_t)(row0 + ai * 128 + m * 16) * DFF + col0) = w;
            }
    }
};
struct EpiF32 {
    static constexpr bool PERM = false, AFTER_DRAIN = false, IDEMP = (PROBE_EPI2 == 2);
    bf16* C; float* SLAB;
    __device__ __forceinline__ void operator()(const pg8::f32x4 (&acc)[2][2][4][2], const pg8::Unit& u, int wr, int wc, int fr, int fq) const {
        const int row0 = u.pm * 256 + wr * 64 + fr, col0 = u.pn * 256 + wc * 32 + 4 * fq;
        if (u.kx == 0) {
#pragma unroll
            for (int ai = 0; ai < 2; ++ai)
#pragma unroll
                for (int m = 0; m < 4; ++m) { bf16* rowp = C + (size_t)(row0 + ai * 128 + m * 16) * DM + col0;
#pragma unroll
                    for (int bj = 0; bj < 2; ++bj)
#pragma unroll
                        for (int n = 0; n < 2; ++n) { const pg8::f32x4 v = acc[ai][bj][m][n]; u32x2 w; w.x = cvtpk(v[0], v[1]); w.y = cvtpk(v[2], v[3]); *(u32x2*)(rowp + bj * 128 + n * 16) = w; } }
        } else {
            float* base = SLAB + (size_t)u.sl() * NST * DM - (size_t)NPT * DM;
#pragma unroll
            for (int ai = 0; ai < 2; ++ai)
#pragma unroll
                for (int m = 0; m < 4; ++m) { float* rowp = base + (size_t)(row0 + ai * 128 + m * 16) * DM + col0;
#pragma unroll
                    for (int bj = 0; bj < 2; ++bj)
#pragma unroll
                        for (int n = 0; n < 2; ++n) *(pg8::f32x4*)(rowp + bj * 128 + n * 16) = acc[ai][bj][m][n]; }
        }
    }
};
struct EpiIN {
    static constexpr bool PERM = true, AFTER_DRAIN = false, IDEMP = (PROBE_EPI2 == 3);
    unsigned char* ws; float* out;
    __device__ __forceinline__ void operator()(const pg8::f32x4 (&acc)[2][2][4][2], const pg8::Unit& u, int wr, int wc, int fr, int fq) const {
        const int pn = u.pn, rowb = u.pm * 256 + wr * 64 + fr, cw = wc * 32 + 8 * fq;
        if (pn == 40) {
            if (wc == 0 && fq < 2) {
                float* GA = (float*)(ws + WS_GA);
#pragma unroll
                for (int ai = 0; ai < 2; ++ai)
#pragma unroll
                    for (int m = 0; m < 4; ++m) { float* p = GA + (size_t)(rowb + ai * 128 + m * 16) * 16 + 8 * fq; *(pg8::f32x4*)p = acc[ai][0][m][0]; *(pg8::f32x4*)(p + 4) = acc[ai][0][m][1]; }
            }
            return;
        }
        bf16* bb; int ld, c0; float sc = 1.0f; float* fo = nullptr; int act = 0;
        const bool samp = (u.pm >= 128);
        if (pn >= 41) {
            const int t = pn - 41; ld = 1024;
            if (t < 4) { bb = (bf16*)(ws + WS_MKB); c0 = t * 256; fo = out + O_MEMK_P; } else { bb = (bf16*)(ws + WS_MVB); c0 = (t - 4) * 256; fo = out + O_MEMV_P; }
        } else if (pn < 4) { bb = (bf16*)(ws + WS_SBQ); ld = 1024; c0 = pn * 256; sc = C_SB; }
        else if (pn < 8) { bb = (bf16*)(ws + WS_SBK); ld = 1024; c0 = (pn - 4) * 256; fo = samp ? out + O_SBK_S : out + O_SBK_P; }
        else if (pn < 12) { bb = (bf16*)(ws + WS_SBV); ld = 1024; c0 = (pn - 8) * 256; fo = samp ? out + O_SBV_S : out + O_SBV_P; }
        else if (pn < 16) { bb = (bf16*)(ws + WS_GQ); ld = 1024; c0 = (pn - 12) * 256; sc = C_GQ; }
        else if (pn < 20) { bb = (bf16*)(ws + WS_GK); ld = 1024; c0 = (pn - 16) * 256; }
        else if (pn < 28) { bb = (bf16*)(ws + WS_GV); ld = 2048; c0 = (pn - 20) * 256; }
        else if (pn < 36) { bb = (bf16*)(ws + WS_GR); ld = 2048; c0 = (pn - 28) * 256; act = 1; }
        else { bb = (bf16*)(ws + WS_MQ); ld = 1024; c0 = (pn - 36) * 256; sc = C_MEM; }
        const int rb_b = (pn >= 41) ? rowb - MT : rowb;
        const int rb_f = (pn >= 41) ? rowb - MT : (samp ? rowb - NPT : rowb);
#pragma unroll
        for (int ai = 0; ai < 2; ++ai)
#pragma unroll
            for (int m = 0; m < 4; ++m)
#pragma unroll
                for (int bj = 0; bj < 2; ++bj) {
                    pg8::f32x4 v0 = acc[ai][bj][m][0], v1 = acc[ai][bj][m][1];
                    const int cc = c0 + bj * 128 + cw; const int ro = ai * 128 + m * 16;
                    if (fo) { float* p = fo + (size_t)(rb_f + ro) * 1024 + cc; __builtin_nontemporal_store(v0, (pg8::f32x4*)p); __builtin_nontemporal_store(v1, (pg8::f32x4*)(p + 4)); }
                    if (act) {
#pragma unroll
                        for (int i = 0; i < 4; ++i) { v0[i] = v0[i] * frcp(1.0f + fexp2(-v0[i] * LOG2E)); v1[i] = v1[i] * frcp(1.0f + fexp2(-v1[i] * LOG2E)); }
                    }
                    v0 = v0 * sc; v1 = v1 * sc;
                    v4u w; w.x = cvtpk(v0[0], v0[1]); w.y = cvtpk(v0[2], v0[3]); w.z = cvtpk(v1[0], v1[1]); w.w = cvtpk(v1[2], v1[3]);
                    *(v4u*)(bb + (size_t)(rb_b + ro) * ld + cc) = w;
                }
    }
};
struct EpiGate {
    static constexpr bool PERM = true, AFTER_DRAIN = false, IDEMP = (PROBE_EPI2 == 4);
    unsigned char* ws; const float* bias;
    __device__ __forceinline__ void operator()(const pg8::f32x4 (&acc)[2][2][4][2], const pg8::Unit& u, int wr, int wc, int fr, int fq) const {
        const int br = u.pn >> 3, rowb = u.pm * 256 + wr * 64 + fr, cw = wc * 32 + 8 * fq, c0 = (u.pn & 7) * 256;
        bf16* G = (bf16*)(ws + (br == 0 ? WS_G0 : (br == 1 ? WS_G1 : WS_G2)));
        pg8::f32x4 bv[2][2];
#pragma unroll
        for (int bj = 0; bj < 2; ++bj)
#pragma unroll
            for (int n = 0; n < 2; ++n) bv[bj][n] = *(const pg8::f32x4*)(bias + u.pn * 256 + bj * 128 + cw + 4 * n);
#pragma unroll
        for (int ai = 0; ai < 2; ++ai)
#pragma unroll
            for (int m = 0; m < 4; ++m)
#pragma unroll
                for (int bj = 0; bj < 2; ++bj) {
                    float o[8];
#pragma unroll
                    for (int n = 0; n < 2; ++n)
#pragma unroll
                        for (int i = 0; i < 4; ++i) o[4 * n + i] = sigmoidf_(acc[ai][bj][m][n][i] + bv[bj][n][i]);
                    v4u w; w.x = cvtpk(o[0], o[1]); w.y = cvtpk(o[2], o[3]); w.z = cvtpk(o[4], o[5]); w.w = cvtpk(o[6], o[7]);
                    *(v4u*)(G + (size_t)(rowb + ai * 128 + m * 16) * DM + c0 + bj * 128 + cw) = w;
                }
    }
};
template <int MODE> struct EpiBR {
    static constexpr bool PERM = false, AFTER_DRAIN = false, IDEMP = false;
    const bf16* G; bf16* MRG; bf16* OUTB;
    __device__ __forceinline__ void operator()(const pg8::f32x4 (&acc)[2][2][4][2], const pg8::Unit& u, int wr, int wc, int fr, int fq) const {
        const int row0 = u.pm * 256 + wr * 64 + fr, col0 = u.pn * 256 + wc * 32 + 4 * fq;
#pragma unroll
        for (int ai = 0; ai < 2; ++ai)
#pragma unroll
            for (int m = 0; m < 4; ++m) { const size_t ro = (size_t)(row0 + ai * 128 + m * 16) * DM + col0;
#pragma unroll
                for (int bj = 0; bj < 2; ++bj)
#pragma unroll
                    for (int n = 0; n < 2; ++n) { const size_t o = ro + bj * 128 + n * 16; const u32x2 gw = *(const u32x2*)(G + o);
                        pg8::f32x4 g = {bflo(gw.x), bfhi(gw.x), bflo(gw.y), bfhi(gw.y)}; pg8::f32x4 v = g * acc[ai][bj][m][n];
                        if (MODE >= 1) { const u32x2 mw = *(const u32x2*)(MRG + o); v = v + (pg8::f32x4){bflo(mw.x), bfhi(mw.x), bflo(mw.y), bfhi(mw.y)}; }
                        u32x2 w; w.x = cvtpk(v[0], v[1]); w.y = cvtpk(v[2], v[3]);
                        *(u32x2*)((MODE <= 1 ? MRG : OUTB) + o) = w; }
            }
    }
};
struct EpiBR12 {
    static constexpr bool PERM = false, AFTER_DRAIN = false, IDEMP = false;
    const bf16* Ga; const bf16* Gb; bf16* MRG; bf16* OUTB;
    __device__ __forceinline__ void operator()(const pg8::f32x4 (&acc)[2][2][4][2], const pg8::Unit& u, int wr, int wc, int fr, int fq) const {
        const int row0 = u.pm * 256 + wr * 64 + fr, col0 = u.pn * 256 + wc * 32 + 4 * fq;
        const bool second = u.alt(); const bf16* const G = second ? Gb : Ga; bf16* const O = second ? OUTB : MRG;
#pragma unroll
        for (int ai = 0; ai < 2; ++ai) {
            u32x2 gw[4][2][2], mw[4][2][2];
#pragma unroll
            for (int m = 0; m < 4; ++m) { const size_t ro = (size_t)(row0 + ai * 128 + m * 16) * DM + col0;
#pragma unroll
                for (int bj = 0; bj < 2; ++bj)
#pragma unroll
                    for (int n = 0; n < 2; ++n) { const size_t o = ro + bj * 128 + n * 16; gw[m][bj][n] = *(const u32x2*)(G + o); mw[m][bj][n] = *(const u32x2*)(MRG + o); } }
            __builtin_amdgcn_sched_barrier(0);
#pragma unroll
            for (int m = 0; m < 4; ++m) { const size_t ro = (size_t)(row0 + ai * 128 + m * 16) * DM + col0;
#pragma unroll
                for (int bj = 0; bj < 2; ++bj)
#pragma unroll
                    for (int n = 0; n < 2; ++n) { const size_t o = ro + bj * 128 + n * 16; const u32x2 gq = gw[m][bj][n], mq = mw[m][bj][n];
                        pg8::f32x4 g = {bflo(gq.x), bfhi(gq.x), bflo(gq.y), bfhi(gq.y)};
                        pg8::f32x4 v = g * acc[ai][bj][m][n] + (pg8::f32x4){bflo(mq.x), bfhi(mq.x), bflo(mq.y), bfhi(mq.y)};
                        u32x2 w; w.x = cvtpk(v[0], v[1]); w.y = cvtpk(v[2], v[3]);
                        *(u32x2*)(O + o) = w; } }
        }
    }
};
struct FusedOrder {
    pg8::StaticOrder S;
    __device__ __forceinline__ bool next(int i, pg8::Unit& u) const { if (!S.next(i >> 1, u)) return false; u.kx = (i & 1) ? (1 << 30) : 0; return true; }
    __device__ __forceinline__ bool first(pg8::Unit& u) const { return next(0, u); }
    __device__ __forceinline__ bool peek(int i, pg8::Unit& u, bool& pend) const { pend = false; return next(i, u); }
    __device__ __forceinline__ bool fetch(pg8::Unit&) const { return false; }
    __device__ __forceinline__ void a_ready(const pg8::Unit&) const {}
    __device__ __forceinline__ void done(const pg8::Unit&) const {}
};
#ifndef WGM_A
#define WGM_A 4
#endif
#ifndef WGM_B
#define WGM_B 4
#endif
#ifndef WGM_C
#define WGM_C 4
#endif
struct OrderIN {
    pg8::StaticOrder S; int G, c;
    __device__ void init(int G_, int c_) { S.init(MT, 41 * 256, G_, c_, WGM_A); G = G_; c = c_; }
    __device__ __forceinline__ int total() const { return S.nwg + 32; }
    __device__ bool map(long L, pg8::Unit& u) const {
        if (L < S.nwg) return S.map(L, u);
        const int j = (int)(L - S.nwg); if (j >= 32) return false;
        u.pm = MT / 256 + (j & 3); u.pn = 41 + (j >> 2); u.kx = 0; return true;
    }
    __device__ bool next(int i, pg8::Unit& u) const { return map((long)i * G + c, u); }
    __device__ __forceinline__ void a_ready(const pg8::Unit&) const {}
    __device__ __forceinline__ void done(const pg8::Unit&) const {}
};

struct OrderSplit {
    pg8::StaticOrder S; int G, c, ntk;
    __device__ void init(int G_, int c_, int ntk_) { S.init(NPT, DM, G_, c_, WGM_B); G = G_; c = c_; ntk = ntk_; }
    __device__ __forceinline__ int total() const { return S.nwg + 256; }
    __device__ bool next(int i, pg8::Unit& u) const { return map((long)i * G + c, u); }
    __device__ bool map(long L, pg8::Unit& u) const {
        if (L < S.nwg) return S.map(L, u);
        const int j = (int)(L - S.nwg); if (j >= 256) return false;
        const int tile = j >> 3, sl = j & 7;
        u.pm = NPT / 256 + (tile >> 3); u.pn = tile & 7;
        int n, t0;
        if (ntk == 88) { n = (sl < 4) ? 12 : 10; t0 = (sl < 4) ? 12 * sl : 48 + 10 * (sl - 4); }
        else { n = ntk >> 3; t0 = n * sl; }
        u.kx = t0 | (n << 12) | ((sl + 1) << 24);
        return true;
    }
    __device__ __forceinline__ void a_ready(const pg8::Unit&) const {}
    __device__ __forceinline__ void done(const pg8::Unit&) const {}
};

#ifndef DYN_ROUNDS
#define DYN_ROUNDS 3
#endif
template <class Map> struct DynTail {
    Map M; int G, c, nstatic, Ls, Ltot; gu32* heads; volatile LAS unsigned* qw;
    __device__ void init(const Map& m, int G_, int c_, gu32* heads_, volatile LAS unsigned* qw_) {
        M = m; G = G_; c = c_; heads = heads_; qw = qw_; Ltot = M.total();
        const int R = (Ltot + G - 1) / G; nstatic = R > DYN_ROUNDS ? R - DYN_ROUNDS : 0; Ls = nstatic * G;
    }
    __device__ __forceinline__ bool fetch(pg8::Unit& u) const {
        if (__builtin_amdgcn_readfirstlane((int)(threadIdx.x >> 6)) == 0) {
            if ((threadIdx.x & 63) == 0) {
                unsigned L = 0xffffffffu;
                for (int s = 0; s < 8; ++s) {
                    const int x = (c + s) & 7;
                    const unsigned k = __hip_atomic_fetch_add((unsigned*)heads + x * 256, 1u, __ATOMIC_RELAXED, __HIP_MEMORY_SCOPE_AGENT);
                    const unsigned cand = (unsigned)Ls + (unsigned)((x - Ls) & 7) + 8u * k;
                    if (cand < (unsigned)Ltot) { L = cand; break; }
                }
                *qw = L;
            }
            asm volatile("s_waitcnt lgkmcnt(0)" ::: "memory");
        }
        asm volatile("" ::: "memory"); __builtin_amdgcn_s_barrier(); asm volatile("" ::: "memory");
        const unsigned L = __builtin_amdgcn_readfirstlane(*qw);
        if (L == 0xffffffffu) return false;
        return M.map((long)L, u);
    }
    __device__ __forceinline__ bool first(pg8::Unit& u) const { if (nstatic > 0) return M.map((long)c, u); return fetch(u); }
    __device__ __forceinline__ bool peek(int i, pg8::Unit& u, bool& pend) const {
        if (i < nstatic) { pend = false; return M.map((long)i * G + c, u); }
        pend = true; return false;
    }
    __device__ __forceinline__ void a_ready(const pg8::Unit&) const {}
    __device__ __forceinline__ void done(const pg8::Unit&) const {}
};
__device__ __forceinline__ unsigned wave_ticket(gu32* cnt, unsigned n, int lane) {
    unsigned b = 0; if (lane == 0) b = __hip_atomic_fetch_add((unsigned*)cnt, n, __ATOMIC_RELAXED, __HIP_MEMORY_SCOPE_AGENT);
    return __builtin_amdgcn_readfirstlane(b);
}

constexpr int SB_KP = 272, SB_VP = 288, SB_VOFF = 64 * SB_KP, SB_FLAG = SB_VOFF + 64 * SB_VP;
__device__ __forceinline__ void sb_weights(f32x16& p0, f32x16& p1, float& Rin, int kpos0, int qpos, bool mask, int hi) {
#pragma unroll
    for (int r = 0; r < 16; ++r) { p0[r] = frcp(1.0f + fexp2(p0[r])); p1[r] = frcp(1.0f + fexp2(p1[r])); }
    if (mask) {
#pragma unroll
        for (int r = 0; r < 16; ++r) { const int kp = kpos0 + crow(r, hi); if (kp >= qpos) p0[r] = 1.0f; if (kp + 32 >= qpos) p1[r] = 1.0f; }
    }
    float TG[16];
#pragma unroll
    for (int i = 0; i < 4; ++i) {
        const float t0 = (p0[4 * i] * p0[4 * i + 1]) * (p0[4 * i + 2] * p0[4 * i + 3]), t1 = (p1[4 * i] * p1[4 * i + 1]) * (p1[4 * i + 2] * p1[4 * i + 3]);
        auto a = __builtin_amdgcn_permlane32_swap(__float_as_uint(t0), __float_as_uint(t0), false, false);
        auto b = __builtin_amdgcn_permlane32_swap(__float_as_uint(t1), __float_as_uint(t1), false, false);
        TG[2 * i] = __uint_as_float(a[0]); TG[2 * i + 1] = __uint_as_float(a[1]); TG[8 + 2 * i] = __uint_as_float(b[0]); TG[8 + 2 * i + 1] = __uint_as_float(b[1]);
    }
    float E[17]; E[16] = Rin;
#pragma unroll
    for (int g = 15; g >= 0; --g) E[g] = E[g + 1] * TG[g];
#pragma unroll
    for (int i = 0; i < 4; ++i) {
        { const float st = hi ? E[2 * i + 2] : E[2 * i + 1];
          const float R3 = st * p0[4 * i + 3], R2 = R3 * p0[4 * i + 2], R1 = R2 * p0[4 * i + 1], R0 = R1 * p0[4 * i];
          p0[4 * i + 3] = st - R3; p0[4 * i + 2] = R3 - R2; p0[4 * i + 1] = R2 - R1; p0[4 * i] = R1 - R0; }
        { const float st = hi ? E[8 + 2 * i + 2] : E[8 + 2 * i + 1];
          const float R3 = st * p1[4 * i + 3], R2 = R3 * p1[4 * i + 2], R1 = R2 * p1[4 * i + 1], R0 = R1 * p1[4 * i];
          p1[4 * i + 3] = st - R3; p1[4 * i + 2] = R3 - R2; p1[4 * i + 1] = R2 - R1; p1[4 * i] = R1 - R0; }
    }
    Rin = E[0];
}
template <bool SAMPLE>
__device__ __forceinline__ void sb_unit(ldsp lds, int b, int h, int qb, const bf16* SBQ, const bf16* SBK, const bf16* SBV, bf16* OSB, const float* cK, const float* cV, int tid, int wid, int lane, bool wr) {
    const int r32 = lane & 31, hi = lane >> 5;
    const int nwv = SAMPLE ? 1 : 8;
    const size_t qrow0 = SAMPLE ? (size_t)NPT + b * 32 : (size_t)b * SEQ + qb * 256;
    const int qpos0 = SAMPLE ? PAST : qb * 256;
    const bool wact = wid < nwv;
    const int qmin = qpos0 + 32 * wid, qpos = qmin + r32, qmax = qmin + 31;
    bf16x8 qr[8];
    if (wact) {
        const bf16* qp = SBQ + (qrow0 + 32 * wid + r32) * 1024 + h * 128 + hi * 8;
#pragma unroll
        for (int d0 = 0; d0 < 8; ++d0) qr[d0] = ld8_bf(qp + d0 * 16);
    } else {
#pragma unroll
        for (int d0 = 0; d0 < 8; ++d0) qr[d0] = (bf16x8){0, 0, 0, 0, 0, 0, 0, 0};
    }
    f32x16 o[4];
#pragma unroll
    for (int d = 0; d < 4; ++d)
#pragma unroll
        for (int r = 0; r < 16; ++r) o[d][r] = 0.f;
    float Rin = 1.0f;
    const int sr = tid >> 4, sc = (tid & 15) * 8;
    volatile LAS int* flags = (volatile LAS int*)(lds + SB_FLAG);
    const int kt_last = SAMPLE ? (PAST + DSEQ - 1) / 64 : (qpos0 + 255) / 64;
    bf16x8 k0v, k1v, v0v, v1v;
#define SB_LOAD(KT) do { const int kt_ = (KT); \
        if (!SAMPLE) { const size_t base = ((size_t)b * SEQ + kt_ * 64) * 1024 + h * 128 + sc; \
            k0v = ld8_bf(SBK + base + (size_t)sr * 1024); k1v = ld8_bf(SBK + base + (size_t)(sr + 32) * 1024); \
            v0v = ld8_bf(SBV + base + (size_t)sr * 1024); v1v = ld8_bf(SBV + base + (size_t)(sr + 32) * 1024); } \
        else if (kt_ * 64 < PAST) { const size_t base = ((size_t)b * PAST + kt_ * 64) * 1024 + h * 128 + sc; \
            k0v = ld8_f32(cK + base + (size_t)sr * 1024); k1v = ld8_f32(cK + base + (size_t)(sr + 32) * 1024); \
            v0v = ld8_f32(cV + base + (size_t)sr * 1024); v1v = ld8_f32(cV + base + (size_t)(sr + 32) * 1024); } \
        else { const size_t base = ((size_t)NPT + b * 32) * 1024 + h * 128 + sc;     \
            k0v = ld8_bf(SBK + base + (size_t)sr * 1024); v0v = ld8_bf(SBV + base + (size_t)sr * 1024); \
            k1v = (bf16x8){0, 0, 0, 0, 0, 0, 0, 0}; v1v = k1v; } } while (0)
    SB_LOAD(kt_last);
    for (int kt = kt_last; kt >= 0; --kt) {
        *(LAS bf16x8*)(lds + sr * SB_KP + sc * 2) = k0v; *(LAS bf16x8*)(lds + (sr + 32) * SB_KP + sc * 2) = k1v;
        *(LAS bf16x8*)(lds + SB_VOFF + sr * SB_VP + sc * 2) = v0v; *(LAS bf16x8*)(lds + SB_VOFF + (sr + 32) * SB_VP + sc * 2) = v1v;
        if (kt > 0) SB_LOAD(kt - 1);
        __syncthreads();
        int alive = 0;
        if (wact) {
            alive = 1;
            const int kpos0 = kt * 64;
            if (kpos0 < qmax && __any(Rin >= SB_THR)) {
                f32x16 p0, p1;
#pragma unroll
                for (int r = 0; r < 16; ++r) { p0[r] = 0.f; p1[r] = 0.f; }
                {
                    bf16x8 a0[8], a1[8];
#pragma unroll
                    for (int d0 = 0; d0 < 8; ++d0) { a0[d0] = *(const LAS bf16x8*)(lds + r32 * SB_KP + (d0 * 16 + hi * 8) * 2); a1[d0] = *(const LAS bf16x8*)(lds + (32 + r32) * SB_KP + (d0 * 16 + hi * 8) * 2); }
                    __builtin_amdgcn_sched_barrier(0);
#pragma unroll
                    for (int d0 = 0; d0 < 8; ++d0) { p0 = __builtin_amdgcn_mfma_f32_32x32x16_bf16(a0[d0], qr[d0], p0, 0, 0, 0); p1 = __builtin_amdgcn_mfma_f32_32x32x16_bf16(a1[d0], qr[d0], p1, 0, 0, 0); }
                }
                sb_weights(p0, p1, Rin, kpos0, qpos, kpos0 + 63 >= qmin, hi);
                bf16x8 pa[4]; PK4(p0, 0, pa[0]); PK4(p0, 8, pa[1]); PK4(p1, 0, pa[2]); PK4(p1, 8, pa[3]);
                const int vrow = 8 * hi + ((lane & 15) >> 2), vcol = 16 * ((lane >> 4) & 1) + 4 * (lane & 3);
                {
                    s16x4 cl[4], ch[4], nl[4], nh[4];
                    ldscp vp0 = lds + SB_VOFF + vrow * SB_VP + vcol * 2;
#pragma unroll
                    for (int d0 = 0; d0 < 4; ++d0) { cl[d0] = vtr(vp0 + 64 * d0); ch[d0] = vtr(vp0 + 64 * d0 + 4 * SB_VP); }
#pragma unroll
                    for (int ks = 0; ks < 4; ++ks) {
                        if (ks < 3) {
#pragma unroll
                            for (int d0 = 0; d0 < 4; ++d0) { nl[d0] = vtr(vp0 + 16 * (ks + 1) * SB_VP + 64 * d0); nh[d0] = vtr(vp0 + 16 * (ks + 1) * SB_VP + 64 * d0 + 4 * SB_VP); }
                        }
                        __builtin_amdgcn_sched_barrier(0);
#pragma unroll
                        for (int d0 = 0; d0 < 4; ++d0) { const bf16x8 vb = {cl[d0][0], cl[d0][1], cl[d0][2], cl[d0][3], ch[d0][0], ch[d0][1], ch[d0][2], ch[d0][3]};
                            o[d0] = __builtin_amdgcn_mfma_f32_32x32x16_bf16(pa[ks], vb, o[d0], 0, 0, 0); }
                        __builtin_amdgcn_sched_barrier(0);
#pragma unroll
                        for (int d0 = 0; d0 < 4; ++d0) { cl[d0] = nl[d0]; ch[d0] = nh[d0]; }
                    }
                }
            }
            alive = __any(Rin >= SB_THR) ? 1 : 0;
        }
        if (lane == 0) flags[wid] = alive;
        __syncthreads();
        int any_alive = 0;
#pragma unroll
        for (int w = 0; w < 8; ++w) any_alive |= flags[w];
        if (!any_alive) break;
    }
#undef SB_LOAD
    __syncthreads();
    if (wact && wr) {
        bf16* op = OSB + (qrow0 + 32 * wid) * 1024 + h * 128 + r32;
#pragma unroll
        for (int r = 0; r < 16; ++r) { const int qq = crow(r, hi);
#pragma unroll
            for (int d0 = 0; d0 < 4; ++d0) op[(size_t)qq * 1024 + d0 * 32] = (bf16)(cvtpk(o[d0][r], 0.f) & 0xffffu); }
    }
}

constexpr int MEM_P = 544;
template <bool SAMPLE>
__device__ __forceinline__ void mem_unit(ldsp lds, int b, int h, int qblk, bf16* MQ, const bf16* MKB, const bf16* MVB, const float* cK, const float* cV, int tid, int wid, int lane, bool wr) {
    const int l15 = lane & 15, g = lane >> 4;
    const size_t qrow0 = SAMPLE ? (size_t)NPT + b * 32 : (size_t)b * SEQ + qblk * 128;
    const bool wact = SAMPLE ? (wid < 2) : true;
    bf16x8 qf[8];
    if (wact) { const bf16* qp = MQ + (qrow0 + 16 * wid + l15) * 1024 + h * 256 + 8 * g;
#pragma unroll
        for (int s = 0; s < 8; ++s) qf[s] = ld8_bf(qp + 32 * s); }
    else {
#pragma unroll
        for (int s = 0; s < 8; ++s) qf[s] = (bf16x8){0, 0, 0, 0, 0, 0, 0, 0}; }
    f32x4 st[4][4];
#pragma unroll
    for (int a = 0; a < 4; ++a)
#pragma unroll
        for (int c = 0; c < 4; ++c) st[a][c] = (f32x4){0.f, 0.f, 0.f, 0.f};
    const int sx = tid & 31, sr0 = tid >> 5;
    const size_t kvbase = (size_t)b * 256 * 1024 + h * 256 + 8 * sx;
    bf16x8 tv[4];
#define MEM_LOAD(SRCF, SRCB, KT) do { _Pragma("unroll") for (int c = 0; c < 4; ++c) { const size_t so_ = kvbase + (size_t)((KT) * 64 + sr0 + 16 * c) * 1024; \
        tv[c] = SAMPLE ? ld8_f32((SRCF) + so_) : ld8_bf((SRCB) + so_); } } while (0)
    MEM_LOAD(cK, MKB, 0);
#pragma unroll
    for (int kt = 0; kt < 4; ++kt) {
        __syncthreads();
#pragma unroll
        for (int c = 0; c < 4; ++c) *(LAS bf16x8*)(lds + (sr0 + 16 * c) * MEM_P + sx * 16) = tv[c];
        if (kt < 3) MEM_LOAD(cK, MKB, kt + 1); else MEM_LOAD(cV, MVB, 0);
        __syncthreads();
        if (wact) {
            bf16x8 ac[4], an[4];
#pragma unroll
            for (int t4 = 0; t4 < 4; ++t4) ac[t4] = *(const LAS bf16x8*)(lds + (16 * t4 + l15) * MEM_P + (8 * g) * 2);
#pragma unroll
            for (int s = 0; s < 8; ++s) {
                if (s < 7) {
#pragma unroll
                    for (int t4 = 0; t4 < 4; ++t4) an[t4] = *(const LAS bf16x8*)(lds + (16 * t4 + l15) * MEM_P + (32 * (s + 1) + 8 * g) * 2);
                }
                __builtin_amdgcn_sched_barrier(0);
#pragma unroll
                for (int t4 = 0; t4 < 4; ++t4) st[kt][t4] = __builtin_amdgcn_mfma_f32_16x16x32_bf16(ac[t4], qf[s], st[kt][t4], 0, 0, 0);
                __builtin_amdgcn_sched_barrier(0);
#pragma unroll
                for (int t4 = 0; t4 < 4; ++t4) ac[t4] = an[t4];
            }
        }
    }
    float mx = -3.0e38f;
#pragma unroll
    for (int a = 0; a < 4; ++a)
#pragma unroll
        for (int c = 0; c < 4; ++c)
#pragma unroll
            for (int i = 0; i < 4; ++i) mx = fmaxf(mx, st[a][c][i]);
    mx = fmaxf(mx, __shfl_xor(mx, 16)); mx = fmaxf(mx, __shfl_xor(mx, 32));
    float sm = 0.f;
#pragma unroll
    for (int a = 0; a < 4; ++a)
#pragma unroll
        for (int c = 0; c < 4; ++c)
#pragma unroll
            for (int i = 0; i < 4; ++i) { st[a][c][i] = fexp2(st[a][c][i] - mx); sm += st[a][c][i]; }
    sm += __shfl_xor(sm, 16); sm += __shfl_xor(sm, 32);
    const float inv = 1.0f / sm;
    f32x4 o[16];
#pragma unroll
    for (int c = 0; c < 16; ++c) o[c] = (f32x4){0.f, 0.f, 0.f, 0.f};
#pragma unroll
    for (int kt = 0; kt < 4; ++kt) {
        __syncthreads();
#pragma unroll
        for (int c = 0; c < 4; ++c) *(LAS bf16x8*)(lds + (sr0 + 16 * c) * MEM_P + sx * 16) = tv[c];
        if (kt < 3) MEM_LOAD(cV, MVB, kt + 1);
        __syncthreads();
        if (wact) {
#pragma unroll
            for (int s2 = 0; s2 < 2; ++s2) {
                const f32x4 x0 = st[kt][2 * s2] * inv, x1 = st[kt][2 * s2 + 1] * inv;
                v4u pw = {cvtpk(x0[0], x0[1]), cvtpk(x0[2], x0[3]), cvtpk(x1[0], x1[1]), cvtpk(x1[2], x1[3])};
                const bf16x8 pa = __builtin_bit_cast(bf16x8, pw);
                ldscp vp0 = lds + (32 * s2 + 4 * g + (l15 >> 2)) * MEM_P + (4 * (lane & 3)) * 2;
                s16x4 cl[4], ch[4], nl[4], nh[4];
#pragma unroll
                for (int i = 0; i < 4; ++i) { cl[i] = vtr(vp0 + 32 * i); ch[i] = vtr(vp0 + 32 * i + 16 * MEM_P); }
#pragma unroll
                for (int grp = 0; grp < 4; ++grp) {
                    if (grp < 3) {
#pragma unroll
                        for (int i = 0; i < 4; ++i) { nl[i] = vtr(vp0 + 32 * (4 * grp + 4 + i)); nh[i] = vtr(vp0 + 32 * (4 * grp + 4 + i) + 16 * MEM_P); }
                    }
                    __builtin_amdgcn_sched_barrier(0);
#pragma unroll
                    for (int i = 0; i < 4; ++i) { const bf16x8 vb = {cl[i][0], cl[i][1], cl[i][2], cl[i][3], ch[i][0], ch[i][1], ch[i][2], ch[i][3]};
                        o[4 * grp + i] = __builtin_amdgcn_mfma_f32_16x16x32_bf16(pa, vb, o[4 * grp + i], 0, 0, 0); }
                    __builtin_amdgcn_sched_barrier(0);
#pragma unroll
                    for (int i = 0; i < 4; ++i) { cl[i] = nl[i]; ch[i] = nh[i]; }
                }
            }
        }
    }
    if (wact && wr) {
        bf16* op = MQ + (qrow0 + 16 * wid + 4 * g) * 1024 + h * 256 + l15;
#pragma unroll
        for (int cb = 0; cb < 16; ++cb)
#pragma unroll
            for (int i = 0; i < 4; ++i) op[(size_t)i * 1024 + cb * 16] = (bf16)(cvtpk(o[cb][i], 0.f) & 0xffffu);
    }
#undef MEM_LOAD
    __syncthreads();
}

constexpr int GP_VP = 1056, GP_QP = 528, GP_QE = 67584, GP_KD = 101376, GP_ATT = 135168, GP_AP = 144, GP_BP = 260;
__device__ __forceinline__ void gla_pre_item(ldsp lds, int cid, int h, unsigned char* ws, bf16* frag, const float* wa2, const float* ba2, int tid, int wid, int lane, bool wr) {
    const bool samp = cid >= NPT / 64; const int L = samp ? 32 : 64;
    const size_t row0 = samp ? (size_t)NPT + (cid - NPT / 64) * 32 : (size_t)cid * 64;
    bf16* GQ = (bf16*)(ws + WS_GQ); bf16* GK = (bf16*)(ws + WS_GK); const bf16* GV = (const bf16*)(ws + WS_GV); const float* GA = (const float*)(ws + WS_GA);
    float* EB = (float*)(ws + WS_EB); bf16* OI = (bf16*)(ws + WS_OINTRA);
    bf16* const qef = samp ? (bf16*)(ws + WS_QEF_S) + (size_t)((cid - NPT / 64) * 4 + h) * 16384 : frag + FRAG_QEF + (size_t)(cid * 4 + h) * 16384;
    bf16* const ketf = samp ? (bf16*)(ws + WS_KETF_S) + (size_t)((cid - NPT / 64) * 4 + h) * 16384 : frag + FRAG_KETF + (size_t)(cid * 4 + h) * 16384;
    LAS float* bl = (LAS float*)lds; LAS float* gal = (LAS float*)(lds + GP_ATT);
    const int dk = tid & 255, half = tid >> 8;
    const int cx = tid & 31, tg = tid >> 5;
    bf16x8 qin[4], kin[4];
#pragma unroll
    for (int j = 0; j < 4; ++j) { const int t = tg + 16 * j; qin[j] = (bf16x8){0, 0, 0, 0, 0, 0, 0, 0}; kin[j] = qin[j];
        if (t < L) { qin[j] = ld8_bf(GQ + (row0 + t) * 1024 + h * 256 + 8 * cx); kin[j] = ld8_bf(GK + (row0 + t) * 1024 + h * 256 + 8 * cx); } }
    __syncthreads();
    for (int i = tid; i < 64 * 16; i += NTHR) { const int t = i >> 4; gal[i] = (t < L) ? GA[(row0 + t) * 16 + (i & 15)] : 0.f; }
    float w[16];
#pragma unroll
    for (int r = 0; r < 16; ++r) w[r] = wa2[r * 1024 + h * 256 + dk];
    const float bias = ba2[h * 256 + dk];
    __syncthreads();
    float cum = 0.f;
#pragma unroll 4
    for (int tt = 0; tt < 32; ++tt) {
        const int t = half * 32 + tt; float x = bias;
#pragma unroll
        for (int r = 0; r < 16; ++r) x += gal[t * 16 + r] * w[r];
        const float ls = fminf(x, 0.f) - LN2 * flog2(1.0f + fexp2(-fabsf(x) * LOG2E));
        if (t < L) cum += ls * (1.0f / 16.0f);
        bl[t * GP_BP + dk] = cum;
    }
    __syncthreads();
    const float add = half ? bl[31 * GP_BP + dk] : 0.f;
    if (half) {
#pragma unroll 8
        for (int tt = 0; tt < 32; ++tt) bl[(32 + tt) * GP_BP + dk] += add;
    }
    __syncthreads();
    {
        const f32x4 l0 = *(const LAS f32x4*)(bl + 63 * GP_BP + 8 * cx), l1 = *(const LAS f32x4*)(bl + 63 * GP_BP + 8 * cx + 4);
#pragma unroll
        for (int j = 0; j < 4; ++j) {
            const int t = tg + 16 * j;
            const f32x4 b0 = *(const LAS f32x4*)(bl + t * GP_BP + 8 * cx), b1 = *(const LAS f32x4*)(bl + t * GP_BP + 8 * cx + 4);
            float qe[8], kd[8];
#pragma unroll
            for (int i = 0; i < 8; ++i) {
                const float bb = (i < 4 ? b0[i] : b1[i - 4]) * LOG2E;
                const float q = bf2f((unsigned short)qin[j][i]), k = bf2f((unsigned short)kin[j][i]);
                qe[i] = q * fexp2(bb); kd[i] = k * fexp2(-bb);
            }
            *(LAS v4u*)(lds + GP_QE + t * GP_QP + cx * 16) = (v4u){cvtpk(qe[0], qe[1]), cvtpk(qe[2], qe[3]), cvtpk(qe[4], qe[5]), cvtpk(qe[6], qe[7])};
            *(LAS v4u*)(lds + GP_KD + t * GP_QP + cx * 16) = (v4u){cvtpk(kd[0], kd[1]), cvtpk(kd[2], kd[3]), cvtpk(kd[4], kd[5]), cvtpk(kd[6], kd[7])};
        }
        if (tg == 0) { float* e = EB + (size_t)cid * 1024 + h * 256 + 8 * cx;
            *(f32x4*)e = (f32x4){fexp2(l0[0] * LOG2E), fexp2(l0[1] * LOG2E), fexp2(l0[2] * LOG2E), fexp2(l0[3] * LOG2E)};
            *(f32x4*)(e + 4) = (f32x4){fexp2(l1[0] * LOG2E), fexp2(l1[1] * LOG2E), fexp2(l1[2] * LOG2E), fexp2(l1[3] * LOG2E)}; }
    }
    __syncthreads();
    { const int l15 = lane & 15, g = lane >> 4;
#pragma unroll
      for (int tt = 0; tt < 4; ++tt) *(v4u*)(qef + ((size_t)((tt * 8 + wid) * 64 + lane)) * 8) = *(const LAS v4u*)(lds + GP_QE + (16 * tt + l15) * GP_QP + (32 * wid + 8 * g) * 2); }
    { const int r32_ = lane & 31, hi_ = lane >> 5;
      const float ebl = fexp2(bl[63 * GP_BP + 32 * wid + r32_] * LOG2E);
      const int trow = 8 * hi_ + ((lane & 15) >> 2), tcol = 16 * ((lane >> 4) & 1) + 4 * (lane & 3);
      s16x4 kl[4], kh[4];
#pragma unroll
      for (int ks = 0; ks < 4; ++ks) { ldscp kp = lds + GP_KD + (16 * ks + trow) * GP_QP + (32 * wid + tcol) * 2; kl[ks] = vtr(kp); kh[ks] = vtr(kp + 4 * GP_QP); }
#pragma unroll
      for (int ks = 0; ks < 4; ++ks) {
          float e[8];
#pragma unroll
          for (int j = 0; j < 4; ++j) { e[j] = bf2f((unsigned short)kl[ks][j]) * ebl; e[4 + j] = bf2f((unsigned short)kh[ks][j]) * ebl; }
          *(v4u*)(ketf + ((size_t)((wid * 4 + ks) * 64 + lane)) * 8) = (v4u){cvtpk(e[0], e[1]), cvtpk(e[2], e[3]), cvtpk(e[4], e[5]), cvtpk(e[6], e[7])};
      } }
    __syncthreads();
    { const int vx = tid & 63, vr0 = tid >> 6;
      bf16x8 vv[8];
#pragma unroll
      for (int p = 0; p < 8; ++p) { const int vr = vr0 + 8 * p; vv[p] = (bf16x8){0, 0, 0, 0, 0, 0, 0, 0}; if (vr < L) vv[p] = ld8_bf(GV + (row0 + vr) * 2048 + h * 512 + 8 * vx); }
#pragma unroll
      for (int p = 0; p < 8; ++p) *(LAS bf16x8*)(lds + (vr0 + 8 * p) * GP_VP + vx * 16) = vv[p]; }
    const int r32 = lane & 31, hi = lane >> 5;
    if (wid < 3) {
        const int sb = (wid == 2) ? 1 : 0, tb = (wid >= 1) ? 1 : 0;
        f32x16 p;
#pragma unroll
        for (int r = 0; r < 16; ++r) p[r] = 0.f;
#pragma unroll
        for (int kb = 0; kb < 4; ++kb) {
            bf16x8 a[4], bq[4];
#pragma unroll
            for (int k4 = 0; k4 < 4; ++k4) { const int ks = 4 * kb + k4;
                a[k4] = *(const LAS bf16x8*)(lds + GP_KD + (32 * sb + r32) * GP_QP + (16 * ks + 8 * hi) * 2);
                bq[k4] = *(const LAS bf16x8*)(lds + GP_QE + (32 * tb + r32) * GP_QP + (16 * ks + 8 * hi) * 2); }
            __builtin_amdgcn_sched_barrier(0);
#pragma unroll
            for (int k4 = 0; k4 < 4; ++k4) p = __builtin_amdgcn_mfma_f32_32x32x16_bf16(a[k4], bq[k4], p, 0, 0, 0);
        }
        const int t = 32 * tb + r32;
#pragma unroll
        for (int i = 0; i < 4; ++i) {
            float v[4];
#pragma unroll
            for (int j = 0; j < 4; ++j) { const int s = 32 * sb + 8 * i + 4 * hi + j; v[j] = (s <= t) ? p[4 * i + j] : 0.f; }
            u32x2 wv; wv.x = cvtpk(v[0], v[1]); wv.y = cvtpk(v[2], v[3]);
            *(LAS u32x2*)(lds + GP_ATT + t * GP_AP + (32 * sb + 8 * i + 4 * hi) * 2) = wv;
        }
    } else if (wid == 3) {
        for (int i = lane; i < 32 * 4; i += 64) { const int t = i >> 2, c = i & 3; *(LAS v4u*)(lds + GP_ATT + t * GP_AP + 64 + c * 16) = (v4u){0u, 0u, 0u, 0u}; }
    }
    __syncthreads();
    {
        bf16x8 af[2][4];
#pragma unroll
        for (int tb = 0; tb < 2; ++tb)
#pragma unroll
            for (int ks = 0; ks < 4; ++ks) af[tb][ks] = *(const LAS bf16x8*)(lds + GP_ATT + (32 * tb + r32) * GP_AP + (16 * ks + 8 * hi) * 2);
        const int vrow = 8 * hi + ((lane & 15) >> 2), vcol = 16 * ((lane >> 4) & 1) + 4 * (lane & 3);
#pragma unroll
        for (int cbi = 0; cbi < 2; ++cbi) {
            const int cb = 2 * wid + cbi;
            f32x16 o0, o1;
#pragma unroll
            for (int r = 0; r < 16; ++r) { o0[r] = 0.f; o1[r] = 0.f; }
            s16x4 lo[4], hh[4];
#pragma unroll
            for (int ks = 0; ks < 4; ++ks) { ldscp vp = lds + (16 * ks + vrow) * GP_VP + (32 * cb + vcol) * 2; lo[ks] = vtr(vp); hh[ks] = vtr(vp + 4 * GP_VP); }
            __builtin_amdgcn_sched_barrier(0);
#pragma unroll
            for (int ks = 0; ks < 4; ++ks) {
                const bf16x8 vb = {lo[ks][0], lo[ks][1], lo[ks][2], lo[ks][3], hh[ks][0], hh[ks][1], hh[ks][2], hh[ks][3]};
                if (ks < 2) o0 = __builtin_amdgcn_mfma_f32_32x32x16_bf16(af[0][ks], vb, o0, 0, 0, 0);
                o1 = __builtin_amdgcn_mfma_f32_32x32x16_bf16(af[1][ks], vb, o1, 0, 0, 0);
            }
            bf16* op = OI + row0 * 2048 + h * 512 + 32 * cb + r32;
#pragma unroll
            for (int r = 0; r < 16; ++r) { const int t = crow(r, hi);
                if (t < L) op[(size_t)t * 2048] = (bf16)(cvtpk(o0[r], 0.f) & 0xffffu);
                if (t + 32 < L) op[(size_t)(t + 32) * 2048] = (bf16)(cvtpk(o1[r], 0.f) & 0xffffu); }
        }
    }
    __syncthreads();
}

constexpr int GC_SP = 528, GC_SB = 32 * GC_SP, GC_VOFF = 2 * GC_SB, GC_VB = 4096;
constexpr int GC_XOFF = GC_VOFF + 2 * GC_VB, GC_XB = 8192;
struct GcQ { bf16x8 qa[4]; unsigned short oi[4]; };
struct GcK { bf16x8 ka[4]; f32x4 eb[4]; u32x2 vn; };
struct GcCtx { const bf16* QE; const bf16* KT; const bf16* GV; const float* EB; bf16* OI; size_t row0; int cid0, blk0, h, sl; };
template <int L> __device__ __forceinline__ void gc_load_q(GcQ& Q, const GcCtx& X, int c, int wid, int lane) {
    const int l15 = lane & 15, g = lane >> 4, tt = (L == 64) ? (wid & 3) : (wid & 1), kh = wid >> 2;
    const size_t r = X.row0 + (size_t)c * 64 + 16 * tt;
#pragma unroll
    for (int i = 0; i < 4; ++i) Q.qa[i] = ld8_bf(X.QE + (size_t)(X.blk0 + 4 * c) * 16384 + ((size_t)((tt * 8 + 4 * kh + i) * 64 + lane)) * 8);
#pragma unroll
    for (int i = 0; i < 4; ++i) Q.oi[i] = X.OI[(r + 4 * g + i) * 2048 + X.h * 512 + X.sl * 32 + 16 * kh + l15];
}
template <int L> __device__ __forceinline__ void gc_load_k(GcK& Kx, const GcCtx& X, int c, int cv, int tid, int wid, int lane) {
    const int hi = lane >> 5; const int cid = X.cid0 + c;
    { const int vr = (L == 64) ? (tid >> 3) : ((tid >> 3) & 31), vc = (tid & 7) * 4;
      Kx.vn = *(const u32x2*)(X.GV + (X.row0 + (size_t)cv * 64 + vr) * 2048 + X.h * 512 + X.sl * 32 + vc); }
#pragma unroll
    for (int i = 0; i < 4; ++i) Kx.eb[i] = *(const f32x4*)(X.EB + (size_t)cid * 1024 + X.h * 256 + 32 * wid + 8 * i + 4 * hi);
#pragma unroll
    for (int ks = 0; ks < 4; ++ks) Kx.ka[ks] = ld8_bf(X.KT + (size_t)(X.blk0 + 4 * c) * 16384 + ((size_t)((wid * 4 + ks) * 64 + lane)) * 8);
}
template <int L> __device__ __forceinline__ void gc_write_v(ldsp lds, int buf, u32x2 v, int tid) {
    const int vr = tid >> 3, vc = (tid & 7) * 4;
    if (L == 32 && vr >= 32) v = (u32x2){0u, 0u};
    *(LAS u32x2*)(lds + GC_VOFF + buf * GC_VB + vr * 64 + vc * 2) = v;
}
template <int L> __device__ __forceinline__ void gc_finish(ldsp lds, const f32x4& own, const GcCtx& X, int c, int wid, int lane, bool wr) {
    const int l15 = lane & 15, g = lane >> 4, tt = wid & 3, kh = wid >> 2;
    const f32x4 o = own + *(const LAS f32x4*)(lds + GC_XOFF + (c & 1) * GC_XB + ((wid ^ 4) * 64 + lane) * 16);
    if (wr && 16 * tt < L) { bf16* op = X.OI + (X.row0 + (size_t)c * 64 + 16 * tt + 4 * g) * 2048 + X.h * 512 + X.sl * 32 + 16 * kh + l15;
#pragma unroll
        for (int i = 0; i < 4; ++i) op[(size_t)i * 2048] = (bf16)(cvtpk(o[i], 0.f) & 0xffffu); }
}
template <int L, int VAR = 0, bool FIRST = false> __device__ __forceinline__ void gc_step(ldsp lds, f32x16& S, GcK& Kx, GcQ& Q, f32x4& own, const GcCtx& X, int c, int nsteps, int tid, int wid, int lane, bool wr) {
    const int r32 = lane & 31, hi = lane >> 5, l15 = lane & 15, g = lane >> 4, kh = wid >> 2, p = c & 1;
    const int c2 = (c + 2 < nsteps) ? c + 2 : nsteps - 1, c3 = (c + 3 < nsteps) ? c + 3 : nsteps - 1;
#pragma unroll
    for (int i = 0; i < 4; ++i) { u32x2 w; w.x = cvtpk(S[4 * i], S[4 * i + 1]); w.y = cvtpk(S[4 * i + 2], S[4 * i + 3]);
        *(LAS u32x2*)(lds + p * GC_SB + r32 * GC_SP + (32 * wid + 8 * i + 4 * hi) * 2) = w; }
    gc_write_v<L>(lds, p ^ 1, Kx.vn, tid);
    { const int trow = 8 * hi + ((lane & 15) >> 2), tcol = 16 * ((lane >> 4) & 1) + 4 * (lane & 3);
      s16x4 vl[4], vh[4];
#pragma unroll
      for (int ks = 0; ks < 4; ++ks) { ldscp vp = lds + GC_VOFF + p * GC_VB + (16 * ks + trow) * 64 + tcol * 2; vl[ks] = vtr(vp); vh[ks] = vtr(vp + 4 * 64); }
#pragma unroll
      for (int i = 0; i < 4; ++i)
#pragma unroll
          for (int j = 0; j < 4; ++j) S[4 * i + j] *= Kx.eb[i][j];
      __builtin_amdgcn_sched_barrier(0);
#pragma unroll
      for (int ks = 0; ks < 4; ++ks) { const bf16x8 vb = {vl[ks][0], vl[ks][1], vl[ks][2], vl[ks][3], vh[ks][0], vh[ks][1], vh[ks][2], vh[ks][3]};
          S = __builtin_amdgcn_mfma_f32_32x32x16_bf16(Kx.ka[ks], vb, S, 0, 0, 0); } }
    if (!(VAR & 1)) gc_load_k<L>(Kx, X, c2, c3, tid, wid, lane);
    __syncthreads();
    if constexpr (!FIRST) gc_finish<L>(lds, own, X, c - 1, wid, lane, wr);
    {
        bf16x8 b0[4], b1[4];
#pragma unroll
        for (int i = 0; i < 4; ++i) { b0[i] = *(const LAS bf16x8*)(lds + p * GC_SB + l15 * GC_SP + (32 * (4 * kh + i) + 8 * g) * 2);
                                      b1[i] = *(const LAS bf16x8*)(lds + p * GC_SB + (16 + l15) * GC_SP + (32 * (4 * kh + i) + 8 * g) * 2); }
        __builtin_amdgcn_sched_barrier(0);
        f32x4 pa = (f32x4){0.f, 0.f, 0.f, 0.f}, pb = pa;
#pragma unroll
        for (int i = 0; i < 4; ++i) { pa = __builtin_amdgcn_mfma_f32_16x16x32_bf16(Q.qa[i], b0[i], pa, 0, 0, 0); pb = __builtin_amdgcn_mfma_f32_16x16x32_bf16(Q.qa[i], b1[i], pb, 0, 0, 0); }
        const f32x4 oiv = (f32x4){bf2f(Q.oi[0]), bf2f(Q.oi[1]), bf2f(Q.oi[2]), bf2f(Q.oi[3])};
        own = (kh ? pb : pa) + oiv;
        *(LAS f32x4*)(lds + GC_XOFF + p * GC_XB + (wid * 64 + lane) * 16) = kh ? pa : pb;
    }
    if (!(VAR & 2)) gc_load_q<L>(Q, X, c2, wid, lane);
}
template <int L, int VAR = 0> __device__ __forceinline__ void gc_run(ldsp lds, f32x16& S, const GcCtx& X, int nsteps, int tid, int wid, int lane, bool wr) {
    GcK Ka, Kb; GcQ Qa, Qb; f32x4 own = (f32x4){0.f, 0.f, 0.f, 0.f};
    const int c1 = (1 < nsteps) ? 1 : 0, c2 = (2 < nsteps) ? 2 : nsteps - 1;
    { const int vr = (L == 64) ? (tid >> 3) : ((tid >> 3) & 31), vc = (tid & 7) * 4;
      const u32x2 v0 = *(const u32x2*)(X.GV + (X.row0 + vr) * 2048 + X.h * 512 + X.sl * 32 + vc);
      gc_load_k<L>(Ka, X, 0, c1, tid, wid, lane); gc_load_q<L>(Qa, X, 0, wid, lane);
      __syncthreads();
      gc_write_v<L>(lds, 0, v0, tid); }
    if (L == 64) { gc_load_k<L>(Kb, X, c1, c2, tid, wid, lane); gc_load_q<L>(Qb, X, c1, wid, lane); }
    __syncthreads();
    if (L == 64) {
        gc_step<L, VAR, true>(lds, S, Ka, Qa, own, X, 0, nsteps, tid, wid, lane, wr); gc_step<L, VAR>(lds, S, Kb, Qb, own, X, 1, nsteps, tid, wid, lane, wr);
        for (int c = 2; c < nsteps; c += 2) { gc_step<L, VAR>(lds, S, Ka, Qa, own, X, c, nsteps, tid, wid, lane, wr); gc_step<L, VAR>(lds, S, Kb, Qb, own, X, c + 1, nsteps, tid, wid, lane, wr); }
    } else gc_step<L, VAR, true>(lds, S, Ka, Qa, own, X, 0, 1, tid, wid, lane, wr);
    __syncthreads();
    gc_finish<L>(lds, own, X, nsteps - 1, wid, lane, wr);
}

struct Args { const float* in[N_IN]; float* out; unsigned char* ws; int ph_lo, ph_hi, dup, pad; };
static_assert(sizeof(Args) == N_IN * 8 + 8 + 8 + 16, "Args has no padding");
#ifndef PROBE_SUB
#define PROBE_SUB 7
#endif
#ifndef PROBE_DUP
#define PROBE_DUP 0
#endif
constexpr int N_PHASES = 16;

template <int K, int SUB = 7> __device__ __forceinline__ void run_phase(const Args& args, const ldsp lds, const int tid, const int lane, const int wid, const int G, const int cu, const bool wr) {
    const int gw = cu * NWAVES + wid, NGW = G * NWAVES; (void)gw; (void)NGW; (void)wr;
    unsigned char* const ws = args.ws; float* const out = args.out;
    gu32* const ctl = (gu32*)(ws + WS_CTL); (void)ctl;
    volatile LAS unsigned* const QW = (volatile LAS unsigned*)(lds + MISC_OFF + 64); (void)QW;
    bf16* const A = (bf16*)(ws + WS_A); (void)A;
    float* const H = out + O_Y; (void)H;
    bf16* const H1 = (bf16*)(out + O_Y); (void)H1;
    bf16* const H2 = (bf16*)(ws + WS_H2); (void)H2;
    if constexpr (K == 0) {
        LAS float* scr = (LAS float*)(lds + wid * 8448);
        constexpr int I0 = 32 * 352, I1 = 88 * 64, I2 = 32 * 328, I3 = 32 * 64, I4 = 32 * 192, I5 = 16 * 64, I6 = 32 * 64, I7 = 16 * 64, I8 = 32 * 64;
        constexpr int NIT = I0 + I1 + I2 + I3 + I4 + I5 + I6 + I7 + I8;
        (void)NIT; (void)I1; (void)I4; (void)I5; (void)I6; (void)I7; (void)I8;
        for (int it = gw; it < I0 + I2 + I3; it += NGW) {
            int r = it;
            if (r < I0) { cvt_item(args.in[I_F1GU], 2048, 2 * DFF, (bf16*)(ws + WS_WGU), 1, 352, r, scr, lane, args.in[I_F1PRE]); continue; } r -= I0;
            if (r < I2) { cvt_item(args.in[I_WIN], 2048, INW, (bf16*)(ws + WS_WIN), 2, 328, r, scr, lane, args.in[I_MIXPRE]); continue; } r -= I2;
            cvt_item(args.in[I_WMEMKV], 2048, 2048, (bf16*)(ws + WS_WIN) + (size_t)10496 * 2048, 0, 64, r, scr, lane);
        }
        f32x4 g1[8], gm[8];
        load_gain(args.in[I_F1PRE], g1, lane); load_gain(args.in[I_MEMNG], gm, lane);
        for (int m = gw; m < MA; m += NGW) {
            if (m < MT) { const float* xr = (m < NPT) ? args.in[I_XP] + (size_t)m * DM : args.in[I_XS] + (size_t)(m - NPT) * DM;
                thin_row<false, false, false, 1, false, true, true>(xr, nullptr, 0.f, g1, nullptr, g1, A + (size_t)m * DM, lane, true, (float*)(ctl + CW_IRS0) + m); }
            else thin_row<false, false, true>(args.in[I_MEMP] + (size_t)(m - MT) * DM, nullptr, 0.f, gm, nullptr, gm, A + (size_t)m * DM, lane);
        }
    }
    if constexpr (K == 1) {
        pg8::Gemm g{A, (const bf16*)(ws + WS_WGU), MT, 2 * DFF, DM}; pg8::StaticOrder S0; S0.init(MT, 2 * DFF, G, cu, WGM_A);
        DynTail<pg8::StaticOrder> S; S.init(S0, G, cu, ctl + CW_Q + 2048 * (K == 1 ? 0 : 5), QW);
        EpiGU E{(bf16*)(ws + WS_HID)};
        pg8::gemm_phase<EpiGU, DynTail<pg8::StaticOrder>, true, true>(lds, g, S, E);
        { __syncthreads();
          LAS float* scr = (LAS float*)(lds + wid * 8448);
          for (int it = gw; it < 88 * 64; it += NGW) cvt_item(args.in[I_F1D], DFF, DM, (bf16*)(ws + WS_WD), 0, 64, it, scr, lane); }
    }
    if constexpr (K == 2) {
        pg8::Gemm g{(const bf16*)(ws + WS_HID), (const bf16*)(ws + WS_WD), MT, DM, DFF}; OrderSplit S0; S0.init(G, cu, DFF / 64);
        DynTail<OrderSplit> S; S.init(S0, G, cu, ctl + CW_Q + 2048 * (K == 2 ? 1 : 6), QW);
        EpiF32 E{(bf16*)(ws + WS_F), (float*)(ws + WS_SLAB_F)};
        pg8::gemm_phase<EpiF32, DynTail<OrderSplit>, true, true>(lds, g, S, E);
    }
    if constexpr (K == 3) {
        f32x4 gp[8], gn[8];
        load_gain(args.in[I_F1POST], gp, lane); load_gain(args.in[I_MIXPRE], gn, lane);
        const bf16* F = (const bf16*)(ws + WS_F);
        float* const IRS1 = (float*)(ctl + CW_IRS1); const float* const IRS0 = (const float*)(ctl + CW_IRS0);
        for (int m = gw; m < NPT; m += NGW)
            thin_row<true, false, false, 1, true, true, true>(A + (size_t)m * DM, F + (size_t)m * DM, 0.5f, gp, nullptr, gn, A + (size_t)m * DM, lane, true, IRS1 + m, IRS0[m]);
        for (int m = NPT + gw; m < MT; m += NGW)
            thin_row<true, false, false, 8, true, true, true>(A + (size_t)m * DM, (const float*)(ws + WS_SLAB_F) + (size_t)(m - NPT) * DM, 0.5f, gp, nullptr, gn, A + (size_t)m * DM, lane, true, IRS1 + m, IRS0[m]);
    }
    if constexpr (K == 4) {
        pg8::Gemm g{A, (const bf16*)(ws + WS_WIN), MA, 49 * 256, DM}; OrderIN S0; S0.init(G, cu);
        DynTail<OrderIN> S; S.init(S0, G, cu, ctl + CW_Q + 2048 * 2, QW);
        EpiIN E{ws, out};
        pg8::gemm_phase<EpiIN, DynTail<OrderIN>, true, true>(lds, g, S, E);
    }
    if constexpr (K == 5) {
        const bf16* SBQ = (const bf16*)(ws + WS_SBQ); const bf16* SBK = (const bf16*)(ws + WS_SBK); const bf16* SBV = (const bf16*)(ws + WS_SBV);
        constexpr int NSBP = NBP * 8 * 32, NSBS = NBS * 8;
        if (SUB & 1) {
        for (int it = cu; it < NSBP; it += G) { const int qb = 31 - (it & 31), bh = it >> 5; sb_unit<false>(lds, bh >> 3, bh & 7, qb, SBQ, SBK, SBV, (bf16*)(ws + WS_SBQ), nullptr, nullptr, tid, wid, lane, wr); }
        for (int it = cu; it < NSBS; it += G) sb_unit<true>(lds, it >> 3, it & 7, 0, SBQ, SBK, SBV, (bf16*)(ws + WS_SBQ), args.in[I_CSBK], args.in[I_CSBV], tid, wid, lane, wr);
        }
        constexpr int NMP = NBP * 4 * 64, NMS = NBS * 4;
        if (SUB & 2) {
        for (int it = cu; it < NMP; it += G) { const int blk = it & 63, bh = it >> 6; mem_unit<false>(lds, bh >> 2, bh & 3, blk, (bf16*)(ws + WS_MQ), (const bf16*)(ws + WS_MKB), (const bf16*)(ws + WS_MVB), nullptr, nullptr, tid, wid, lane, wr); }
        for (int it = (cu + G - (NCHUNK * 4) % G) % G; it < NMS; it += G) mem_unit<true>(     lds, it >> 2, it & 3, 0, (bf16*)(ws + WS_MQ), nullptr, nullptr, args.in[I_CMK], args.in[I_CMV], tid, wid, lane, wr);
        }
        if (SUB & 4)
        for (int it = cu; it < NCHUNK * 4; it += G) gla_pre_item(lds, it >> 2, it & 3, ws, (bf16*)out, args.in[I_WA2], args.in[I_BA2], tid, wid, lane, wr);
    }
    if constexpr (K == 6) {
        const int r32 = lane & 31, hi = lane >> 5;
        GcCtx X; X.GV = (const bf16*)(ws + WS_GV); X.EB = (const float*)(ws + WS_EB); X.OI = (bf16*)(ws + WS_OINTRA);
        for (int it = cu; it < NBP * 4 * 16; it += G) {
            const int slot = it >> 3, bh = (it & 7) * 2 + (slot >> 4);
            const int sl = slot & 15, h = bh & 3, b = bh >> 2;
            f32x16 S;
#pragma unroll
            for (int r = 0; r < 16; ++r) S[r] = 0.f;
            X.QE = (const bf16*)out + FRAG_QEF; X.KT = (const bf16*)out + FRAG_KETF; X.row0 = (size_t)b * SEQ; X.cid0 = b * (SEQ / 64); X.blk0 = X.cid0 * 4 + h; X.h = h; X.sl = sl;
            gc_run<64, (SUB >> 3) & 3>(lds, S, X, SEQ / 64, tid, wid, lane, wr);
            float* so = out + O_GLA_P + ((size_t)(b * 4 + h) * 256 + 32 * wid) * 512 + sl * 32 + r32;
#pragma unroll
            for (int r = 0; r < 16; ++r) so[(size_t)crow(r, hi) * 512] = S[r];
        }
        for (int it = cu; it < NBS * 4 * 16; it += G) {
            const int sl = it & 15, h = (it >> 4) & 3, b = it >> 6;
            const float* si = args.in[I_SGLA] + ((size_t)(b * 4 + h) * 256 + 32 * wid) * 512 + sl * 32 + r32;
            f32x16 S;
#pragma unroll
            for (int r = 0; r < 16; ++r) S[r] = si[(size_t)crow(r, hi) * 512];
            X.QE = (const bf16*)(ws + WS_QEF_S); X.KT = (const bf16*)(ws + WS_KETF_S); X.row0 = (size_t)NPT + b * 32; X.cid0 = NPT / 64 + b; X.blk0 = b * 4 + h; X.h = h; X.sl = sl;
            gc_run<32>(lds, S, X, 1, tid, wid, lane, wr);
            float* so = out + O_GLA_S + ((size_t)(b * 4 + h) * 256 + 32 * wid) * 512 + sl * 32 + r32;
#pragma unroll
            for (int r = 0; r < 16; ++r) so[(size_t)crow(r, hi) * 512] = S[r];
        }
        __syncthreads();
        { LAS float* scr = (LAS float*)(lds + wid * 8448);
          constexpr int I4 = 32 * 192, I5 = 16 * 64, I6 = 32 * 64, I7 = 16 * 64, I8 = 32 * 64;
          for (int it = gw; it < I4 + I5 + I6 + I7 + I8; it += NGW) {
              int r = it;
              if (r < I4) { cvt_item(args.in[I_WGATE], 2048, 6144, (bf16*)(ws + WS_WGATE), 0, 192, r, scr, lane, args.in[I_MIXPRE]); continue; } r -= I4;
              if (r < I5) { cvt_item(args.in[I_WSB], 1024, 2048, (bf16*)(ws + WS_WSB), 0, 64, r, scr, lane); continue; } r -= I5;
              if (r < I6) { cvt_item(args.in[I_WGLA], 2048, 2048, (bf16*)(ws + WS_WGLA), 0, 64, r, scr, lane); continue; } r -= I6;
              if (r < I7) { cvt_item(args.in[I_WMEM], 1024, 2048, (bf16*)(ws + WS_WMEM), 0, 64, r, scr, lane); continue; } r -= I7;
              cvt_item(args.in[I_WOUT], 2048, 2048, (bf16*)(ws + WS_WOUT), 0, 64, r, scr, lane);
          }
          constexpr int J0 = 32 * 352, J1 = 88 * 64;
          for (int it = gw; it < J0 + J1; it += NGW) {
              if (it < J0) cvt_item(args.in[I_F2GU], 2048, 2 * DFF, (bf16*)(ws + WS_WGU), 1, 352, it, scr, lane, args.in[I_F2PRE]);
              else cvt_item(args.in[I_F2D], DFF, DM, (bf16*)(ws + WS_WD), 0, 64, it - J0, scr, lane);
          } }
    }
    if constexpr (K == 7) {
        const bf16* OI = (const bf16*)(ws + WS_OINTRA); bf16* GR = (bf16*)(ws + WS_GR);
        pg8::Gemm g{A, (const bf16*)(ws + WS_WGATE), MT, 3 * DM, DM}; pg8::StaticOrder S0; S0.init(MT, 3 * DM, G, cu, WGM_A);
        DynTail<pg8::StaticOrder> S; S.init(S0, G, cu, ctl + CW_Q + 2048 * 3, QW);
        EpiGate E{ws, args.in[I_BGATE]};
        pg8::gemm_phase<EpiGate, DynTail<pg8::StaticOrder>, true, true>(lds, g, S, E);
        __syncthreads();
        f32x4 gg0 = *(const f32x4*)(args.in[I_GLANG] + 8 * lane), gg1 = *(const f32x4*)(args.in[I_GLANG] + 8 * lane + 4);
        for (;;) {
        const unsigned mb = wave_ticket(ctl + CW_ITEM + 64, 8u, lane); if (mb >= (unsigned)MT) break;
#pragma unroll 1
        for (int m = (int)mb; m < (int)mb + 8; ++m) {
#pragma unroll
            for (int hh = 0; hh < 4; ++hh) {
                const size_t o = (size_t)m * 2048 + hh * 512 + 8 * lane;
                const v4u ow = __builtin_nontemporal_load((const v4u*)(OI + o)), rw = *(const v4u*)(GR + o);
                float x[8] = {bflo(ow.x), bfhi(ow.x), bflo(ow.y), bfhi(ow.y), bflo(ow.z), bfhi(ow.z), bflo(ow.w), bfhi(ow.w)};
                const float rr[8] = {bflo(rw.x), bfhi(rw.x), bflo(rw.y), bfhi(rw.y), bflo(rw.z), bfhi(rw.z), bflo(rw.w), bfhi(rw.w)};
                float ss = 0.f;
#pragma unroll
                for (int i = 0; i < 8; ++i) ss += x[i] * x[i];
                const float rs = __builtin_amdgcn_rsqf(wave_sum(ss) * (1.0f / 512.0f) + EPS);
#pragma unroll
                for (int i = 0; i < 8; ++i) x[i] = x[i] * rs * (i < 4 ? gg0[i] : gg1[i - 4]) * rr[i];
                v4u w; w.x = cvtpk(x[0], x[1]); w.y = cvtpk(x[2], x[3]); w.z = cvtpk(x[4], x[5]); w.w = cvtpk(x[6], x[7]);
                if (wr) *(v4u*)(GR + o) = w;
            }
        }
        }
    }
    if constexpr (K == 8) {
        { pg8::Gemm g{(const bf16*)(ws + WS_GR), (const bf16*)(ws + WS_WGLA), MT, DM, 2048}; pg8::StaticOrder S; S.init(MT, DM, G, cu, WGM_C);
          EpiBR<0> E{(const bf16*)(ws + WS_G1), (bf16*)(out + O_Y), nullptr};
          pg8::gemm_phase<EpiBR<0>, pg8::StaticOrder, true, true>(lds, g, S, E); }
        { pg8::Gemm g{(const bf16*)(ws + WS_SBQ), (const bf16*)(ws + WS_WSB), MT, DM, 1024, (const bf16*)(ws + WS_MQ), (const bf16*)(ws + WS_WMEM)};
          FusedOrder S; S.S.init(MT, DM, G, cu, WGM_C);
          EpiBR12 E{(const bf16*)(ws + WS_G0), (const bf16*)(ws + WS_G2), (bf16*)(out + O_Y), (bf16*)(ws + WS_MERGED)};
          pg8::gemm_phase<EpiBR12, FusedOrder, true, true>(lds, g, S, E); }
    }
    if constexpr (K == 9) { }
    if constexpr (K == 10) {
        pg8::Gemm g{(const bf16*)(ws + WS_MERGED), (const bf16*)(ws + WS_WOUT), MT, DM, DM}; OrderSplit S0; S0.init(G, cu, DM / 64);
        DynTail<OrderSplit> S; S.init(S0, G, cu, ctl + CW_Q + 2048 * 4, QW);
        EpiF32 E{(bf16*)(ws + WS_FO), (float*)(ws + WS_SLAB_O)};
        pg8::gemm_phase<EpiF32, DynTail<OrderSplit>, true, true>(lds, g, S, E);
    }
    if constexpr (K == 11) {
        f32x4 gp[8], gn[8];
        load_gain(args.in[I_MIXPOST], gp, lane); load_gain(args.in[I_F2PRE], gn, lane);
        const bf16* F = (const bf16*)(ws + WS_FO);
        const float* const IRS1 = (const float*)(ctl + CW_IRS1); float* const IRS2 = (float*)(ctl + CW_IRS2);
        for (int m = gw; m < NPT; m += NGW) thin_row<true, false, false, 1, true, true, true>(A + (size_t)m * DM, F + (size_t)m * DM, 1.0f, gp, nullptr, gn, A + (size_t)m * DM, lane, wr, IRS2 + m, IRS1[m]);
        for (int m = NPT + gw; m < MT; m += NGW) thin_row<true, false, false, 8, true, true, true>(A + (size_t)m * DM, (const float*)(ws + WS_SLAB_O) + (size_t)(m - NPT) * DM, 1.0f, gp, nullptr, gn, A + (size_t)m * DM, lane, wr, IRS2 + m, IRS1[m]);
    }
    if constexpr (K == 12) {
        pg8::Gemm g{A, (const bf16*)(ws + WS_WGU), MT, 2 * DFF, DM}; pg8::StaticOrder S0; S0.init(MT, 2 * DFF, G, cu, WGM_A);
        DynTail<pg8::StaticOrder> S; S.init(S0, G, cu, ctl + CW_Q + 2048 * (K == 1 ? 0 : 5), QW);
        EpiGU E{(bf16*)(ws + WS_HID)};
        pg8::gemm_phase<EpiGU, DynTail<pg8::StaticOrder>, true, true>(lds, g, S, E);
    }
    if constexpr (K == 13) {
        pg8::Gemm g{(const bf16*)(ws + WS_HID), (const bf16*)(ws + WS_WD), MT, DM, DFF}; OrderSplit S0; S0.init(G, cu, DFF / 64);
        DynTail<OrderSplit> S; S.init(S0, G, cu, ctl + CW_Q + 2048 * (K == 2 ? 1 : 6), QW);
        EpiF32 E{(bf16*)(ws + WS_F), (float*)(ws + WS_SLAB_F)};
        pg8::gemm_phase<EpiF32, DynTail<OrderSplit>, true, true>(lds, g, S, E);
    }
    if constexpr (K == 14) {
        f32x4 gp[8];
        load_gain(args.in[I_F2POST], gp, lane);
        const bf16* F = (const bf16*)(ws + WS_F);
        const float* const IRS2 = (const float*)(ctl + CW_IRS2);
        for (int m = gw; m < NPT; m += NGW) thin_row<true, true, false, 1, true, false>(A + (size_t)m * DM, F + (size_t)m * DM, 0.5f, gp, H + (size_t)m * DM, gp, nullptr, lane, wr, nullptr, IRS2[m]);
        for (int m = NPT + gw; m < MT; m += NGW) thin_row<true, true, false, 8, true, false>(A + (size_t)m * DM, (const float*)(ws + WS_SLAB_F) + (size_t)(m - NPT) * DM, 0.5f, gp, H + (size_t)m * DM, gp, nullptr, lane, wr, nullptr, IRS2[m]);
    }
}

__global__ void __launch_bounds__(NTHR, 2) fwd_kernel(Args args) {
    extern __shared__ __attribute__((aligned(16))) unsigned char lds_raw[];
    const ldsp lds = (ldsp)lds_raw;
    volatile LAS unsigned* MISC = (volatile LAS unsigned*)(lds + MISC_OFF);
    const int tid = threadIdx.x, lane = tid & 63, wid = __builtin_amdgcn_readfirstlane(tid >> 6);
    const int G = gridDim.x, cu = blockIdx.x;
    gu32* ctl = (gu32*)(args.ws + WS_CTL);
    for (int u = tid; u < (LDS_BYTES - LDSCTL_OFF) / 4; u += NTHR) ((LAS unsigned*)(lds + LDSCTL_OFF))[u] = 0u;
    __syncthreads();
    XcdBarrier bar; bar.bar = (unsigned*)(ctl + CW_BAR); bar.x = 0; bar.st = nullptr;
    bar = xcd_barrier_post((unsigned*)(ctl + CW_BAR), MISC + 8);
    const int lo = args.ph_lo, hi_ph = args.ph_hi;
#define IN(k) (lo <= (k) && (k) < hi_ph)
#define PHASE(k) do { if (IN(k)) { if constexpr ((PROBE_DUP >> (k)) & 1) { run_phase<k, PROBE_SUB>(args, lds, tid, lane, wid, G, cu, args.pad != 0); xcd_barrier(bar); } \
        run_phase<k>(args, lds, tid, lane, wid, G, cu, true); } } while (0)
#if defined(PROBE_BWMASK)
    long long bw_sum = 0;
#define SEAM(k) do { const long long b0_ = wall_clock64(); xcd_barrier(bar); if ((PROBE_BWMASK >> (k)) & 1) bw_sum += wall_clock64() - b0_; } while (0)
#else
#define SEAM(k) xcd_barrier(bar)
#endif
    PHASE(0); SEAM(0); PHASE(1); SEAM(1); PHASE(2); SEAM(2); PHASE(3); SEAM(3); PHASE(4); SEAM(4); PHASE(5); SEAM(5); PHASE(6); SEAM(6); PHASE(7); SEAM(7);
    PHASE(8); PHASE(9); SEAM(9); PHASE(10); SEAM(10); PHASE(11); SEAM(11); PHASE(12); SEAM(12); PHASE(13); SEAM(13); PHASE(14);
#if defined(PROBE_BWMASK)
    if (tid == 0) atomicAdd((unsigned long long*)(args.ws + WS_CTL + 786432), (unsigned long long)bw_sum);
    xcd_barrier(bar);
    if (blockIdx.x == 0 && tid == 0) {
        const unsigned long long tot = __hip_atomic_load((unsigned long long*)(args.ws + WS_CTL + 786432), __ATOMIC_RELAXED, __HIP_MEMORY_SCOPE_AGENT);
        const long long spin_ticks = (long long)(tot / gridDim.x) * 10;
        const long long s0 = wall_clock64();
        while (wall_clock64() - s0 < spin_ticks) __builtin_amdgcn_s_sleep(8);
    }
#endif
#undef SEAM
#undef PHASE
#undef IN
}

extern "C" void kernel_launch(void* const* d_in, const int* in_sizes, int n_in, void* d_out, int out_size, void* d_ws, size_t ws_size, hipStream_t stream) {
    static int grid = 0;
    if (grid == 0) {
        if (n_in != N_IN || (size_t)out_size != O_END || ws_size < WS_END) { fprintf(stderr, "kernel_launch: unexpected sizes (n_in %d, out %d, ws %zu)\n", n_in, out_size, ws_size); grid = -1; return; }
        int dev = 0, cus = 0, per_cu = 0;
        if (hipGetDevice(&dev) != hipSuccess || hipDeviceGetAttribute(&cus, hipDeviceAttributeMultiprocessorCount, dev) != hipSuccess) { grid = -1; return; }
        if (hipFuncSetAttribute((const void*)fwd_kernel, hipFuncAttributeMaxDynamicSharedMemorySize, LDS_BYTES) != hipSuccess) { fprintf(stderr, "kernel_launch: hipFuncSetAttribute failed\n"); grid = -1; return; }
        if (hipOccupancyMaxActiveBlocksPerMultiprocessor(&per_cu, (const void*)fwd_kernel, NTHR, LDS_BYTES) != hipSuccess || per_cu < 1) fprintf(stderr, "kernel_launch: occupancy query says %d\n", per_cu);
        (void)hipGetLastError();
        grid = cus;
    }
    if (grid < 0) return;
    (void)hipMemsetAsync((char*)d_ws + WS_CTL, 0, CTL_ZERO_BYTES, stream);
    Args a{};
    for (int i = 0; i < N_IN; ++i) a.in[i] = (const float*)d_in[i];
    a.out = (float*)d_out; a.ws = (unsigned char*)d_ws;
    a.dup = PROBE_DUP; a.pad = 0;
    a.ph_lo = 0; a.ph_hi = N_PHASES;
    hipLaunchKernelGGL(fwd_kernel, dim3(grid), dim3(NTHR), LDS_BYTES, stream, a);
}
```

```cpp
#include <hip/hip_runtime.h>
#include <cstdio>
#include <cstdint>
#ifndef PROBE_EPI2
#define PROBE_EPI2 0
#endif
namespace pg8 {
#define PG8_LAS __attribute__((address_space(3)))
typedef unsigned short bf16_t;
typedef short bf16x8 __attribute__((ext_vector_type(8)));
typedef float f32x4 __attribute__((ext_vector_type(4)));
typedef unsigned u32x4 __attribute__((ext_vector_type(4)));
constexpr int BM = 256, BK = 64, HALF = 128, HTB = HALF * BK * 2  , STAGE_BYTES = 8 * HTB, NXCD = 8, WGM = 8;

__host__ __device__ __forceinline__ int lds_byte(int r, int c) { const int st = (r >> 4) * 2 + (c >> 5), rr = r & 15, cc = c & 31, ob = rr * 64 + cc * 2; return st * 1024 + (ob ^ (((ob >> 9) & 1) << 5)); }
__host__ __device__ __forceinline__ void stage_rc(int b, int& R, int& C) { const int st = b / 1024, sb = b % 1024, swz = sb ^ (((sb >> 9) & 1) << 5); R = (st >> 1) * 16 + swz / 64; C = (st & 1) * 32 + (swz % 64) / 2; }
__host__ __device__ __forceinline__ int perm32(int rho) { const int n = rho >> 4, i = rho & 15; return 8 * (i >> 2) + 4 * n + (i & 3); }

struct Unit { int pm, pn, kx = 0;
    __host__ __device__ int kt0() const { return kx & 0xfff; } __host__ __device__ int knt() const { return (kx >> 12) & 0xfff; } __host__ __device__ int sl() const { return (kx >> 24) - 1; } };
struct Gemm { const bf16_t* A; const bf16_t* Bt; int M, N, K; };

struct StaticOrder {
    int nM, nN, nwg, G, c, wgm;
    __host__ __device__ void init(int M, int N, int G_, int c_, int wgm_ = WGM) { nM = M / BM; nN = N / BM; nwg = nM * nN; G = G_; c = c_; wgm = wgm_; }
    __host__ __device__ bool next(int i, Unit& u) const { return map((long)i * G + c, u); }
    __device__ __forceinline__ int total() const { return nwg; }
    __device__ __forceinline__ bool first(Unit& u) const { return next(0, u); }
    __device__ __forceinline__ bool peek(int i, Unit& u, bool& pend) const { pend = false; return next(i, u); }
    __device__ __forceinline__ bool fetch(Unit&) const { return false; }
    __host__ __device__ bool map(long L, Unit& u) const {
        if (L >= nwg) return false;
        int wgid = (int)L; { const int q = nwg / NXCD, r = nwg % NXCD, xcd = wgid % NXCD, off = wgid / NXCD; wgid = (xcd < r ? xcd * (q + 1) : r * (q + 1) + (xcd - r) * q) + off; }
        const int nig = wgm * nN, gid = wgid / nig, fm = gid * wgm, gsz = (nM - fm) < wgm ? (nM - fm) : wgm;
        u.pm = fm + ((wgid % nig) % gsz); u.pn = (wgid % nig) / gsz; u.kx = 0; return true;
    }
    __device__ __forceinline__ void a_ready(const Unit&) const {}
    __device__ __forceinline__ void done(const Unit&) const {}
};
__device__ __forceinline__ unsigned cvt_pk_bf16(float lo, float hi) { unsigned r; asm volatile("v_cvt_pk_bf16_f32 %0, %1, %2" : "=v"(r) : "v"(lo), "v"(hi)); return r; }
typedef float f32x2 __attribute__((ext_vector_type(2)));
template <class Epi, class Sched, bool ALIGN_EPI = false, bool SP2 = false>
__device__ __forceinline__ void gemm_phase(PG8_LAS unsigned char* lds, const Gemm g, const Sched& S, const Epi& E) {
    const int tid = threadIdx.x, wid = __builtin_amdgcn_readfirstlane(tid >> 6), lane = tid & 63, wr = wid >> 2, wc = wid & 3, fr = lane & 15, fq = lane >> 4;
    const int K = g.K;
    unsigned voffA[2], voffB[2];
#pragma unroll
    for (int i = 0; i < 2; ++i) { int R, C; stage_rc(tid * 16 + i * 8192, R, C); const int Rb = Epi::PERM ? ((R & ~31) + perm32(R & 31)) : R;
        voffA[i] = (unsigned)(R * K + C) * 2u; voffB[i] = (unsigned)(Rb * K + C) * 2u; }
    const size_t kstep = (size_t)(BK * 2);
    const size_t hstep = (size_t)HALF * K * 2;
    const size_t tstep = 2 * hstep;
    const unsigned ldsw = (unsigned)wid * 1024u;
    const int aoff = lds_byte(wr * 64 + fr, fq * 8), boff = lds_byte(wc * 32 + fr, fq * 8);
#define PG8_SA(b, h) (((b) * 2 + (h)) * HTB)
#define PG8_SB(b, h) ((4 + (b) * 2 + (h)) * HTB)
#define PG8_STAGE(bufoff, gbase, voff) do { _Pragma("unroll") for (int _i = 0; _i < 2; ++_i) \
        __builtin_amdgcn_global_load_lds((const unsigned*)((const char*)(gbase) + (voff)[_i]), (PG8_LAS unsigned*)(lds + (bufoff) + ldsw + _i * 8192), 16, 0, 0); } while (0)
#define PG8_LDA(dst, b, h) do { _Pragma("unroll") for (int m = 0; m < 4; ++m) _Pragma("unroll") for (int k = 0; k < 2; ++k) dst[m][k] = *(const PG8_LAS bf16x8*)(lds + PG8_SA(b, h) + aoff + m * 2048 + k * 1024); } while (0)
#define PG8_LDB(dst, b, h) do { _Pragma("unroll") for (int n = 0; n < 2; ++n) _Pragma("unroll") for (int k = 0; k < 2; ++k) dst[n][k] = *(const PG8_LAS bf16x8*)(lds + PG8_SB(b, h) + boff + n * 2048 + k * 1024); } while (0)
#define PG8_MMA(ai, bj, At, Bt) do { __builtin_amdgcn_s_setprio(1); _Pragma("unroll") for (int m = 0; m < 4; ++m) _Pragma("unroll") for (int n = 0; n < 2; ++n) _Pragma("unroll") for (int k = 0; k < 2; ++k) \
        acc[ai][bj][m][n] = __builtin_amdgcn_mfma_f32_16x16x32_bf16(Bt[n][k], At[m][k], acc[ai][bj][m][n], 0, 0, 0); __builtin_amdgcn_s_setprio(0); } while (0)
#define PG8_WAIT_V(n) asm volatile("s_waitcnt vmcnt(" #n ")" ::: "memory")
#define PG8_WAIT_L(n) asm volatile("s_waitcnt lgkmcnt(" #n ")" ::: "memory")
#define PG8_BAR __builtin_amdgcn_s_barrier()
#define PG8_SCHED __builtin_amdgcn_sched_barrier(0)
    Unit cur, nxt; int ui = 0;
    if (!S.first(cur)) return;
    f32x4 acc[2][2][4][2];
#pragma unroll
    for (int a = 0; a < 2; ++a)
#pragma unroll
        for (int b = 0; b < 2; ++b)
#pragma unroll
            for (int m = 0; m < 4; ++m)
#pragma unroll
                for (int n = 0; n < 2; ++n) acc[a][b][m][n] = (f32x4){0.f, 0.f, 0.f, 0.f};
    bf16x8 At[4][2], B0[2][2], B1[2][2];
    const char* cA = (const char*)g.A + (size_t)cur.pm * tstep + (size_t)cur.kt0() * (BK * 2); const char* cB = (const char*)g.Bt + (size_t)cur.pn * tstep + (size_t)cur.kt0() * (BK * 2);
    int nt = cur.kx ? cur.knt() : K / BK;
    S.a_ready(cur);
    if constexpr (SP2) {
        PG8_STAGE(PG8_SB(0, 0), cB, voffB); PG8_STAGE(PG8_SB(0, 1), cB + hstep, voffB); PG8_STAGE(PG8_SA(0, 0), cA, voffA); PG8_STAGE(PG8_SA(0, 1), cA + hstep, voffA);
        if (wr == 1) PG8_BAR;
        PG8_WAIT_V(2); PG8_BAR;
        PG8_STAGE(PG8_SB(1, 0), cB + kstep, voffB); PG8_STAGE(PG8_SA(1, 0), cA + kstep, voffA); PG8_STAGE(PG8_SB(1, 1), cB + hstep + kstep, voffB);
        PG8_WAIT_V(6); PG8_BAR;
    } else {
        PG8_STAGE(PG8_SB(0, 0), cB, voffB); PG8_STAGE(PG8_SA(0, 0), cA, voffA); PG8_STAGE(PG8_SB(0, 1), cB + hstep, voffB); PG8_STAGE(PG8_SA(0, 1), cA + hstep, voffA);
        if (wr == 1) PG8_BAR;
        PG8_WAIT_V(4); PG8_BAR;
        PG8_STAGE(PG8_SB(1, 0), cB + kstep, voffB); PG8_STAGE(PG8_SA(1, 0), cA + kstep, voffA); PG8_STAGE(PG8_SB(1, 1), cB + hstep + kstep, voffB);
        PG8_WAIT_V(6); PG8_BAR;
    }
    for (;;) {
        bool pend = false; bool has_next = S.peek(ui + 1, nxt, pend);
        const char* nA = has_next ? (const char*)g.A + (size_t)nxt.pm * tstep + (size_t)nxt.kt0() * (BK * 2) : cA; const char* nB = has_next ? (const char*)g.Bt + (size_t)nxt.pn * tstep + (size_t)nxt.kt0() * (BK * 2) : cB;
        const int tf = nt > 4 ? nt - 4 : 0;
        for (int t = 0; t < nt; t += 2) {
            if (pend && t == tf) {
                pend = false; has_next = S.fetch(nxt);
                if (has_next) { nA = (const char*)g.A + (size_t)nxt.pm * tstep + (size_t)nxt.kt0() * (BK * 2); nB = (const char*)g.Bt + (size_t)nxt.pn * tstep + (size_t)nxt.kt0() * (BK * 2); }
            }
            const bool last = (t == nt - 2);
            const char* a1 = cA + (size_t)(t + 1) * kstep;
            const char* a2 = last ? nA : cA + (size_t)(t + 2) * kstep; const char* b2 = last ? nB : cB + (size_t)(t + 2) * kstep;
            const char* a3 = a2 + kstep; const char* b3 = b2 + kstep;
            if (last && has_next) S.a_ready(nxt);
            if constexpr (SP2) {
            PG8_LDB(B0, 0, 0); PG8_LDB(B1, 0, 1); PG8_SCHED; PG8_LDA(At, 0, 0); PG8_STAGE(PG8_SA(1, 1), a1 + hstep, voffA);
            PG8_WAIT_V(8); PG8_WAIT_L(0); PG8_BAR; PG8_MMA(0, 0, At, B0); PG8_MMA(0, 1, At, B1); PG8_BAR; PG8_SCHED;
            PG8_LDA(At, 0, 1); PG8_STAGE(PG8_SB(0, 0), b2, voffB); PG8_STAGE(PG8_SB(0, 1), b2 + hstep, voffB); PG8_STAGE(PG8_SA(0, 0), a2, voffA);
            PG8_WAIT_V(8); PG8_WAIT_L(0); PG8_BAR; PG8_MMA(1, 0, At, B0); PG8_MMA(1, 1, At, B1); PG8_BAR; PG8_SCHED;
            PG8_LDB(B0, 1, 0); PG8_LDB(B1, 1, 1); PG8_SCHED; PG8_LDA(At, 1, 0); PG8_STAGE(PG8_SA(0, 1), a2 + hstep, voffA);
            PG8_WAIT_V(8); PG8_WAIT_L(0); PG8_BAR; PG8_MMA(0, 0, At, B0); PG8_MMA(0, 1, At, B1); PG8_BAR; PG8_SCHED;
            PG8_LDA(At, 1, 1); PG8_STAGE(PG8_SB(1, 0), b3, voffB); PG8_STAGE(PG8_SB(1, 1), b3 + hstep, voffB); PG8_STAGE(PG8_SA(1, 0), a3, voffA);
            PG8_WAIT_V(8); PG8_WAIT_L(0); PG8_BAR; PG8_MMA(1, 0, At, B0); PG8_MMA(1, 1, At, B1); PG8_BAR; PG8_SCHED;
            } else {
            PG8_LDB(B0, 0, 0); PG8_SCHED; PG8_LDA(At, 0, 0); PG8_STAGE(PG8_SA(1, 1), a1 + hstep, voffA);
            PG8_WAIT_L(8); PG8_BAR; PG8_WAIT_L(0); PG8_MMA(0, 0, At, B0); PG8_BAR; PG8_SCHED;
            PG8_LDB(B1, 0, 1); PG8_STAGE(PG8_SB(0, 0), b2, voffB);
            PG8_BAR; PG8_WAIT_L(0); PG8_MMA(0, 1, At, B1); PG8_BAR;
            PG8_LDA(At, 0, 1); PG8_STAGE(PG8_SA(0, 0), a2, voffA);
            PG8_BAR; PG8_WAIT_L(0); PG8_MMA(1, 0, At, B0); PG8_BAR; PG8_SCHED;
            PG8_STAGE(PG8_SB(0, 1), b2 + hstep, voffB);
            PG8_WAIT_V(6); PG8_BAR; PG8_MMA(1, 1, At, B1); PG8_BAR;
            PG8_LDB(B0, 1, 0); PG8_SCHED; PG8_LDA(At, 1, 0); PG8_STAGE(PG8_SA(0, 1), a2 + hstep, voffA);
            PG8_WAIT_L(8); PG8_BAR; PG8_WAIT_L(0); PG8_MMA(0, 0, At, B0); PG8_BAR; PG8_SCHED;
            PG8_LDB(B1, 1, 1); PG8_STAGE(PG8_SB(1, 0), b3, voffB);
            PG8_BAR; PG8_WAIT_L(0); PG8_MMA(0, 1, At, B1); PG8_BAR;
            PG8_LDA(At, 1, 1); PG8_STAGE(PG8_SA(1, 0), a3, voffA);
            PG8_BAR; PG8_WAIT_L(0); PG8_MMA(1, 0, At, B0); PG8_BAR; PG8_SCHED;
            PG8_STAGE(PG8_SB(1, 1), b3 + hstep, voffB);
            PG8_WAIT_V(6); PG8_BAR; PG8_MMA(1, 1, At, B1); PG8_BAR;
            }
        }
        if constexpr (ALIGN_EPI) { if (wr == 0) PG8_BAR; }
        if constexpr (!Epi::AFTER_DRAIN) { E(acc, cur, wr, wc, fr, fq);
#if PROBE_EPI2
            if constexpr (Epi::IDEMP) { asm volatile("" ::: "memory"); E(acc, cur, wr, wc, fr, fq); }
#endif
            S.done(cur); }
        if (!has_next) break;
#pragma unroll
        for (int a = 0; a < 2; ++a)
#pragma unroll
            for (int b = 0; b < 2; ++b)
#pragma unroll
                for (int m = 0; m < 4; ++m)
#pragma unroll
                    for (int n = 0; n < 2; ++n) acc[a][b][m][n] = (f32x4){0.f, 0.f, 0.f, 0.f};
        cur = nxt; cA = nA; cB = nB; ++ui; nt = cur.kx ? cur.knt() : K / BK;
        if constexpr (ALIGN_EPI) { if (wr == 1) PG8_BAR; }
    }
    PG8_WAIT_V(0);
    if constexpr (!ALIGN_EPI) { if (wr == 0) PG8_BAR; }
    PG8_BAR;
    if constexpr (Epi::AFTER_DRAIN) { E.fused(acc, cur, wr, wc, fr, fq, lds, wid, lane); S.done(cur); }
#undef PG8_SA
#undef PG8_SB
#undef PG8_STAGE
#undef PG8_LDA
#undef PG8_LDB
#undef PG8_MMA
#undef PG8_WAIT_V
#undef PG8_WAIT_L
#undef PG8_BAR
#undef PG8_SCHED
}
}
#define GAS __attribute__((address_space(1)))
#define LAS __attribute__((address_space(3)))
typedef unsigned short bf16;
typedef unsigned v4u __attribute__((ext_vector_type(4)));
typedef float f32x4 __attribute__((ext_vector_type(4)));
typedef short bf16x8 __attribute__((ext_vector_type(8)));
typedef GAS unsigned gu32;
typedef GAS unsigned long long gu64;
#define RLX_AGENT __ATOMIC_RELAXED, __HIP_MEMORY_SCOPE_AGENT
#define LDS_WAIT() asm volatile("s_waitcnt lgkmcnt(0)" ::: "memory")
#define VM_WAIT() asm volatile("s_waitcnt vmcnt(0)" ::: "memory")
__device__ __forceinline__ unsigned long long rt() { return __builtin_amdgcn_s_memrealtime(); }
__device__ __forceinline__ unsigned f2bf(float f) { unsigned u = __builtin_bit_cast(unsigned, f); return (u + 0x7fffu + ((u >> 16) & 1u)) >> 16; }
__device__ __forceinline__ unsigned pk2(float lo, float hi) { return f2bf(lo) | (f2bf(hi) << 16); }

#define XB_TMO      128
#define XB_XCNT(j)  (256  + 64 * (j))
#define XB_XSUB(j)  (1280 + 64 * (j))
#define XB_XGEN(j)  (2304 + 64 * (j))
#define XB_TOP      3328
#define XB_TOPGEN   3392
#define XCD_BAR_WORDS 3456
#define XB_SPIN_CAP (1u << 18)

__device__ __forceinline__ unsigned xb_ld(unsigned* p)              { return __hip_atomic_load(p, __ATOMIC_RELAXED, __HIP_MEMORY_SCOPE_AGENT); }
__device__ __forceinline__ unsigned xb_add(unsigned* p, unsigned v) { return __hip_atomic_fetch_add(p, v, __ATOMIC_RELAXED, __HIP_MEMORY_SCOPE_AGENT); }
__device__ __forceinline__ unsigned xb_xcc_id() { return (unsigned)__builtin_amdgcn_s_getreg((3 << 11) | 20) & 0xFu; }
#define XB_SPIN(cond, bar) do { unsigned _sp = 0; while (cond) { __builtin_amdgcn_s_sleep(1); \
    if ((++_sp & 255u) == 0u) { if (xb_ld(&(bar)[XB_TMO])) break; if (_sp > XB_SPIN_CAP) { atomicAdd(&(bar)[XB_TMO], 1u); break; } } } } while (0)

struct XcdBarrier {
    unsigned* bar; unsigned x;
    volatile LAS unsigned* st;
};

__device__ __forceinline__ XcdBarrier xcd_barrier_post(unsigned* bar, volatile LAS unsigned* st) {
    XcdBarrier b; b.bar = bar; b.x = xb_xcc_id(); b.st = st;
    if (threadIdx.x == 0) (void)xb_add(&bar[XB_XCNT(b.x)], 1u);
    return b;
}
__device__ __forceinline__ void xcd_barrier_complete(unsigned* bar, unsigned x, unsigned& nloc, unsigned& nx) {
    const unsigned G = gridDim.x * gridDim.y * gridDim.z;
    unsigned sum, cnt, mine, sp = 0u;
    for (;;) {
        sum = 0u; cnt = 0u; mine = 0u;
#pragma unroll
        for (unsigned j = 0; j < 16; ++j) { const unsigned c = xb_ld(&bar[XB_XCNT(j)]); sum += c; cnt += (c > 0u) ? 1u : 0u; mine = (j == x) ? c : mine; }
        if (sum == G) break;
        __builtin_amdgcn_s_sleep(1);
        if ((++sp & 255u) == 0u) { if (xb_ld(&bar[XB_TMO])) break; if (sp > XB_SPIN_CAP) { atomicAdd(&bar[XB_TMO], 1u); break; } }
    }
    nloc = mine > 0u ? mine : 1u; nx = cnt > 0u ? cnt : 1u;
}

__device__ __forceinline__ void xcd_barrier(const XcdBarrier& b) {
    asm volatile("s_waitcnt vmcnt(0)" ::: "memory");
    __syncthreads();
    if (threadIdx.x == 0) {
        unsigned* bar = b.bar;
        __builtin_amdgcn_s_waitcnt(0);
        unsigned nloc = b.st[0], nx = b.st[1];
        if (nloc == 0u) { xcd_barrier_complete(bar, b.x, nloc, nx); b.st[0] = nloc; b.st[1] = nx; }
        const unsigned old = xb_add(&bar[XB_XSUB(b.x)], 1u);
        const unsigned gen = old / nloc;
        if (old + 1u == (gen + 1u) * nloc) {
            __builtin_amdgcn_fence(__ATOMIC_RELEASE, "agent");
            asm volatile("s_waitcnt vmcnt(0)" ::: "memory");
            const unsigned og = xb_add(&bar[XB_TOP], 1u);
            const unsigned tg = og / nx;
            if (og + 1u == (tg + 1u) * nx) xb_add(&bar[XB_TOPGEN], 1u);
            else XB_SPIN(xb_ld(&bar[XB_TOPGEN]) == tg, bar);
            __builtin_amdgcn_fence(__ATOMIC_ACQUIRE, "agent");
            xb_add(&bar[XB_XGEN(b.x)], 1u);
            asm volatile("s_waitcnt vmcnt(0)" ::: "memory");
        } else {
            XB_SPIN(xb_ld(&bar[XB_XGEN(b.x)]) == gen, bar);
            __builtin_amdgcn_fence(__ATOMIC_ACQUIRE, "agent");
            asm volatile("s_waitcnt vmcnt(0)" ::: "memory");
        }
    }
    __syncthreads();
}

typedef float f32x16 __attribute__((ext_vector_type(16)));
typedef float f32x2v __attribute__((ext_vector_type(2)));
typedef short s16x4 __attribute__((ext_vector_type(4)));
typedef short v4i16_t __attribute__((ext_vector_type(4)));
typedef unsigned u32x2 __attribute__((ext_vector_type(2)));
typedef LAS unsigned char* ldsp;
typedef const LAS unsigned char* ldscp;

constexpr int NWAVES = 8, NTHR = 512;
#ifndef MK_ONE_LAUNCH
#define MK_ONE_LAUNCH 1
#endif

constexpr int DM = 2048, DFF = 5632, SEQ = 8192, NBP = 4, NPT = NBP * SEQ, NBS = 32, DSEQ = 32, NST = NBS * DSEQ, PAST = 1024;
constexpr int MT = NPT + NST;
constexpr int MEMR = 1024, MA = MT + MEMR;
constexpr int INW = 10256;
constexpr int NCHUNK = NPT / 64 + NBS;
constexpr float EPS = 1e-6f, LOG2E = 1.4426950408889634f, LN2 = 0.6931471805599453f;
constexpr float C_SB = 0.08838834764831845f * LOG2E;
constexpr float C_MEM = 0.0625f * LOG2E;
constexpr float C_GQ = 0.0625f;
constexpr float SB_THR = 8.470329472543003e-22f;

enum { I_XP = 0, I_XS, I_MEMP, I_CSBK, I_CSBV, I_SGLA, I_CMK, I_CMV, I_F1PRE, I_F1GU, I_F1D, I_F1POST, I_MIXPRE, I_WIN, I_WA2, I_BA2, I_GLANG, I_MEMNG,
       I_WMEMKV, I_WSB, I_WGLA, I_WMEM, I_WGATE, I_BGATE, I_WOUT, I_MIXPOST, I_F2PRE, I_F2GU, I_F2D, I_F2POST, N_IN };
constexpr size_t O_Y = 0, O_SBK_P = (size_t)MT * DM, O_SBV_P = O_SBK_P + (size_t)NPT * 1024, O_GLA_P = O_SBV_P + (size_t)NPT * 1024,
                 O_MEMK_P = O_GLA_P + (size_t)NBP * 4 * 256 * 512, O_MEMV_P = O_MEMK_P + (size_t)MEMR * 1024, O_SBK_S = O_MEMV_P + (size_t)MEMR * 1024,
                 O_SBV_S = O_SBK_S + (size_t)NST * 1024, O_GLA_S = O_SBV_S + (size_t)NST * 1024, O_END = O_GLA_S + (size_t)NBS * 4 * 256 * 512;
static_assert(O_END == 159383552ull, "d_out size");

constexpr size_t MiB = 1ull << 20;
constexpr size_t WS_CTL = 0, CTL_ZERO_BYTES = 1 * MiB;
constexpr size_t WS_WGU = 1 * MiB;
constexpr size_t WS_WD = 45 * MiB;
constexpr size_t WS_WIN = 67 * MiB;
constexpr size_t WS_WGATE = 116 * MiB;
constexpr size_t WS_WSB = 140 * MiB, WS_WGLA = 144 * MiB, WS_WMEM = 152 * MiB, WS_WOUT = 156 * MiB;
constexpr size_t WS_A = 164 * MiB;
constexpr size_t WS_HID = 300 * MiB;
constexpr size_t WS_F = 663 * MiB;
constexpr size_t WS_OINTRA = 300 * MiB;
constexpr size_t WS_SBQ = 432 * MiB, WS_SBK = 498 * MiB, WS_SBV = 564 * MiB, WS_GQ = 630 * MiB, WS_GK = 696 * MiB, WS_GV = 762 * MiB, WS_GR = 894 * MiB, WS_MQ = 1026 * MiB;
constexpr size_t WS_GA = 1092 * MiB;
constexpr size_t WS_EB = 1095 * MiB;
constexpr size_t WS_MKB = 1098 * MiB, WS_MVB = 1100 * MiB, WS_END = 1110 * MiB;
constexpr size_t WS_MRG = 164 * MiB;
constexpr size_t WS_G0 = WS_SBK, WS_G1 = WS_GQ, WS_G2 = WS_GV;
constexpr size_t WS_MERGED = WS_OINTRA;
constexpr size_t WS_FO = 762 * MiB;
static_assert(WS_A + (size_t)MA * DM * 2 <= WS_HID && WS_HID + (size_t)MT * DFF * 2 <= WS_F && WS_F + (size_t)MT * DM * 4 <= WS_GA, "ws map 1");
static_assert(WS_OINTRA + (size_t)MT * DM * 2 <= WS_SBQ && WS_MQ + (size_t)MT * 1024 * 2 <= WS_GA && WS_GA + (size_t)MT * 64 <= WS_EB && WS_EB + (size_t)NCHUNK * 4096 <= WS_MKB, "ws map 2");
static_assert(WS_MRG + (size_t)MT * DM * 4 <= WS_SBQ && WS_FO + (size_t)MT * DM * 4 <= WS_MQ && WS_WIN + 12544ull * 4096 <= WS_WGATE && WS_WGU + 11264ull * 4096 <= WS_WD && WS_WD + 2048ull * 11264 <= WS_WIN, "ws map 3");
constexpr size_t FRAG_KETF = (size_t)MT * DM, FRAG_QEF = FRAG_KETF + 512ull * 4 * 16384;
constexpr size_t WS_KETF_S = 1102 * MiB, WS_QEF_S = 1106 * MiB;
static_assert((FRAG_QEF + 512ull * 4 * 16384) * 2 <= (size_t)MT * DM * 4, "fragment buffers fit in the y rows");
constexpr size_t WS_H2 = 894 * MiB;
constexpr size_t WS_SLAB_F = 1026 * MiB;
constexpr size_t WS_SLAB_O = 1026 * MiB;
static_assert(WS_SLAB_F + 8ull * NST * DM * 4 <= WS_GA && WS_SLAB_O + 8ull * NST * DM * 4 <= WS_GA && WS_F + (size_t)MT * DM * 2 <= WS_H2 && WS_FO + (size_t)MT * DM * 2 <= WS_H2 && WS_H2 + (size_t)MT * DM * 2 <= WS_SLAB_F && WS_HID + (size_t)MT * DFF * 2 <= WS_F, "slabs / H2");
constexpr int CW_TMO = 0, CW_BAR = 4096, CW_Q = 32768, CW_ITEM = 65536, CW_IRS0 = 98304, CW_IRS1 = 163840, CW_IRS2 = 198656;

constexpr int LDS_BYTES = 155648;
constexpr int LDSCTL_OFF = 151552;
constexpr int MISC_OFF = LDSCTL_OFF + 320;

__device__ __forceinline__ float wave_sum(float v) {
#pragma unroll
    for (int o = 1; o < 64; o <<= 1) v += __shfl_xor(v, o);
    return v;
}
__device__ __forceinline__ float fexp2(float x) { return __builtin_amdgcn_exp2f(x); }
__device__ __forceinline__ float flog2(float x) { return __builtin_amdgcn_logf(x); }
__device__ __forceinline__ float frcp(float x) { return __builtin_amdgcn_rcpf(x); }
__device__ __forceinline__ float sigmoidf_(float x) { return frcp(1.0f + fexp2(-x * LOG2E)); }
typedef __bf16 bf16x2_t __attribute__((ext_vector_type(2)));
__device__ __forceinline__ unsigned cvtpk(float lo, float hi) { f32x2v v = {lo, hi}; bf16x2_t b = __builtin_convertvector(v, bf16x2_t); return __builtin_bit_cast(unsigned, b); }
__device__ __forceinline__ float bf2f(unsigned short b) { return __uint_as_float(((unsigned)b) << 16); }
__device__ __forceinline__ float bflo(unsigned w) { return __uint_as_float(w << 16); }
__device__ __forceinline__ float bfhi(unsigned w) { return __uint_as_float(w & 0xffff0000u); }
__device__ __forceinline__ s16x4 vtr(ldscp p) { return __builtin_bit_cast(s16x4, __builtin_amdgcn_ds_read_tr16_b64_v4i16((LAS v4i16_t*)p)); }
__device__ __forceinline__ int crow(int r, int hi) { return (r & 3) + 8 * (r >> 2) + 4 * hi; }
__device__ __forceinline__ bf16x8 ld8_bf(const bf16* p) { return *(const bf16x8*)p; }
__device__ __forceinline__ bf16x8 ld8_f32(const float* p) { const f32x4 a = *(const f32x4*)p, b = *(const f32x4*)(p + 4); v4u w = {cvtpk(a.x, a.y), cvtpk(a.z, a.w), cvtpk(b.x, b.y), cvtpk(b.z, b.w)}; return __builtin_bit_cast(bf16x8, w); }
#define PK4(P, BASE, OUT) do { unsigned a0_ = cvtpk(P[BASE + 0], P[BASE + 1]), a1_ = cvtpk(P[BASE + 2], P[BASE + 3]); \
    unsigned b0_ = cvtpk(P[BASE + 4], P[BASE + 5]), b1_ = cvtpk(P[BASE + 6], P[BASE + 7]); \
    auto r0_ = __builtin_amdgcn_permlane32_swap(a0_, b0_, false, false); auto r1_ = __builtin_amdgcn_permlane32_swap(a1_, b1_, false, false); \
    v4u w_ = {r0_[0], r1_[0], r0_[1], r1_[1]}; OUT = __builtin_bit_cast(bf16x8, w_); } while (0)

__device__ __forceinline__ void cvt_block(const float* W, int ldw, int k0, int srccol, int nvalid, bf16* WT, int K, int dstrow, LAS float* scr, int lane, const float* kgain = nullptr) {
    const int n = lane & 31;
#pragma unroll 8
    for (int i = 0; i < 32; ++i) { const int kk = 2 * i + (lane >> 5); scr[kk * 33 + n] = (n < nvalid) ? __builtin_nontemporal_load(W + (size_t)(k0 + kk) * ldw + srccol + n) : 0.f; }
    LDS_WAIT(); asm volatile("" ::: "memory");
    const int c = lane & 7;
    f32x4 ga = {1.f, 1.f, 1.f, 1.f}, gb = ga;
    if (kgain) { ga = *(const f32x4*)(kgain + k0 + 8 * c); gb = *(const f32x4*)(kgain + k0 + 8 * c + 4); }
#pragma unroll
    for (int j = 0; j < 4; ++j) { const int nn = (lane >> 3) + 8 * j; const LAS float* s = scr + (8 * c) * 33 + nn;
        v4u o; o.x = cvtpk(s[0 * 33] * ga.x, s[1 * 33] * ga.y); o.y = cvtpk(s[2 * 33] * ga.z, s[3 * 33] * ga.w); o.z = cvtpk(s[4 * 33] * gb.x, s[5 * 33] * gb.y); o.w = cvtpk(s[6 * 33] * gb.z, s[7 * 33] * gb.w);
        *(v4u*)(WT + (size_t)(dstrow + nn) * K + k0 + 8 * c) = o; }
    LDS_WAIT(); asm volatile("" ::: "memory");
}
__device__ __forceinline__ void cvt_item(const float* W, int K, int ldw, bf16* WT, int mode, int nblk, int item, LAS float* scr, int lane, const float* kgain = nullptr) {
    const int kb = item / nblk, db = item - kb * nblk; int src = 32 * db, nvalid = 32;
    if (mode == 1) { const int t = db >> 3, j = db & 7; src = (j < 4) ? 128 * t + 32 * j : DFF + 128 * t + 32 * (j - 4); }
    if (mode == 2) { if (db >= 288 && db < 320) src = 9232 + 32 * (db - 288); else if (db == 320) { src = 9216; nvalid = 16; } else if (db > 320) { src = 0; nvalid = 0; } }
    cvt_block(W, ldw, 64 * kb, src, nvalid, WT, K, 32 * db, scr, lane, kgain);
}

__device__ __forceinline__ void load_gain(const float* g, f32x4 (&v)[8], int lane) {
#pragma unroll
    for (int j = 0; j < 8; ++j) v[j] = *(const f32x4*)(g + 4 * lane + 256 * j);
}
template <bool HAS_F, bool ST_H, bool ST_A, int NF = 1, bool BASE_BF = false, bool HOUT_BF = false, bool ST_N = false>
__device__ __forceinline__ void thin_row(const void* basev, const void* fsrc, float s, const f32x4 (&gpost)[8], void* houtv, const f32x4 (&gpre)[8], bf16* aout, int lane, bool wr = true, float* rout = nullptr, float bscale = 1.0f) {
    f32x4 h[8];
    if constexpr (BASE_BF) { const bf16* bb = (const bf16*)basev;
#pragma unroll
        for (int j = 0; j < 8; ++j) { const u32x2 w = __builtin_nontemporal_load((const u32x2*)(bb + 4 * lane + 256 * j)); h[j] = (f32x4){bflo(w.x), bfhi(w.x), bflo(w.y), bfhi(w.y)} * bscale; } }
    else { const float* base = (const float*)basev;
#pragma unroll
        for (int j = 0; j < 8; ++j) h[j] = __builtin_nontemporal_load((const f32x4*)(base + 4 * lane + 256 * j)); }
    if (HAS_F) {
        f32x4 fv[8]; float ss = 0.f;
        if constexpr (NF == 1) {
            const bf16* fb = (const bf16*)fsrc;
#pragma unroll
            for (int j = 0; j < 8; ++j) { const u32x2 w = __builtin_nontemporal_load((const u32x2*)(fb + 4 * lane + 256 * j)); fv[j] = (f32x4){bflo(w.x), bfhi(w.x), bflo(w.y), bfhi(w.y)}; }
        } else {
            const float* f = (const float*)fsrc;
#pragma unroll
            for (int j = 0; j < 8; ++j) fv[j] = __builtin_nontemporal_load((const f32x4*)(f + 4 * lane + 256 * j));
#pragma unroll 1
            for (int k = 1; k < NF; ++k) {
#pragma unroll
                for (int j = 0; j < 8; ++j) fv[j] = fv[j] + __builtin_nontemporal_load((const f32x4*)(f + (size_t)k * NST * DM + 4 * lane + 256 * j)); }
        }
#pragma unroll
        for (int j = 0; j < 8; ++j) ss += (fv[j].x * fv[j].x + fv[j].y * fv[j].y) + (fv[j].z * fv[j].z + fv[j].w * fv[j].w);
        const float r = s * __builtin_amdgcn_rsqf(wave_sum(ss) * (1.0f / DM) + EPS);
#pragma unroll
        for (int j = 0; j < 8; ++j) h[j] = h[j] + fv[j] * gpost[j] * r;
    }
    if (ST_H && wr) {
        if constexpr (HOUT_BF) { bf16* hb = (bf16*)houtv;
#pragma unroll
            for (int j = 0; j < 8; ++j) { u32x2 w; w.x = cvtpk(h[j].x, h[j].y); w.y = cvtpk(h[j].z, h[j].w); __builtin_nontemporal_store(w, (u32x2*)(hb + 4 * lane + 256 * j)); } }
        else { float* hout = (float*)houtv;
#pragma unroll
            for (int j = 0; j < 8; ++j) __builtin_nontemporal_store(h[j], (f32x4*)(hout + 4 * lane + 256 * j)); }
    }
    if constexpr (ST_N) {
        float ss = 0.f;
#pragma unroll
        for (int j = 0; j < 8; ++j) ss += (h[j].x * h[j].x + h[j].y * h[j].y) + (h[j].z * h[j].z + h[j].w * h[j].w);
        const float ms = wave_sum(ss) * (1.0f / DM) + EPS, r = __builtin_amdgcn_rsqf(ms);
        if (wr) {
#pragma unroll
            for (int j = 0; j < 8; ++j) { const f32x4 a = h[j] * r; u32x2 w; w.x = cvtpk(a.x, a.y); w.y = cvtpk(a.z, a.w); *(u32x2*)(aout + 4 * lane + 256 * j) = w; }
            if (lane == 0) *rout = ms * r;
        }
    }
    if (ST_A) {
        float ss = 0.f;
#pragma unroll
        for (int j = 0; j < 8; ++j) ss += (h[j].x * h[j].x + h[j].y * h[j].y) + (h[j].z * h[j].z + h[j].w * h[j].w);
        const float r = __builtin_amdgcn_rsqf(wave_sum(ss) * (1.0f / DM) + EPS);
#pragma unroll
        for (int j = 0; j < 8; ++j) { const f32x4 a = h[j] * gpre[j] * r; u32x2 w; w.x = cvtpk(a.x, a.y); w.y = cvtpk(a.z, a.w); *(u32x2*)(aout + 4 * lane + 256 * j) = w; }
    }
}

#ifndef PROBE_EPI2
#define PROBE_EPI2 0
#endif
struct EpiGU {
    static constexpr bool PERM = true, AFTER_DRAIN = false, IDEMP = (PROBE_EPI2 == 1);
    bf16* H;
    __device__ __forceinline__ void operator()(const pg8::f32x4 (&acc)[2][2][4][2], const pg8::Unit& u, int wr, int wc, int fr, int fq) const {
        const int row0 = u.pm * 256 + wr * 64 + fr, col0 = u.pn * 128 + wc * 32 + 8 * fq;
#pragma unroll
        for (int ai = 0; ai < 2; ++ai)
#pragma unroll
            for (int m = 0; m < 4; ++m) {
                float o[8];
#pragma unroll
                for (int n = 0; n < 2; ++n)
#pragma unroll
                    for (int i = 0; i < 4; ++i) { const float g = acc[ai][0][m][n][i], uu = acc[ai][1][m][n][i]; o[4 * n + i] = g * uu * frcp(1.0f + fexp2(-g * LOG2E)); }
                v4u w; w.x = cvtpk(o[0], o[1]); w.y = cvtpk(o[2], o[3]); w.z = cvtpk(o[4], o[5]); w.w = cvtpk(o[6], o[7]);
                *(v4u*)(H + (size_t)(row0 + ai * 128 + m * 16) * DFF + col0) = w;
            }
    }
};
struct EpiF32 {
    static constexpr bool PERM = false, AFTER_DRAIN = false, IDEMP = (PROBE_EPI2 == 2);
    bf16* C; float* SLAB;
    __device__ __forceinline__ void operator()(const pg8::f32x4 (&acc)[2][2][4][2], const pg8::Unit& u, int wr, int wc, int fr, int fq) const {
        const int row0 = u.pm * 256 + wr * 64 + fr, col0 = u.pn * 256 + wc * 32 + 4 * fq;
        if (u.kx == 0) {
#pragma unroll
            for (int ai = 0; ai < 2; ++ai)
#pragma unroll
                for (int m = 0; m < 4; ++m) { bf16* rowp = C + (size_t)(row0 + ai * 128 + m * 16) * DM + col0;
#pragma unroll
                    for (int bj = 0; bj < 2; ++bj)
#pragma unroll
                        for (int n = 0; n < 2; ++n) { const pg8::f32x4 v = acc[ai][bj][m][n]; u32x2 w; w.x = cvtpk(v[0], v[1]); w.y = cvtpk(v[2], v[3]); *(u32x2*)(rowp + bj * 128 + n * 16) = w; } }
        } else {
            float* base = SLAB + (size_t)u.sl() * NST * DM - (size_t)NPT * DM;
#pragma unroll
            for (int ai = 0; ai < 2; ++ai)
#pragma unroll
                for (int m = 0; m < 4; ++m) { float* rowp = base + (size_t)(row0 + ai * 128 + m * 16) * DM + col0;
#pragma unroll
                    for (int bj = 0; bj < 2; ++bj)
#pragma unroll
                        for (int n = 0; n < 2; ++n) *(pg8::f32x4*)(rowp + bj * 128 + n * 16) = acc[ai][bj][m][n]; }
        }
    }
};
struct EpiIN {
    static constexpr bool PERM = true, AFTER_DRAIN = false, IDEMP = (PROBE_EPI2 == 3);
    unsigned char* ws; float* out;
    __device__ __forceinline__ void operator()(const pg8::f32x4 (&acc)[2][2][4][2], const pg8::Unit& u, int wr, int wc, int fr, int fq) const {
        const int pn = u.pn, rowb = u.pm * 256 + wr * 64 + fr, cw = wc * 32 + 8 * fq;
        if (pn == 40) {
            if (wc == 0 && fq < 2) {
                float* GA = (float*)(ws + WS_GA);
#pragma unroll
                for (int ai = 0; ai < 2; ++ai)
#pragma unroll
                    for (int m = 0; m < 4; ++m) { float* p = GA + (size_t)(rowb + ai * 128 + m * 16) * 16 + 8 * fq; *(pg8::f32x4*)p = acc[ai][0][m][0]; *(pg8::f32x4*)(p + 4) = acc[ai][0][m][1]; }
            }
            return;
        }
        bf16* bb; int ld, c0; float sc = 1.0f; float* fo = nullptr; int act = 0;
        const bool samp = (u.pm >= 128);
        if (pn >= 41) {
            const int t = pn - 41; ld = 1024;
            if (t < 4) { bb = (bf16*)(ws + WS_MKB); c0 = t * 256; fo = out + O_MEMK_P; } else { bb = (bf16*)(ws + WS_MVB); c0 = (t - 4) * 256; fo = out + O_MEMV_P; }
        } else if (pn < 4) { bb = (bf16*)(ws + WS_SBQ); ld = 1024; c0 = pn * 256; sc = C_SB; }
        else if (pn < 8) { bb = (bf16*)(ws + WS_SBK); ld = 1024; c0 = (pn - 4) * 256; fo = samp ? out + O_SBK_S : out + O_SBK_P; }
        else if (pn < 12) { bb = (bf16*)(ws + WS_SBV); ld = 1024; c0 = (pn - 8) * 256; fo = samp ? out + O_SBV_S : out + O_SBV_P; }
        else if (pn < 16) { bb = (bf16*)(ws + WS_GQ); ld = 1024; c0 = (pn - 12) * 256; sc = C_GQ; }
        else if (pn < 20) { bb = (bf16*)(ws + WS_GK); ld = 1024; c0 = (pn - 16) * 256; }
        else if (pn < 28) { bb = (bf16*)(ws + WS_GV); ld = 2048; c0 = (pn - 20) * 256; }
        else if (pn < 36) { bb = (bf16*)(ws + WS_GR); ld = 2048; c0 = (pn - 28) * 256; act = 1; }
        else { bb = (bf16*)(ws + WS_MQ); ld = 1024; c0 = (pn - 36) * 256; sc = C_MEM; }
        const int rb_b = (pn >= 41) ? rowb - MT : rowb;
        const int rb_f = (pn >= 41) ? rowb - MT : (samp ? rowb - NPT : rowb);
#pragma unroll
        for (int ai = 0; ai < 2; ++ai)
#pragma unroll
            for (int m = 0; m < 4; ++m)
#pragma unroll
                for (int bj = 0; bj < 2; ++bj) {
                    pg8::f32x4 v0 = acc[ai][bj][m][0], v1 = acc[ai][bj][m][1];
                    const int cc = c0 + bj * 128 + cw; const int ro = ai * 128 + m * 16;
                    if (fo) { float* p = fo + (size_t)(rb_f + ro) * 1024 + cc; __builtin_nontemporal_store(v0, (pg8::f32x4*)p); __builtin_nontemporal_store(v1, (pg8::f32x4*)(p + 4)); }
                    if (act) {
#pragma unroll
                        for (int i = 0; i < 4; ++i) { v0[i] = v0[i] * frcp(1.0f + fexp2(-v0[i] * LOG2E)); v1[i] = v1[i] * frcp(1.0f + fexp2(-v1[i] * LOG2E)); }
                    }
                    v0 = v0 * sc; v1 = v1 * sc;
                    v4u w; w.x = cvtpk(v0[0], v0[1]); w.y = cvtpk(v0[2], v0[3]); w.z = cvtpk(v1[0], v1[1]); w.w = cvtpk(v1[2], v1[3]);
                    *(v4u*)(bb + (size_t)(rb_b + ro) * ld + cc) = w;
                }
    }
};
struct EpiGate {
    static constexpr bool PERM = true, AFTER_DRAIN = false, IDEMP = (PROBE_EPI2 == 4);
    unsigned char* ws; const float* bias;
    __device__ __forceinline__ void operator()(const pg8::f32x4 (&acc)[2][2][4][2], const pg8::Unit& u, int wr, int wc, int fr, int fq) const {
        const int br = u.pn >> 3, rowb = u.pm * 256 + wr * 64 + fr, cw = wc * 32 + 8 * fq, c0 = (u.pn & 7) * 256;
        bf16* G = (bf16*)(ws + (br == 0 ? WS_G0 : (br == 1 ? WS_G1 : WS_G2)));
        pg8::f32x4 bv[2][2];
#pragma unroll
        for (int bj = 0; bj < 2; ++bj)
#pragma unroll
            for (int n = 0; n < 2; ++n) bv[bj][n] = *(const pg8::f32x4*)(bias + u.pn * 256 + bj * 128 + cw + 4 * n);
#pragma unroll
        for (int ai = 0; ai < 2; ++ai)
#pragma unroll
            for (int m = 0; m < 4; ++m)
#pragma unroll
                for (int bj = 0; bj < 2; ++bj) {
                    float o[8];
#pragma unroll
                    for (int n = 0; n < 2; ++n)
#pragma unroll
                        for (int i = 0; i < 4; ++i) o[4 * n + i] = sigmoidf_(acc[ai][bj][m][n][i] + bv[bj][n][i]);
                    v4u w; w.x = cvtpk(o[0], o[1]); w.y = cvtpk(o[2], o[3]); w.z = cvtpk(o[4], o[5]); w.w = cvtpk(o[6], o[7]);
                    *(v4u*)(G + (size_t)(rowb + ai * 128 + m * 16) * DM + c0 + bj * 128 + cw) = w;
                }
    }
};
template <int MODE> struct EpiBR {
    static constexpr bool PERM = false, AFTER_DRAIN = false, IDEMP = false;
    const bf16* G; bf16* MRG; bf16* OUTB;
    __device__ __forceinline__ void operator()(const pg8::f32x4 (&acc)[2][2][4][2], const pg8::Unit& u, int wr, int wc, int fr, int fq) const {
        const int row0 = u.pm * 256 + wr * 64 + fr, col0 = u.pn * 256 + wc * 32 + 4 * fq;
#pragma unroll
        for (int ai = 0; ai < 2; ++ai)
#pragma unroll
            for (int m = 0; m < 4; ++m) { const size_t ro = (size_t)(row0 + ai * 128 + m * 16) * DM + col0;
#pragma unroll
                for (int bj = 0; bj < 2; ++bj)
#pragma unroll
                    for (int n = 0; n < 2; ++n) { const size_t o = ro + bj * 128 + n * 16; const u32x2 gw = *(const u32x2*)(G + o);
                        pg8::f32x4 g = {bflo(gw.x), bfhi(gw.x), bflo(gw.y), bfhi(gw.y)}; pg8::f32x4 v = g * acc[ai][bj][m][n];
                        if (MODE >= 1) { const u32x2 mw = *(const u32x2*)(MRG + o); v = v + (pg8::f32x4){bflo(mw.x), bfhi(mw.x), bflo(mw.y), bfhi(mw.y)}; }
                        u32x2 w; w.x = cvtpk(v[0], v[1]); w.y = cvtpk(v[2], v[3]);
                        *(u32x2*)((MODE <= 1 ? MRG : OUTB) + o) = w; }
            }
    }
};
#ifndef WGM_A
#define WGM_A 4
#endif
#ifndef WGM_B
#define WGM_B 4
#endif
#ifndef WGM_C
#define WGM_C 4
#endif
struct OrderIN {
    pg8::StaticOrder S; int G, c;
    __device__ void init(int G_, int c_) { S.init(MT, 41 * 256, G_, c_, WGM_A); G = G_; c = c_; }
    __device__ __forceinline__ int total() const { return S.nwg + 32; }
    __device__ bool map(long L, pg8::Unit& u) const {
        if (L < S.nwg) return S.map(L, u);
        const int j = (int)(L - S.nwg); if (j >= 32) return false;
        u.pm = MT / 256 + (j & 3); u.pn = 41 + (j >> 2); u.kx = 0; return true;
    }
    __device__ bool next(int i, pg8::Unit& u) const { return map((long)i * G + c, u); }
    __device__ __forceinline__ void a_ready(const pg8::Unit&) const {}
    __device__ __forceinline__ void done(const pg8::Unit&) const {}
};

constexpr int NSPLIT = 4;
struct OrderSplit {
    pg8::StaticOrder S; int G, c, ntk;
    __device__ void init(int G_, int c_, int ntk_) { S.init(NPT, DM, G_, c_, WGM_B); G = G_; c = c_; ntk = ntk_; }
    __device__ __forceinline__ int total() const { return S.nwg + 32 * NSPLIT; }
    __device__ bool next(int i, pg8::Unit& u) const { return map((long)i * G + c, u); }
    __device__ bool map(long L, pg8::Unit& u) const {
        if (L < S.nwg) return S.map(L, u);
        const int j = (int)(L - S.nwg); if (j >= 32 * NSPLIT) return false;
        const int tile = j / NSPLIT, sl = j % NSPLIT;
        u.pm = NPT / 256 + (tile >> 3); u.pn = tile & 7;
        int n, t0;
        n = ntk / NSPLIT; t0 = n * sl;
        u.kx = t0 | (n << 12) | ((sl + 1) << 24);
        return true;
    }
    __device__ __forceinline__ void a_ready(const pg8::Unit&) const {}
    __device__ __forceinline__ void done(const pg8::Unit&) const {}
};

#ifndef DYN_ROUNDS
#define DYN_ROUNDS 3
#endif
template <class Map> struct DynTail {
    Map M; int G, c, nstatic, Ls, Ltot; gu32* heads; volatile LAS unsigned* qw;
    __device__ void init(const Map& m, int G_, int c_, gu32* heads_, volatile LAS unsigned* qw_) {
        M = m; G = G_; c = c_; heads = heads_; qw = qw_; Ltot = M.total();
        const int R = (Ltot + G - 1) / G; nstatic = R > DYN_ROUNDS ? R - DYN_ROUNDS : 0; Ls = nstatic * G;
    }
    __device__ __forceinline__ bool fetch(pg8::Unit& u) const {
        if (__builtin_amdgcn_readfirstlane((int)(threadIdx.x >> 6)) == 0) {
            if ((threadIdx.x & 63) == 0) {
                unsigned L = 0xffffffffu;
                for (int s = 0; s < 8; ++s) {
                    const int x = (c + s) & 7;
                    const unsigned k = __hip_atomic_fetch_add((unsigned*)heads + x * 256, 1u, __ATOMIC_RELAXED, __HIP_MEMORY_SCOPE_AGENT);
                    const unsigned cand = (unsigned)Ls + (unsigned)((x - Ls) & 7) + 8u * k;
                    if (cand < (unsigned)Ltot) { L = cand; break; }
                }
                *qw = L;
            }
            asm volatile("s_waitcnt lgkmcnt(0)" ::: "memory");
        }
        asm volatile("" ::: "memory"); __builtin_amdgcn_s_barrier(); asm volatile("" ::: "memory");
        const unsigned L = __builtin_amdgcn_readfirstlane(*qw);
        if (L == 0xffffffffu) return false;
        return M.map((long)L, u);
    }
    __device__ __forceinline__ bool first(pg8::Unit& u) const { if (nstatic > 0) return M.map((long)c, u); return fetch(u); }
    __device__ __forceinline__ bool peek(int i, pg8::Unit& u, bool& pend) const {
        if (i < nstatic) { pend = false; return M.map((long)i * G + c, u); }
        pend = true; return false;
    }
    __device__ __forceinline__ void a_ready(const pg8::Unit&) const {}
    __device__ __forceinline__ void done(const pg8::Unit&) const {}
};
__device__ __forceinline__ unsigned wave_ticket(gu32* cnt, unsigned n, int lane) {
    unsigned b = 0; if (lane == 0) b = __hip_atomic_fetch_add((unsigned*)cnt, n, __ATOMIC_RELAXED, __HIP_MEMORY_SCOPE_AGENT);
    return __builtin_amdgcn_readfirstlane(b);
}

constexpr int SB_KP = 272, SB_VP = 288, SB_VOFF = 64 * SB_KP, SB_FLAG = SB_VOFF + 64 * SB_VP;
__device__ __forceinline__ void sb_weights(f32x16& p0, f32x16& p1, float& Rin, int kpos0, int qpos, bool mask, int hi) {
#pragma unroll
    for (int r = 0; r < 16; ++r) { p0[r] = frcp(1.0f + fexp2(p0[r])); p1[r] = frcp(1.0f + fexp2(p1[r])); }
    if (mask) {
#pragma unroll
        for (int r = 0; r < 16; ++r) { const int kp = kpos0 + crow(r, hi); if (kp >= qpos) p0[r] = 1.0f; if (kp + 32 >= qpos) p1[r] = 1.0f; }
    }
    float TG[16];
#pragma unroll
    for (int i = 0; i < 4; ++i) {
        const float t0 = (p0[4 * i] * p0[4 * i + 1]) * (p0[4 * i + 2] * p0[4 * i + 3]), t1 = (p1[4 * i] * p1[4 * i + 1]) * (p1[4 * i + 2] * p1[4 * i + 3]);
        auto a = __builtin_amdgcn_permlane32_swap(__float_as_uint(t0), __float_as_uint(t0), false, false);
        auto b = __builtin_amdgcn_permlane32_swap(__float_as_uint(t1), __float_as_uint(t1), false, false);
        TG[2 * i] = __uint_as_float(a[0]); TG[2 * i + 1] = __uint_as_float(a[1]); TG[8 + 2 * i] = __uint_as_float(b[0]); TG[8 + 2 * i + 1] = __uint_as_float(b[1]);
    }
    float E[17]; E[16] = Rin;
#pragma unroll
    for (int g = 15; g >= 0; --g) E[g] = E[g + 1] * TG[g];
#pragma unroll
    for (int i = 0; i < 4; ++i) {
        { const float st = hi ? E[2 * i + 2] : E[2 * i + 1];
          const float R3 = st * p0[4 * i + 3], R2 = R3 * p0[4 * i + 2], R1 = R2 * p0[4 * i + 1], R0 = R1 * p0[4 * i];
          p0[4 * i + 3] = st - R3; p0[4 * i + 2] = R3 - R2; p0[4 * i + 1] = R2 - R1; p0[4 * i] = R1 - R0; }
        { const float st = hi ? E[8 + 2 * i + 2] : E[8 + 2 * i + 1];
          const float R3 = st * p1[4 * i + 3], R2 = R3 * p1[4 * i + 2], R1 = R2 * p1[4 * i + 1], R0 = R1 * p1[4 * i];
          p1[4 * i + 3] = st - R3; p1[4 * i + 2] = R3 - R2; p1[4 * i + 1] = R2 - R1; p1[4 * i] = R1 - R0; }
    }
    Rin = E[0];
}
template <bool SAMPLE>
__device__ __forceinline__ void sb_unit(ldsp lds, int b, int h, int qb, const bf16* SBQ, const bf16* SBK, const bf16* SBV, bf16* OSB, const float* cK, const float* cV, int tid, int wid, int lane, bool wr) {
    const int r32 = lane & 31, hi = lane >> 5;
    const int nwv = SAMPLE ? 1 : 8;
    const size_t qrow0 = SAMPLE ? (size_t)NPT + b * 32 : (size_t)b * SEQ + qb * 256;
    const int qpos0 = SAMPLE ? PAST : qb * 256;
    const bool wact = wid < nwv;
    const int qmin = qpos0 + 32 * wid, qpos = qmin + r32, qmax = qmin + 31;
    bf16x8 qr[8];
    if (wact) {
        const bf16* qp = SBQ + (qrow0 + 32 * wid + r32) * 1024 + h * 128 + hi * 8;
#pragma unroll
        for (int d0 = 0; d0 < 8; ++d0) qr[d0] = ld8_bf(qp + d0 * 16);
    } else {
#pragma unroll
        for (int d0 = 0; d0 < 8; ++d0) qr[d0] = (bf16x8){0, 0, 0, 0, 0, 0, 0, 0};
    }
    f32x16 o[4];
#pragma unroll
    for (int d = 0; d < 4; ++d)
#pragma unroll
        for (int r = 0; r < 16; ++r) o[d][r] = 0.f;
    float Rin = 1.0f;
    const int sr = tid >> 4, sc = (tid & 15) * 8;
    volatile LAS int* flags = (volatile LAS int*)(lds + SB_FLAG);
    const int kt_last = SAMPLE ? (PAST + DSEQ - 1) / 64 : (qpos0 + 255) / 64;
    bf16x8 k0v, k1v, v0v, v1v;
#define SB_LOAD(KT) do { const int kt_ = (KT); \
        if (!SAMPLE) { const size_t base = ((size_t)b * SEQ + kt_ * 64) * 1024 + h * 128 + sc; \
            k0v = ld8_bf(SBK + base + (size_t)sr * 1024); k1v = ld8_bf(SBK + base + (size_t)(sr + 32) * 1024); \
            v0v = ld8_bf(SBV + base + (size_t)sr * 1024); v1v = ld8_bf(SBV + base + (size_t)(sr + 32) * 1024); } \
        else if (kt_ * 64 < PAST) { const size_t base = ((size_t)b * PAST + kt_ * 64) * 1024 + h * 128 + sc; \
            k0v = ld8_f32(cK + base + (size_t)sr * 1024); k1v = ld8_f32(cK + base + (size_t)(sr + 32) * 1024); \
            v0v = ld8_f32(cV + base + (size_t)sr * 1024); v1v = ld8_f32(cV + base + (size_t)(sr + 32) * 1024); } \
        else { const size_t base = ((size_t)NPT + b * 32) * 1024 + h * 128 + sc;     \
            k0v = ld8_bf(SBK + base + (size_t)sr * 1024); v0v = ld8_bf(SBV + base + (size_t)sr * 1024); \
            k1v = (bf16x8){0, 0, 0, 0, 0, 0, 0, 0}; v1v = k1v; } } while (0)
    SB_LOAD(kt_last);
    for (int kt = kt_last; kt >= 0; --kt) {
        *(LAS bf16x8*)(lds + sr * SB_KP + sc * 2) = k0v; *(LAS bf16x8*)(lds + (sr + 32) * SB_KP + sc * 2) = k1v;
        *(LAS bf16x8*)(lds + SB_VOFF + sr * SB_VP + sc * 2) = v0v; *(LAS bf16x8*)(lds + SB_VOFF + (sr + 32) * SB_VP + sc * 2) = v1v;
        if (kt > 0) SB_LOAD(kt - 1);
        __syncthreads();
        int alive = 0;
        if (wact) {
            alive = 1;
            const int kpos0 = kt * 64;
            if (kpos0 < qmax && __any(Rin >= SB_THR)) {
                f32x16 p0, p1;
#pragma unroll
                for (int r = 0; r < 16; ++r) { p0[r] = 0.f; p1[r] = 0.f; }
                {
                    bf16x8 a0[8], a1[8];
#pragma unroll
                    for (int d0 = 0; d0 < 8; ++d0) { a0[d0] = *(const LAS bf16x8*)(lds + r32 * SB_KP + (d0 * 16 + hi * 8) * 2); a1[d0] = *(const LAS bf16x8*)(lds + (32 + r32) * SB_KP + (d0 * 16 + hi * 8) * 2); }
                    __builtin_amdgcn_sched_barrier(0);
#pragma unroll
                    for (int d0 = 0; d0 < 8; ++d0) { p0 = __builtin_amdgcn_mfma_f32_32x32x16_bf16(a0[d0], qr[d0], p0, 0, 0, 0); p1 = __builtin_amdgcn_mfma_f32_32x32x16_bf16(a1[d0], qr[d0], p1, 0, 0, 0); }
                }
                sb_weights(p0, p1, Rin, kpos0, qpos, kpos0 + 63 >= qmin, hi);
                bf16x8 pa[4]; PK4(p0, 0, pa[0]); PK4(p0, 8, pa[1]); PK4(p1, 0, pa[2]); PK4(p1, 8, pa[3]);
                const int vrow = 8 * hi + ((lane & 15) >> 2), vcol = 16 * ((lane >> 4) & 1) + 4 * (lane & 3);
                {
                    s16x4 cl[4], ch[4], nl[4], nh[4];
                    ldscp vp0 = lds + SB_VOFF + vrow * SB_VP + vcol * 2;
#pragma unroll
                    for (int d0 = 0; d0 < 4; ++d0) { cl[d0] = vtr(vp0 + 64 * d0); ch[d0] = vtr(vp0 + 64 * d0 + 4 * SB_VP); }
#pragma unroll
                    for (int ks = 0; ks < 4; ++ks) {
                        if (ks < 3) {
#pragma unroll
                            for (int d0 = 0; d0 < 4; ++d0) { nl[d0] = vtr(vp0 + 16 * (ks + 1) * SB_VP + 64 * d0); nh[d0] = vtr(vp0 + 16 * (ks + 1) * SB_VP + 64 * d0 + 4 * SB_VP); }
                        }
                        __builtin_amdgcn_sched_barrier(0);
#pragma unroll
                        for (int d0 = 0; d0 < 4; ++d0) { const bf16x8 vb = {cl[d0][0], cl[d0][1], cl[d0][2], cl[d0][3], ch[d0][0], ch[d0][1], ch[d0][2], ch[d0][3]};
                            o[d0] = __builtin_amdgcn_mfma_f32_32x32x16_bf16(pa[ks], vb, o[d0], 0, 0, 0); }
                        __builtin_amdgcn_sched_barrier(0);
#pragma unroll
                        for (int d0 = 0; d0 < 4; ++d0) { cl[d0] = nl[d0]; ch[d0] = nh[d0]; }
                    }
                }
            }
            alive = __any(Rin >= SB_THR) ? 1 : 0;
        }
        if (lane == 0) flags[wid] = alive;
        __syncthreads();
        int any_alive = 0;
#pragma unroll
        for (int w = 0; w < 8; ++w) any_alive |= flags[w];
        if (!any_alive) break;
    }
#undef SB_LOAD
    __syncthreads();
    if (wact && wr) {
        bf16* op = OSB + (qrow0 + 32 * wid) * 1024 + h * 128 + r32;
#pragma unroll
        for (int r = 0; r < 16; ++r) { const int qq = crow(r, hi);
#pragma unroll
            for (int d0 = 0; d0 < 4; ++d0) op[(size_t)qq * 1024 + d0 * 32] = (bf16)(cvtpk(o[d0][r], 0.f) & 0xffffu); }
    }
}

constexpr int MEM_P = 544;
template <bool SAMPLE>
__device__ __forceinline__ void mem_unit(ldsp lds, int b, int h, int qblk, bf16* MQ, const bf16* MKB, const bf16* MVB, const float* cK, const float* cV, int tid, int wid, int lane, bool wr) {
    const int l15 = lane & 15, g = lane >> 4;
    const size_t qrow0 = SAMPLE ? (size_t)NPT + b * 32 : (size_t)b * SEQ + qblk * 128;
    const bool wact = SAMPLE ? (wid < 2) : true;
    bf16x8 qf[8];
    if (wact) { const bf16* qp = MQ + (qrow0 + 16 * wid + l15) * 1024 + h * 256 + 8 * g;
#pragma unroll
        for (int s = 0; s < 8; ++s) qf[s] = ld8_bf(qp + 32 * s); }
    else {
#pragma unroll
        for (int s = 0; s < 8; ++s) qf[s] = (bf16x8){0, 0, 0, 0, 0, 0, 0, 0}; }
    f32x4 st[4][4];
#pragma unroll
    for (int a = 0; a < 4; ++a)
#pragma unroll
        for (int c = 0; c < 4; ++c) st[a][c] = (f32x4){0.f, 0.f, 0.f, 0.f};
    const int sx = tid & 31, sr0 = tid >> 5;
    const size_t kvbase = (size_t)b * 256 * 1024 + h * 256 + 8 * sx;
    bf16x8 tv[4];
#define MEM_LOAD(SRCF, SRCB, KT) do { _Pragma("unroll") for (int c = 0; c < 4; ++c) { const size_t so_ = kvbase + (size_t)((KT) * 64 + sr0 + 16 * c) * 1024; \
        tv[c] = SAMPLE ? ld8_f32((SRCF) + so_) : ld8_bf((SRCB) + so_); } } while (0)
    MEM_LOAD(cK, MKB, 0);
#pragma unroll
    for (int kt = 0; kt < 4; ++kt) {
        __syncthreads();
#pragma unroll
        for (int c = 0; c < 4; ++c) *(LAS bf16x8*)(lds + (sr0 + 16 * c) * MEM_P + sx * 16) = tv[c];
        if (kt < 3) MEM_LOAD(cK, MKB, kt + 1); else MEM_LOAD(cV, MVB, 0);
        __syncthreads();
        if (wact) {
            bf16x8 ac[4], an[4];
#pragma unroll
            for (int t4 = 0; t4 < 4; ++t4) ac[t4] = *(const LAS bf16x8*)(lds + (16 * t4 + l15) * MEM_P + (8 * g) * 2);
#pragma unroll
            for (int s = 0; s < 8; ++s) {
                if (s < 7) {
#pragma unroll
                    for (int t4 = 0; t4 < 4; ++t4) an[t4] = *(const LAS bf16x8*)(lds + (16 * t4 + l15) * MEM_P + (32 * (s + 1) + 8 * g) * 2);
                }
                __builtin_amdgcn_sched_barrier(0);
#pragma unroll
                for (int t4 = 0; t4 < 4; ++t4) st[kt][t4] = __builtin_amdgcn_mfma_f32_16x16x32_bf16(ac[t4], qf[s], st[kt][t4], 0, 0, 0);
                __builtin_amdgcn_sched_barrier(0);
#pragma unroll
                for (int t4 = 0; t4 < 4; ++t4) ac[t4] = an[t4];
            }
        }
    }
    float mx = -3.0e38f;
#pragma unroll
    for (int a = 0; a < 4; ++a)
#pragma unroll
        for (int c = 0; c < 4; ++c)
#pragma unroll
            for (int i = 0; i < 4; ++i) mx = fmaxf(mx, st[a][c][i]);
    mx = fmaxf(mx, __shfl_xor(mx, 16)); mx = fmaxf(mx, __shfl_xor(mx, 32));
    float sm = 0.f;
#pragma unroll
    for (int a = 0; a < 4; ++a)
#pragma unroll
        for (int c = 0; c < 4; ++c)
#pragma unroll
            for (int i = 0; i < 4; ++i) { st[a][c][i] = fexp2(st[a][c][i] - mx); sm += st[a][c][i]; }
    sm += __shfl_xor(sm, 16); sm += __shfl_xor(sm, 32);
    const float inv = 1.0f / sm;
    f32x4 o[16];
#pragma unroll
    for (int c = 0; c < 16; ++c) o[c] = (f32x4){0.f, 0.f, 0.f, 0.f};
#pragma unroll
    for (int kt = 0; kt < 4; ++kt) {
        __syncthreads();
#pragma unroll
        for (int c = 0; c < 4; ++c) *(LAS bf16x8*)(lds + (sr0 + 16 * c) * MEM_P + sx * 16) = tv[c];
        if (kt < 3) MEM_LOAD(cV, MVB, kt + 1);
        __syncthreads();
        if (wact) {
#pragma unroll
            for (int s2 = 0; s2 < 2; ++s2) {
                const f32x4 x0 = st[kt][2 * s2] * inv, x1 = st[kt][2 * s2 + 1] * inv;
                v4u pw = {cvtpk(x0[0], x0[1]), cvtpk(x0[2], x0[3]), cvtpk(x1[0], x1[1]), cvtpk(x1[2], x1[3])};
                const bf16x8 pa = __builtin_bit_cast(bf16x8, pw);
                ldscp vp0 = lds + (32 * s2 + 4 * g + (l15 >> 2)) * MEM_P + (4 * (lane & 3)) * 2;
                s16x4 cl[4], ch[4], nl[4], nh[4];
#pragma unroll
                for (int i = 0; i < 4; ++i) { cl[i] = vtr(vp0 + 32 * i); ch[i] = vtr(vp0 + 32 * i + 16 * MEM_P); }
#pragma unroll
                for (int grp = 0; grp < 4; ++grp) {
                    if (grp < 3) {
#pragma unroll
                        for (int i = 0; i < 4; ++i) { nl[i] = vtr(vp0 + 32 * (4 * grp + 4 + i)); nh[i] = vtr(vp0 + 32 * (4 * grp + 4 + i) + 16 * MEM_P); }
                    }
                    __builtin_amdgcn_sched_barrier(0);
#pragma unroll
                    for (int i = 0; i < 4; ++i) { const bf16x8 vb = {cl[i][0], cl[i][1], cl[i][2], cl[i][3], ch[i][0], ch[i][1], ch[i][2], ch[i][3]};
                        o[4 * grp + i] = __builtin_amdgcn_mfma_f32_16x16x32_bf16(pa, vb, o[4 * grp + i], 0, 0, 0); }
                    __builtin_amdgcn_sched_barrier(0);
#pragma unroll
                    for (int i = 0; i < 4; ++i) { cl[i] = nl[i]; ch[i] = nh[i]; }
                }
            }
        }
    }
    if (wact && wr) {
        bf16* op = MQ + (qrow0 + 16 * wid + 4 * g) * 1024 + h * 256 + l15;
#pragma unroll
        for (int cb = 0; cb < 16; ++cb)
#pragma unroll
            for (int i = 0; i < 4; ++i) op[(size_t)i * 1024 + cb * 16] = (bf16)(cvtpk(o[cb][i], 0.f) & 0xffffu);
    }
#undef MEM_LOAD
    __syncthreads();
}

constexpr int GP_VP = 1056, GP_QP = 528, GP_QE = 67584, GP_KD = 101376, GP_ATT = 135168, GP_AP = 144, GP_BP = 260;
__device__ __forceinline__ void gla_pre_item(ldsp lds, int cid, int h, unsigned char* ws, bf16* frag, const float* wa2, const float* ba2, int tid, int wid, int lane, bool wr) {
    const bool samp = cid >= NPT / 64; const int L = samp ? 32 : 64;
    const size_t row0 = samp ? (size_t)NPT + (cid - NPT / 64) * 32 : (size_t)cid * 64;
    bf16* GQ = (bf16*)(ws + WS_GQ); bf16* GK = (bf16*)(ws + WS_GK); const bf16* GV = (const bf16*)(ws + WS_GV); const float* GA = (const float*)(ws + WS_GA);
    float* EB = (float*)(ws + WS_EB); bf16* OI = (bf16*)(ws + WS_OINTRA);
    bf16* const qef = samp ? (bf16*)(ws + WS_QEF_S) + (size_t)((cid - NPT / 64) * 4 + h) * 16384 : frag + FRAG_QEF + (size_t)(cid * 4 + h) * 16384;
    bf16* const ketf = samp ? (bf16*)(ws + WS_KETF_S) + (size_t)((cid - NPT / 64) * 4 + h) * 16384 : frag + FRAG_KETF + (size_t)(cid * 4 + h) * 16384;
    LAS float* bl = (LAS float*)lds; LAS float* gal = (LAS float*)(lds + GP_ATT);
    const int dk = tid & 255, half = tid >> 8;
    const int cx = tid & 31, tg = tid >> 5;
    bf16x8 qin[4], kin[4];
#pragma unroll
    for (int j = 0; j < 4; ++j) { const int t = tg + 16 * j; qin[j] = (bf16x8){0, 0, 0, 0, 0, 0, 0, 0}; kin[j] = qin[j];
        if (t < L) { qin[j] = ld8_bf(GQ + (row0 + t) * 1024 + h * 256 + 8 * cx); kin[j] = ld8_bf(GK + (row0 + t) * 1024 + h * 256 + 8 * cx); } }
    __syncthreads();
    for (int i = tid; i < 64 * 16; i += NTHR) { const int t = i >> 4; gal[i] = (t < L) ? GA[(row0 + t) * 16 + (i & 15)] : 0.f; }
    float w[16];
#pragma unroll
    for (int r = 0; r < 16; ++r) w[r] = wa2[r * 1024 + h * 256 + dk];
    const float bias = ba2[h * 256 + dk];
    __syncthreads();
    float cum = 0.f;
#pragma unroll 4
    for (int tt = 0; tt < 32; ++tt) {
        const int t = half * 32 + tt; float x = bias;
#pragma unroll
        for (int r = 0; r < 16; ++r) x += gal[t * 16 + r] * w[r];
        const float ls = fminf(x, 0.f) - LN2 * flog2(1.0f + fexp2(-fabsf(x) * LOG2E));
        if (t < L) cum += ls * (1.0f / 16.0f);
        bl[t * GP_BP + dk] = cum;
    }
    __syncthreads();
    const float add = half ? bl[31 * GP_BP + dk] : 0.f;
    if (half) {
#pragma unroll 8
        for (int tt = 0; tt < 32; ++tt) bl[(32 + tt) * GP_BP + dk] += add;
    }
    __syncthreads();
    {
        const f32x4 l0 = *(const LAS f32x4*)(bl + 63 * GP_BP + 8 * cx), l1 = *(const LAS f32x4*)(bl + 63 * GP_BP + 8 * cx + 4);
#pragma unroll
        for (int j = 0; j < 4; ++j) {
            const int t = tg + 16 * j;
            const f32x4 b0 = *(const LAS f32x4*)(bl + t * GP_BP + 8 * cx), b1 = *(const LAS f32x4*)(bl + t * GP_BP + 8 * cx + 4);
            float qe[8], kd[8];
#pragma unroll
            for (int i = 0; i < 8; ++i) {
                const float bb = (i < 4 ? b0[i] : b1[i - 4]) * LOG2E;
                const float q = bf2f((unsigned short)qin[j][i]), k = bf2f((unsigned short)kin[j][i]);
                qe[i] = q * fexp2(bb); kd[i] = k * fexp2(-bb);
            }
            *(LAS v4u*)(lds + GP_QE + t * GP_QP + cx * 16) = (v4u){cvtpk(qe[0], qe[1]), cvtpk(qe[2], qe[3]), cvtpk(qe[4], qe[5]), cvtpk(qe[6], qe[7])};
            *(LAS v4u*)(lds + GP_KD + t * GP_QP + cx * 16) = (v4u){cvtpk(kd[0], kd[1]), cvtpk(kd[2], kd[3]), cvtpk(kd[4], kd[5]), cvtpk(kd[6], kd[7])};
        }
        if (tg == 0) { float* e = EB + (size_t)cid * 1024 + h * 256 + 8 * cx;
            *(f32x4*)e = (f32x4){fexp2(l0[0] * LOG2E), fexp2(l0[1] * LOG2E), fexp2(l0[2] * LOG2E), fexp2(l0[3] * LOG2E)};
            *(f32x4*)(e + 4) = (f32x4){fexp2(l1[0] * LOG2E), fexp2(l1[1] * LOG2E), fexp2(l1[2] * LOG2E), fexp2(l1[3] * LOG2E)}; }
    }
    __syncthreads();
    { const int l15 = lane & 15, g = lane >> 4;
#pragma unroll
      for (int tt = 0; tt < 4; ++tt) *(v4u*)(qef + ((size_t)((tt * 8 + wid) * 64 + lane)) * 8) = *(const LAS v4u*)(lds + GP_QE + (16 * tt + l15) * GP_QP + (32 * wid + 8 * g) * 2); }
    { const int r32_ = lane & 31, hi_ = lane >> 5;
      const float ebl = fexp2(bl[63 * GP_BP + 32 * wid + r32_] * LOG2E);
      const int trow = 8 * hi_ + ((lane & 15) >> 2), tcol = 16 * ((lane >> 4) & 1) + 4 * (lane & 3);
      s16x4 kl[4], kh[4];
#pragma unroll
      for (int ks = 0; ks < 4; ++ks) { ldscp kp = lds + GP_KD + (16 * ks + trow) * GP_QP + (32 * wid + tcol) * 2; kl[ks] = vtr(kp); kh[ks] = vtr(kp + 4 * GP_QP); }
#pragma unroll
      for (int ks = 0; ks < 4; ++ks) {
          float e[8];
#pragma unroll
          for (int j = 0; j < 4; ++j) { e[j] = bf2f((unsigned short)kl[ks][j]) * ebl; e[4 + j] = bf2f((unsigned short)kh[ks][j]) * ebl; }
          *(v4u*)(ketf + ((size_t)((wid * 4 + ks) * 64 + lane)) * 8) = (v4u){cvtpk(e[0], e[1]), cvtpk(e[2], e[3]), cvtpk(e[4], e[5]), cvtpk(e[6], e[7])};
      } }
    __syncthreads();
    { const int vx = tid & 63, vr0 = tid >> 6;
      bf16x8 vv[8];
#pragma unroll
      for (int p = 0; p < 8; ++p) { const int vr = vr0 + 8 * p; vv[p] = (bf16x8){0, 0, 0, 0, 0, 0, 0, 0}; if (vr < L) vv[p] = ld8_bf(GV + (row0 + vr) * 2048 + h * 512 + 8 * vx); }
#pragma unroll
      for (int p = 0; p < 8; ++p) *(LAS bf16x8*)(lds + (vr0 + 8 * p) * GP_VP + vx * 16) = vv[p]; }
    const int r32 = lane & 31, hi = lane >> 5;
    if (wid < 3) {
        const int sb = (wid == 2) ? 1 : 0, tb = (wid >= 1) ? 1 : 0;
        f32x16 p;
#pragma unroll
        for (int r = 0; r < 16; ++r) p[r] = 0.f;
#pragma unroll
        for (int kb = 0; kb < 4; ++kb) {
            bf16x8 a[4], bq[4];
#pragma unroll
            for (int k4 = 0; k4 < 4; ++k4) { const int ks = 4 * kb + k4;
                a[k4] = *(const LAS bf16x8*)(lds + GP_KD + (32 * sb + r32) * GP_QP + (16 * ks + 8 * hi) * 2);
                bq[k4] = *(const LAS bf16x8*)(lds + GP_QE + (32 * tb + r32) * GP_QP + (16 * ks + 8 * hi) * 2); }
            __builtin_amdgcn_sched_barrier(0);
#pragma unroll
            for (int k4 = 0; k4 < 4; ++k4) p = __builtin_amdgcn_mfma_f32_32x32x16_bf16(a[k4], bq[k4], p, 0, 0, 0);
        }
        const int t = 32 * tb + r32;
#pragma unroll
        for (int i = 0; i < 4; ++i) {
            float v[4];
#pragma unroll
            for (int j = 0; j < 4; ++j) { const int s = 32 * sb + 8 * i + 4 * hi + j; v[j] = (s <= t) ? p[4 * i + j] : 0.f; }
            u32x2 wv; wv.x = cvtpk(v[0], v[1]); wv.y = cvtpk(v[2], v[3]);
            *(LAS u32x2*)(lds + GP_ATT + t * GP_AP + (32 * sb + 8 * i + 4 * hi) * 2) = wv;
        }
    } else if (wid == 3) {
        for (int i = lane; i < 32 * 4; i += 64) { const int t = i >> 2, c = i & 3; *(LAS v4u*)(lds + GP_ATT + t * GP_AP + 64 + c * 16) = (v4u){0u, 0u, 0u, 0u}; }
    }
    __syncthreads();
    {
        bf16x8 af[2][4];
#pragma unroll
        for (int tb = 0; tb < 2; ++tb)
#pragma unroll
            for (int ks = 0; ks < 4; ++ks) af[tb][ks] = *(const LAS bf16x8*)(lds + GP_ATT + (32 * tb + r32) * GP_AP + (16 * ks + 8 * hi) * 2);
        const int vrow = 8 * hi + ((lane & 15) >> 2), vcol = 16 * ((lane >> 4) & 1) + 4 * (lane & 3);
#pragma unroll
        for (int cbi = 0; cbi < 2; ++cbi) {
            const int cb = 2 * wid + cbi;
            f32x16 o0, o1;
#pragma unroll
            for (int r = 0; r < 16; ++r) { o0[r] = 0.f; o1[r] = 0.f; }
            s16x4 lo[4], hh[4];
#pragma unroll
            for (int ks = 0; ks < 4; ++ks) { ldscp vp = lds + (16 * ks + vrow) * GP_VP + (32 * cb + vcol) * 2; lo[ks] = vtr(vp); hh[ks] = vtr(vp + 4 * GP_VP); }
            __builtin_amdgcn_sched_barrier(0);
#pragma unroll
            for (int ks = 0; ks < 4; ++ks) {
                const bf16x8 vb = {lo[ks][0], lo[ks][1], lo[ks][2], lo[ks][3], hh[ks][0], hh[ks][1], hh[ks][2], hh[ks][3]};
                if (ks < 2) o0 = __builtin_amdgcn_mfma_f32_32x32x16_bf16(af[0][ks], vb, o0, 0, 0, 0);
                o1 = __builtin_amdgcn_mfma_f32_32x32x16_bf16(af[1][ks], vb, o1, 0, 0, 0);
            }
            bf16* op = OI + row0 * 2048 + h * 512 + 32 * cb + r32;
#pragma unroll
            for (int r = 0; r < 16; ++r) { const int t = crow(r, hi);
                if (t < L) op[(size_t)t * 2048] = (bf16)(cvtpk(o0[r], 0.f) & 0xffffu);
                if (t + 32 < L) op[(size_t)(t + 32) * 2048] = (bf16)(cvtpk(o1[r], 0.f) & 0xffffu); }
        }
    }
    __syncthreads();
}

constexpr int GC_SP = 528, GC_SB = 32 * GC_SP, GC_VOFF = 2 * GC_SB, GC_VB = 4096;
constexpr int GC_XOFF = GC_VOFF + 2 * GC_VB, GC_XB = 8192;
struct GcQ { bf16x8 qa[4]; unsigned short oi[4]; };
struct GcK { bf16x8 ka[4]; f32x4 eb[4]; u32x2 vn; };
struct GcCtx { const bf16* QE; const bf16* KT; const bf16* GV; const float* EB; bf16* OI; size_t row0; int cid0, blk0, h, sl; };
template <int L> __device__ __forceinline__ void gc_load_q(GcQ& Q, const GcCtx& X, int c, int wid, int lane) {
    const int l15 = lane & 15, g = lane >> 4, tt = (L == 64) ? (wid & 3) : (wid & 1), kh = wid >> 2;
    const size_t r = X.row0 + (size_t)c * 64 + 16 * tt;
#pragma unroll
    for (int i = 0; i < 4; ++i) Q.qa[i] = ld8_bf(X.QE + (size_t)(X.blk0 + 4 * c) * 16384 + ((size_t)((tt * 8 + 4 * kh + i) * 64 + lane)) * 8);
#pragma unroll
    for (int i = 0; i < 4; ++i) Q.oi[i] = X.OI[(r + 4 * g + i) * 2048 + X.h * 512 + X.sl * 32 + 16 * kh + l15];
}
template <int L> __device__ __forceinline__ void gc_load_k(GcK& Kx, const GcCtx& X, int c, int cv, int tid, int wid, int lane) {
    const int hi = lane >> 5; const int cid = X.cid0 + c;
    { const int vr = (L == 64) ? (tid >> 3) : ((tid >> 3) & 31), vc = (tid & 7) * 4;
      Kx.vn = *(const u32x2*)(X.GV + (X.row0 + (size_t)cv * 64 + vr) * 2048 + X.h * 512 + X.sl * 32 + vc); }
#pragma unroll
    for (int i = 0; i < 4; ++i) Kx.eb[i] = *(const f32x4*)(X.EB + (size_t)cid * 1024 + X.h * 256 + 32 * wid + 8 * i + 4 * hi);
#pragma unroll
    for (int ks = 0; ks < 4; ++ks) Kx.ka[ks] = ld8_bf(X.KT + (size_t)(X.blk0 + 4 * c) * 16384 + ((size_t)((wid * 4 + ks) * 64 + lane)) * 8);
}
template <int L> __device__ __forceinline__ void gc_write_v(ldsp lds, int buf, u32x2 v, int tid) {
    const int vr = tid >> 3, vc = (tid & 7) * 4;
    if (L == 32 && vr >= 32) v = (u32x2){0u, 0u};
    *(LAS u32x2*)(lds + GC_VOFF + buf * GC_VB + vr * 64 + vc * 2) = v;
}
template <int L> __device__ __forceinline__ void gc_finish(ldsp lds, const f32x4& own, const GcCtx& X, int c, int wid, int lane, bool wr) {
    const int l15 = lane & 15, g = lane >> 4, tt = wid & 3, kh = wid >> 2;
    const f32x4 o = own + *(const LAS f32x4*)(lds + GC_XOFF + (c & 1) * GC_XB + ((wid ^ 4) * 64 + lane) * 16);
    if (wr && 16 * tt < L) { bf16* op = X.OI + (X.row0 + (size_t)c * 64 + 16 * tt + 4 * g) * 2048 + X.h * 512 + X.sl * 32 + 16 * kh + l15;
#pragma unroll
        for (int i = 0; i < 4; ++i) op[(size_t)i * 2048] = (bf16)(cvtpk(o[i], 0.f) & 0xffffu); }
}
template <int L, int VAR = 0, bool FIRST = false> __device__ __forceinline__ void gc_step(ldsp lds, f32x16& S, GcK& Kx, GcQ& Q, f32x4& own, const GcCtx& X, int c, int nsteps, int tid, int wid, int lane, bool wr) {
    const int r32 = lane & 31, hi = lane >> 5, l15 = lane & 15, g = lane >> 4, kh = wid >> 2, p = c & 1;
    const int c2 = (c + 2 < nsteps) ? c + 2 : nsteps - 1, c3 = (c + 3 < nsteps) ? c + 3 : nsteps - 1;
#pragma unroll
    for (int i = 0; i < 4; ++i) { u32x2 w; w.x = cvtpk(S[4 * i], S[4 * i + 1]); w.y = cvtpk(S[4 * i + 2], S[4 * i + 3]);
        *(LAS u32x2*)(lds + p * GC_SB + r32 * GC_SP + (32 * wid + 8 * i + 4 * hi) * 2) = w; }
    gc_write_v<L>(lds, p ^ 1, Kx.vn, tid);
    { const int trow = 8 * hi + ((lane & 15) >> 2), tcol = 16 * ((lane >> 4) & 1) + 4 * (lane & 3);
      s16x4 vl[4], vh[4];
#pragma unroll
      for (int ks = 0; ks < 4; ++ks) { ldscp vp = lds + GC_VOFF + p * GC_VB + (16 * ks + trow) * 64 + tcol * 2; vl[ks] = vtr(vp); vh[ks] = vtr(vp + 4 * 64); }
#pragma unroll
      for (int i = 0; i < 4; ++i)
#pragma unroll
          for (int j = 0; j < 4; ++j) S[4 * i + j] *= Kx.eb[i][j];
      __builtin_amdgcn_sched_barrier(0);
#pragma unroll
      for (int ks = 0; ks < 4; ++ks) { const bf16x8 vb = {vl[ks][0], vl[ks][1], vl[ks][2], vl[ks][3], vh[ks][0], vh[ks][1], vh[ks][2], vh[ks][3]};
          S = __builtin_amdgcn_mfma_f32_32x32x16_bf16(Kx.ka[ks], vb, S, 0, 0, 0); } }
    if (!(VAR & 1)) gc_load_k<L>(Kx, X, c2, c3, tid, wid, lane);
    __syncthreads();
    if constexpr (!FIRST) gc_finish<L>(lds, own, X, c - 1, wid, lane, wr);
    {
        bf16x8 b0[4], b1[4];
#pragma unroll
        for (int i = 0; i < 4; ++i) { b0[i] = *(const LAS bf16x8*)(lds + p * GC_SB + l15 * GC_SP + (32 * (4 * kh + i) + 8 * g) * 2);
                                      b1[i] = *(const LAS bf16x8*)(lds + p * GC_SB + (16 + l15) * GC_SP + (32 * (4 * kh + i) + 8 * g) * 2); }
        __builtin_amdgcn_sched_barrier(0);
        f32x4 pa = (f32x4){0.f, 0.f, 0.f, 0.f}, pb = pa;
#pragma unroll
        for (int i = 0; i < 4; ++i) { pa = __builtin_amdgcn_mfma_f32_16x16x32_bf16(Q.qa[i], b0[i], pa, 0, 0, 0); pb = __builtin_amdgcn_mfma_f32_16x16x32_bf16(Q.qa[i], b1[i], pb, 0, 0, 0); }
        const f32x4 oiv = (f32x4){bf2f(Q.oi[0]), bf2f(Q.oi[1]), bf2f(Q.oi[2]), bf2f(Q.oi[3])};
        own = (kh ? pb : pa) + oiv;
        *(LAS f32x4*)(lds + GC_XOFF + p * GC_XB + (wid * 64 + lane) * 16) = kh ? pa : pb;
    }
    if (!(VAR & 2)) gc_load_q<L>(Q, X, c2, wid, lane);
}
template <int L, int VAR = 0> __device__ __forceinline__ void gc_run(ldsp lds, f32x16& S, const GcCtx& X, int nsteps, int tid, int wid, int lane, bool wr) {
    GcK Ka, Kb; GcQ Qa, Qb; f32x4 own = (f32x4){0.f, 0.f, 0.f, 0.f};
    const int c1 = (1 < nsteps) ? 1 : 0, c2 = (2 < nsteps) ? 2 : nsteps - 1;
    { const int vr = (L == 64) ? (tid >> 3) : ((tid >> 3) & 31), vc = (tid & 7) * 4;
      const u32x2 v0 = *(const u32x2*)(X.GV + (X.row0 + vr) * 2048 + X.h * 512 + X.sl * 32 + vc);
      gc_load_k<L>(Ka, X, 0, c1, tid, wid, lane); gc_load_q<L>(Qa, X, 0, wid, lane);
      __syncthreads();
      gc_write_v<L>(lds, 0, v0, tid); }
    if (L == 64) { gc_load_k<L>(Kb, X, c1, c2, tid, wid, lane); gc_load_q<L>(Qb, X, c1, wid, lane); }
    __syncthreads();
    if (L == 64) {
        gc_step<L, VAR, true>(lds, S, Ka, Qa, own, X, 0, nsteps, tid, wid, lane, wr); gc_step<L, VAR>(lds, S, Kb, Qb, own, X, 1, nsteps, tid, wid, lane, wr);
        for (int c = 2; c < nsteps; c += 2) { gc_step<L, VAR>(lds, S, Ka, Qa, own, X, c, nsteps, tid, wid, lane, wr); gc_step<L, VAR>(lds, S, Kb, Qb, own, X, c + 1, nsteps, tid, wid, lane, wr); }
    } else gc_step<L, VAR, true>(lds, S, Ka, Qa, own, X, 0, 1, tid, wid, lane, wr);
    __syncthreads();
    gc_finish<L>(lds, own, X, nsteps - 1, wid, lane, wr);
}

struct Args { const float* in[N_IN]; float* out; unsigned char* ws; int ph_lo, ph_hi, dup, pad; };
static_assert(sizeof(Args) == N_IN * 8 + 8 + 8 + 16, "Args has no padding");
#ifndef PROBE_SUB
#define PROBE_SUB 7
#endif
#ifndef PROBE_DUP
#define PROBE_DUP 0
#endif
constexpr int N_PHASES = 16;

template <int K, int SUB = 7> __device__ __forceinline__ void run_phase(const Args& args, const ldsp lds, const int tid, const int lane, const int wid, const int G, const int cu, const bool wr) {
    const int gw = cu * NWAVES + wid, NGW = G * NWAVES; (void)gw; (void)NGW; (void)wr;
    unsigned char* const ws = args.ws; float* const out = args.out;
    gu32* const ctl = (gu32*)(ws + WS_CTL); (void)ctl;
    volatile LAS unsigned* const QW = (volatile LAS unsigned*)(lds + MISC_OFF + 64); (void)QW;
    bf16* const A = (bf16*)(ws + WS_A); (void)A;
    float* const H = out + O_Y; (void)H;
    bf16* const H1 = (bf16*)(out + O_Y); (void)H1;
    bf16* const H2 = (bf16*)(ws + WS_H2); (void)H2;
    if constexpr (K == 0) {
        LAS float* scr = (LAS float*)(lds + wid * 8448);
        constexpr int I0 = 32 * 352, I1 = 88 * 64, I2 = 32 * 328, I3 = 32 * 64, I4 = 32 * 192, I5 = 16 * 64, I6 = 32 * 64, I7 = 16 * 64, I8 = 32 * 64;
        constexpr int NIT = I0 + I1 + I2 + I3 + I4 + I5 + I6 + I7 + I8;
        (void)NIT; (void)I1; (void)I4; (void)I5; (void)I6; (void)I7; (void)I8;
        for (int it = gw; it < I0 + I2 + I3; it += NGW) {
            int r = it;
            if (r < I0) { cvt_item(args.in[I_F1GU], 2048, 2 * DFF, (bf16*)(ws + WS_WGU), 1, 352, r, scr, lane, args.in[I_F1PRE]); continue; } r -= I0;
            if (r < I2) { cvt_item(args.in[I_WIN], 2048, INW, (bf16*)(ws + WS_WIN), 2, 328, r, scr, lane, args.in[I_MIXPRE]); continue; } r -= I2;
            cvt_item(args.in[I_WMEMKV], 2048, 2048, (bf16*)(ws + WS_WIN) + (size_t)10496 * 2048, 0, 64, r, scr, lane);
        }
        f32x4 g1[8], gm[8];
        load_gain(args.in[I_F1PRE], g1, lane); load_gain(args.in[I_MEMNG], gm, lane);
        for (int m = gw; m < MA; m += NGW) {
            if (m < MT) { const float* xr = (m < NPT) ? args.in[I_XP] + (size_t)m * DM : args.in[I_XS] + (size_t)(m - NPT) * DM;
                thin_row<false, false, false, 1, false, true, true>(xr, nullptr, 0.f, g1, nullptr, g1, A + (size_t)m * DM, lane, true, (float*)(ctl + CW_IRS0) + m); }
            else thin_row<false, false, true>(args.in[I_MEMP] + (size_t)(m - MT) * DM, nullptr, 0.f, gm, nullptr, gm, A + (size_t)m * DM, lane);
        }
    }
    if constexpr (K == 1) {
        pg8::Gemm g{A, (const bf16*)(ws + WS_WGU), MT, 2 * DFF, DM}; pg8::StaticOrder S0; S0.init(MT, 2 * DFF, G, cu, WGM_A);
        DynTail<pg8::StaticOrder> S; S.init(S0, G, cu, ctl + CW_Q + 2048 * (K == 1 ? 0 : 5), QW);
        EpiGU E{(bf16*)(ws + WS_HID)};
        pg8::gemm_phase<EpiGU, DynTail<pg8::StaticOrder>, true, true>(lds, g, S, E);
        { __syncthreads();
          LAS float* scr = (LAS float*)(lds + wid * 8448);
          for (int it = gw; it < 88 * 64; it += NGW) cvt_item(args.in[I_F1D], DFF, DM, (bf16*)(ws + WS_WD), 0, 64, it, scr, lane); }
    }
    if constexpr (K == 2) {
        pg8::Gemm g{(const bf16*)(ws + WS_HID), (const bf16*)(ws + WS_WD), MT, DM, DFF}; OrderSplit S0; S0.init(G, cu, DFF / 64);
        DynTail<OrderSplit> S; S.init(S0, G, cu, ctl + CW_Q + 2048 * (K == 2 ? 1 : 6), QW);
        EpiF32 E{(bf16*)(ws + WS_F), (float*)(ws + WS_SLAB_F)};
        pg8::gemm_phase<EpiF32, DynTail<OrderSplit>, true, true>(lds, g, S, E);
    }
    if constexpr (K == 3) {
        f32x4 gp[8], gn[8];
        load_gain(args.in[I_F1POST], gp, lane); load_gain(args.in[I_MIXPRE], gn, lane);
        const bf16* F = (const bf16*)(ws + WS_F);
        float* const IRS1 = (float*)(ctl + CW_IRS1); const float* const IRS0 = (const float*)(ctl + CW_IRS0);
        for (int m = gw; m < NPT; m += NGW)
            thin_row<true, false, false, 1, true, true, true>(A + (size_t)m * DM, F + (size_t)m * DM, 0.5f, gp, nullptr, gn, A + (size_t)m * DM, lane, true, IRS1 + m, IRS0[m]);
        for (int m = NPT + gw; m < MT; m += NGW)
            thin_row<true, false, false, NSPLIT, true, true, true>(A + (size_t)m * DM, (const float*)(ws + WS_SLAB_F) + (size_t)(m - NPT) * DM, 0.5f, gp, nullptr, gn, A + (size_t)m * DM, lane, true, IRS1 + m, IRS0[m]);
    }
    if constexpr (K == 4) {
        pg8::Gemm g{A, (const bf16*)(ws + WS_WIN), MA, 49 * 256, DM}; OrderIN S0; S0.init(G, cu);
        DynTail<OrderIN> S; S.init(S0, G, cu, ctl + CW_Q + 2048 * 2, QW);
        EpiIN E{ws, out};
        pg8::gemm_phase<EpiIN, DynTail<OrderIN>, true, true>(lds, g, S, E);
    }
    if constexpr (K == 5) {
        const bf16* SBQ = (const bf16*)(ws + WS_SBQ); const bf16* SBK = (const bf16*)(ws + WS_SBK); const bf16* SBV = (const bf16*)(ws + WS_SBV);
        constexpr int NSBP = NBP * 8 * 32, NSBS = NBS * 8;
        if (SUB & 1) {
        for (int it = cu; it < NSBP; it += G) { const int qb = 31 - (it & 31), bh = it >> 5; sb_unit<false>(lds, bh >> 3, bh & 7, qb, SBQ, SBK, SBV, (bf16*)(ws + WS_SBQ), nullptr, nullptr, tid, wid, lane, wr); }
        for (int it = cu; it < NSBS; it += G) sb_unit<true>(lds, it >> 3, it & 7, 0, SBQ, SBK, SBV, (bf16*)(ws + WS_SBQ), args.in[I_CSBK], args.in[I_CSBV], tid, wid, lane, wr);
        }
        constexpr int NMP = NBP * 4 * 64, NMS = NBS * 4;
        if (SUB & 2) {
        for (int it = cu; it < NMP; it += G) { const int blk = it & 63, bh = it >> 6; mem_unit<false>(lds, bh >> 2, bh & 3, blk, (bf16*)(ws + WS_MQ), (const bf16*)(ws + WS_MKB), (const bf16*)(ws + WS_MVB), nullptr, nullptr, tid, wid, lane, wr); }
        for (int it = (cu + G - (NCHUNK * 4) % G) % G; it < NMS; it += G) mem_unit<true>(     lds, it >> 2, it & 3, 0, (bf16*)(ws + WS_MQ), nullptr, nullptr, args.in[I_CMK], args.in[I_CMV], tid, wid, lane, wr);
        }
        if (SUB & 4)
        for (int it = cu; it < NCHUNK * 4; it += G) gla_pre_item(lds, it >> 2, it & 3, ws, (bf16*)out, args.in[I_WA2], args.in[I_BA2], tid, wid, lane, wr);
    }
    if constexpr (K == 6) {
        const int r32 = lane & 31, hi = lane >> 5;
        GcCtx X; X.GV = (const bf16*)(ws + WS_GV); X.EB = (const float*)(ws + WS_EB); X.OI = (bf16*)(ws + WS_OINTRA);
        for (int it = cu; it < NBP * 4 * 16; it += G) {
            const int slot = it >> 3, bh = (it & 7) * 2 + (slot >> 4);
            const int sl = slot & 15, h = bh & 3, b = bh >> 2;
            f32x16 S;
#pragma unroll
            for (int r = 0; r < 16; ++r) S[r] = 0.f;
            X.QE = (const bf16*)out + FRAG_QEF; X.KT = (const bf16*)out + FRAG_KETF; X.row0 = (size_t)b * SEQ; X.cid0 = b * (SEQ / 64); X.blk0 = X.cid0 * 4 + h; X.h = h; X.sl = sl;
            gc_run<64, (SUB >> 3) & 3>(lds, S, X, SEQ / 64, tid, wid, lane, wr);
            float* so = out + O_GLA_P + ((size_t)(b * 4 + h) * 256 + 32 * wid) * 512 + sl * 32 + r32;
#pragma unroll
            for (int r = 0; r < 16; ++r) so[(size_t)crow(r, hi) * 512] = S[r];
        }
        for (int it = cu; it < NBS * 4 * 16; it += G) {
            const int sl = it & 15, h = (it >> 4) & 3, b = it >> 6;
            const float* si = args.in[I_SGLA] + ((size_t)(b * 4 + h) * 256 + 32 * wid) * 512 + sl * 32 + r32;
            f32x16 S;
#pragma unroll
            for (int r = 0; r < 16; ++r) S[r] = si[(size_t)crow(r, hi) * 512];
            X.QE = (const bf16*)(ws + WS_QEF_S); X.KT = (const bf16*)(ws + WS_KETF_S); X.row0 = (size_t)NPT + b * 32; X.cid0 = NPT / 64 + b; X.blk0 = b * 4 + h; X.h = h; X.sl = sl;
            gc_run<32>(lds, S, X, 1, tid, wid, lane, wr);
            float* so = out + O_GLA_S + ((size_t)(b * 4 + h) * 256 + 32 * wid) * 512 + sl * 32 + r32;
#pragma unroll
            for (int r = 0; r < 16; ++r) so[(size_t)crow(r, hi) * 512] = S[r];
        }
        __syncthreads();
        { LAS float* scr = (LAS float*)(lds + wid * 8448);
          constexpr int I4 = 32 * 192, I5 = 16 * 64, I6 = 32 * 64, I7 = 16 * 64, I8 = 32 * 64;
          for (int it = gw; it < I4 + I5 + I6 + I7 + I8; it += NGW) {
              int r = it;
              if (r < I4) { cvt_item(args.in[I_WGATE], 2048, 6144, (bf16*)(ws + WS_WGATE), 0, 192, r, scr, lane, args.in[I_MIXPRE]); continue; } r -= I4;
              if (r < I5) { cvt_item(args.in[I_WSB], 1024, 2048, (bf16*)(ws + WS_WSB), 0, 64, r, scr, lane); continue; } r -= I5;
              if (r < I6) { cvt_item(args.in[I_WGLA], 2048, 2048, (bf16*)(ws + WS_WGLA), 0, 64, r, scr, lane); continue; } r -= I6;
              if (r < I7) { cvt_item(args.in[I_WMEM], 1024, 2048, (bf16*)(ws + WS_WMEM), 0, 64, r, scr, lane); continue; } r -= I7;
              cvt_item(args.in[I_WOUT], 2048, 2048, (bf16*)(ws + WS_WOUT), 0, 64, r, scr, lane);
          }
          constexpr int J0 = 32 * 352, J1 = 88 * 64;
          for (int it = gw; it < J0 + J1; it += NGW) {
              if (it < J0) cvt_item(args.in[I_F2GU], 2048, 2 * DFF, (bf16*)(ws + WS_WGU), 1, 352, it, scr, lane, args.in[I_F2PRE]);
              else cvt_item(args.in[I_F2D], DFF, DM, (bf16*)(ws + WS_WD), 0, 64, it - J0, scr, lane);
          } }
    }
    if constexpr (K == 7) {
        const bf16* OI = (const bf16*)(ws + WS_OINTRA); bf16* GR = (bf16*)(ws + WS_GR);
        pg8::Gemm g{A, (const bf16*)(ws + WS_WGATE), MT, 3 * DM, DM}; pg8::StaticOrder S0; S0.init(MT, 3 * DM, G, cu, WGM_A);
        DynTail<pg8::StaticOrder> S; S.init(S0, G, cu, ctl + CW_Q + 2048 * 3, QW);
        EpiGate E{ws, args.in[I_BGATE]};
        pg8::gemm_phase<EpiGate, DynTail<pg8::StaticOrder>, true, true>(lds, g, S, E);
        __syncthreads();
        f32x4 gg0 = *(const f32x4*)(args.in[I_GLANG] + 8 * lane), gg1 = *(const f32x4*)(args.in[I_GLANG] + 8 * lane + 4);
        for (;;) {
        const unsigned mb = wave_ticket(ctl + CW_ITEM + 64, 8u, lane); if (mb >= (unsigned)MT) break;
#pragma unroll 1
        for (int m = (int)mb; m < (int)mb + 8; ++m) {
#pragma unroll
            for (int hh = 0; hh < 4; ++hh) {
                const size_t o = (size_t)m * 2048 + hh * 512 + 8 * lane;
                const v4u ow = __builtin_nontemporal_load((const v4u*)(OI + o)), rw = *(const v4u*)(GR + o);
                float x[8] = {bflo(ow.x), bfhi(ow.x), bflo(ow.y), bfhi(ow.y), bflo(ow.z), bfhi(ow.z), bflo(ow.w), bfhi(ow.w)};
                const float rr[8] = {bflo(rw.x), bfhi(rw.x), bflo(rw.y), bfhi(rw.y), bflo(rw.z), bfhi(rw.z), bflo(rw.w), bfhi(rw.w)};
                float ss = 0.f;
#pragma unroll
                for (int i = 0; i < 8; ++i) ss += x[i] * x[i];
                const float rs = __builtin_amdgcn_rsqf(wave_sum(ss) * (1.0f / 512.0f) + EPS);
#pragma unroll
                for (int i = 0; i < 8; ++i) x[i] = x[i] * rs * (i < 4 ? gg0[i] : gg1[i - 4]) * rr[i];
                v4u w; w.x = cvtpk(x[0], x[1]); w.y = cvtpk(x[2], x[3]); w.z = cvtpk(x[4], x[5]); w.w = cvtpk(x[6], x[7]);
                if (wr) *(v4u*)(GR + o) = w;
            }
        }
        }
    }
    if constexpr (K == 8) {
        { pg8::Gemm g{(const bf16*)(ws + WS_GR), (const bf16*)(ws + WS_WGLA), MT, DM, 2048}; pg8::StaticOrder S; S.init(MT, DM, G, cu, WGM_C);
          EpiBR<0> E{(const bf16*)(ws + WS_G1), (bf16*)(out + O_Y), nullptr};
          pg8::gemm_phase<EpiBR<0>, pg8::StaticOrder, true, true>(lds, g, S, E); }
        { pg8::Gemm g{(const bf16*)(ws + WS_SBQ), (const bf16*)(ws + WS_WSB), MT, DM, 1024}; pg8::StaticOrder S; S.init(MT, DM, G, cu, WGM_C);
          EpiBR<1> E{(const bf16*)(ws + WS_G0), (bf16*)(out + O_Y), nullptr};
          pg8::gemm_phase<EpiBR<1>, pg8::StaticOrder, true, true>(lds, g, S, E); }
    }
    if constexpr (K == 9) {
        pg8::Gemm g{(const bf16*)(ws + WS_MQ), (const bf16*)(ws + WS_WMEM), MT, DM, 1024}; pg8::StaticOrder S; S.init(MT, DM, G, cu, WGM_C);
        EpiBR<2> E{(const bf16*)(ws + WS_G2), (bf16*)(out + O_Y), (bf16*)(ws + WS_MERGED)};
        pg8::gemm_phase<EpiBR<2>, pg8::StaticOrder, true, true>(lds, g, S, E);
    }
    if constexpr (K == 10) {
        pg8::Gemm g{(const bf16*)(ws + WS_MERGED), (const bf16*)(ws + WS_WOUT), MT, DM, DM}; OrderSplit S0; S0.init(G, cu, DM / 64);
        DynTail<OrderSplit> S; S.init(S0, G, cu, ctl + CW_Q + 2048 * 4, QW);
        EpiF32 E{(bf16*)(ws + WS_FO), (float*)(ws + WS_SLAB_O)};
        pg8::gemm_phase<EpiF32, DynTail<OrderSplit>, true, true>(lds, g, S, E);
    }
    if constexpr (K == 11) {
        f32x4 gp[8], gn[8];
        load_gain(args.in[I_MIXPOST], gp, lane); load_gain(args.in[I_F2PRE], gn, lane);
        const bf16* F = (const bf16*)(ws + WS_FO);
        const float* const IRS1 = (const float*)(ctl + CW_IRS1); float* const IRS2 = (float*)(ctl + CW_IRS2);
        for (int m = gw; m < NPT; m += NGW) thin_row<true, false, false, 1, true, true, true>(A + (size_t)m * DM, F + (size_t)m * DM, 1.0f, gp, nullptr, gn, A + (size_t)m * DM, lane, wr, IRS2 + m, IRS1[m]);
        for (int m = NPT + gw; m < MT; m += NGW) thin_row<true, false, false, NSPLIT, true, true, true>(A + (size_t)m * DM, (const float*)(ws + WS_SLAB_O) + (size_t)(m - NPT) * DM, 1.0f, gp, nullptr, gn, A + (size_t)m * DM, lane, wr, IRS2 + m, IRS1[m]);
    }
    if constexpr (K == 12) {
        pg8::Gemm g{A, (const bf16*)(ws + WS_WGU), MT, 2 * DFF, DM}; pg8::StaticOrder S0; S0.init(MT, 2 * DFF, G, cu, WGM_A);
        DynTail<pg8::StaticOrder> S; S.init(S0, G, cu, ctl + CW_Q + 2048 * (K == 1 ? 0 : 5), QW);
        EpiGU E{(bf16*)(ws + WS_HID)};
        pg8::gemm_phase<EpiGU, DynTail<pg8::StaticOrder>, true, true>(lds, g, S, E);
    }
    if constexpr (K == 13) {
        pg8::Gemm g{(const bf16*)(ws + WS_HID), (const bf16*)(ws + WS_WD), MT, DM, DFF}; OrderSplit S0; S0.init(G, cu, DFF / 64);
        DynTail<OrderSplit> S; S.init(S0, G, cu, ctl + CW_Q + 2048 * (K == 2 ? 1 : 6), QW);
        EpiF32 E{(bf16*)(ws + WS_F), (float*)(ws + WS_SLAB_F)};
        pg8::gemm_phase<EpiF32, DynTail<OrderSplit>, true, true>(lds, g, S, E);
    }
    if constexpr (K == 14) {
        f32x4 gp[8];
        load_gain(args.in[I_F2POST], gp, lane);
        const bf16* F = (const bf16*)(ws + WS_F);
        const float* const IRS2 = (const float*)(ctl + CW_IRS2);
        for (int m = gw; m < NPT; m += NGW) thin_row<true, true, false, 1, true, false>(A + (size_t)m * DM, F + (size_t)m * DM, 0.5f, gp, H + (size_t)m * DM, gp, nullptr, lane, wr, nullptr, IRS2[m]);
        for (int m = NPT + gw; m < MT; m += NGW) thin_row<true, true, false, NSPLIT, true, false>(A + (size_t)m * DM, (const float*)(ws + WS_SLAB_F) + (size_t)(m - NPT) * DM, 0.5f, gp, H + (size_t)m * DM, gp, nullptr, lane, wr, nullptr, IRS2[m]);
    }
}

__global__ void __launch_bounds__(NTHR, 2) fwd_kernel(Args args) {
    extern __shared__ __attribute__((aligned(16))) unsigned char lds_raw[];
    const ldsp lds = (ldsp)lds_raw;
    volatile LAS unsigned* MISC = (volatile LAS unsigned*)(lds + MISC_OFF);
    const int tid = threadIdx.x, lane = tid & 63, wid = __builtin_amdgcn_readfirstlane(tid >> 6);
    const int G = gridDim.x, cu = blockIdx.x;
    gu32* ctl = (gu32*)(args.ws + WS_CTL);
    for (int u = tid; u < (LDS_BYTES - LDSCTL_OFF) / 4; u += NTHR) ((LAS unsigned*)(lds + LDSCTL_OFF))[u] = 0u;
    __syncthreads();
    XcdBarrier bar; bar.bar = (unsigned*)(ctl + CW_BAR); bar.x = 0; bar.st = nullptr;
    bar = xcd_barrier_post((unsigned*)(ctl + CW_BAR), MISC + 8);
    const int lo = args.ph_lo, hi_ph = args.ph_hi;
#define IN(k) (lo <= (k) && (k) < hi_ph)
#define PHASE(k) do { if (IN(k)) { if constexpr ((PROBE_DUP >> (k)) & 1) { run_phase<k, PROBE_SUB>(args, lds, tid, lane, wid, G, cu, args.pad != 0); xcd_barrier(bar); } \
        run_phase<k>(args, lds, tid, lane, wid, G, cu, true); } } while (0)
#if defined(PROBE_BWMASK)
    long long bw_sum = 0;
#define SEAM(k) do { const long long b0_ = wall_clock64(); xcd_barrier(bar); if ((PROBE_BWMASK >> (k)) & 1) bw_sum += wall_clock64() - b0_; } while (0)
#else
#define SEAM(k) xcd_barrier(bar)
#endif
    PHASE(0); SEAM(0); PHASE(1); SEAM(1); PHASE(2); SEAM(2); PHASE(3); SEAM(3); PHASE(4); SEAM(4); PHASE(5); SEAM(5); PHASE(6); SEAM(6); PHASE(7); SEAM(7);
    PHASE(8); PHASE(9); SEAM(9); PHASE(10); SEAM(10); PHASE(11); SEAM(11); PHASE(12); SEAM(12); PHASE(13); SEAM(13); PHASE(14);
#if defined(PROBE_BWMASK)
    if (tid == 0) atomicAdd((unsigned long long*)(args.ws + WS_CTL + 786432), (unsigned long long)bw_sum);
    xcd_barrier(bar);
    if (blockIdx.x == 0 && tid == 0) {
        const unsigned long long tot = __hip_atomic_load((unsigned long long*)(args.ws + WS_CTL + 786432), __ATOMIC_RELAXED, __HIP_MEMORY_SCOPE_AGENT);
        const long long spin_ticks = (long long)(tot / gridDim.x) * 10;
        const long long s0 = wall_clock64();
        while (wall_clock64() - s0 < spin_ticks) __builtin_amdgcn_s_sleep(8);
    }
#endif
#undef SEAM
#undef PHASE
#undef IN
}

extern "C" void kernel_launch(void* const* d_in, const int* in_sizes, int n_in, void* d_out, int out_size, void* d_ws, size_t ws_size, hipStream_t stream) {
    static int grid = 0;
    if (grid == 0) {
        if (n_in != N_IN || (size_t)out_size != O_END || ws_size < WS_END) { fprintf(stderr, "kernel_launch: unexpected sizes (n_in %d, out %d, ws %zu)\n", n_in, out_size, ws_size); grid = -1; return; }
        int dev = 0, cus = 0, per_cu = 0;
        if (hipGetDevice(&dev) != hipSuccess || hipDeviceGetAttribute(&cus, hipDeviceAttributeMultiprocessorCount, dev) != hipSuccess) { grid = -1; return; }
        if (hipFuncSetAttribute((const void*)fwd_kernel, hipFuncAttributeMaxDynamicSharedMemorySize, LDS_BYTES) != hipSuccess) { fprintf(stderr, "kernel_launch: hipFuncSetAttribute failed\n"); grid = -1; return; }
        if (hipOccupancyMaxActiveBlocksPerMultiprocessor(&per_cu, (const void*)fwd_kernel, NTHR, LDS_BYTES) != hipSuccess || per_cu < 1) fprintf(stderr, "kernel_launch: occupancy query says %d\n", per_cu);
        (void)hipGetLastError();
        grid = cus;
    }
    if (grid < 0) return;
    (void)hipMemsetAsync((char*)d_ws + WS_CTL, 0, CTL_ZERO_BYTES, stream);
    Args a{};
    for (int i = 0; i < N_IN; ++i) a.in[i] = (const float*)d_in[i];
    a.out = (float*)d_out; a.ws = (unsigned char*)d_ws;
    a.dup = PROBE_DUP; a.pad = 0;
    a.ph_lo = 0; a.ph_hi = N_PHASES;
    hipLaunchKernelGGL(fwd_kernel, dim3(grid), dim3(NTHR), LDS_BYTES, stream, a);
}
```

```cpp
#include <hip/hip_runtime.h>
#include <cstdio>
#include <cstdint>
#ifndef PROBE_EPI2
#define PROBE_EPI2 0
#endif
namespace pg8 {
#define PG8_LAS __attribute__((address_space(3)))
typedef unsigned short bf16_t;
typedef short bf16x8 __attribute__((ext_vector_type(8)));
typedef float f32x4 __attribute__((ext_vector_type(4)));
typedef unsigned u32x4 __attribute__((ext_vector_type(4)));
constexpr int BM = 256, BK = 64, HALF = 128, HTB = HALF * BK * 2  , STAGE_BYTES = 8 * HTB, NXCD = 8, WGM = 8;

__host__ __device__ __forceinline__ int lds_byte(int r, int c) { const int st = (r >> 4) * 2 + (c >> 5), rr = r & 15, cc = c & 31, ob = rr * 64 + cc * 2; return st * 1024 + (ob ^ (((ob >> 9) & 1) << 5)); }
__host__ __device__ __forceinline__ void stage_rc(int b, int& R, int& C) { const int st = b / 1024, sb = b % 1024, swz = sb ^ (((sb >> 9) & 1) << 5); R = (st >> 1) * 16 + swz / 64; C = (st & 1) * 32 + (swz % 64) / 2; }
__host__ __device__ __forceinline__ int perm32(int rho) { const int n = rho >> 4, i = rho & 15; return 8 * (i >> 2) + 4 * n + (i & 3); }

struct Unit { int pm, pn, kx = 0;
    __host__ __device__ int kt0() const { return kx & 0xfff; } __host__ __device__ int knt() const { return (kx >> 12) & 0xfff; } __host__ __device__ int sl() const { return (kx >> 24) - 1; } };
struct Gemm { const bf16_t* A; const bf16_t* Bt; int M, N, K; };

struct StaticOrder {
    int nM, nN, nwg, G, c, wgm;
    __host__ __device__ void init(int M, int N, int G_, int c_, int wgm_ = WGM) { nM = M / BM; nN = N / BM; nwg = nM * nN; G = G_; c = c_; wgm = wgm_; }
    __host__ __device__ bool next(int i, Unit& u) const { return map((long)i * G + c, u); }
    __device__ __forceinline__ int total() const { return nwg; }
    __device__ __forceinline__ bool first(Unit& u) const { return next(0, u); }
    __device__ __forceinline__ bool peek(int i, Unit& u, bool& pend) const { pend = false; return next(i, u); }
    __device__ __forceinline__ bool fetch(Unit&) const { return false; }
    __host__ __device__ bool map(long L, Unit& u) const {
        if (L >= nwg) return false;
        int wgid = (int)L; { const int q = nwg / NXCD, r = nwg % NXCD, xcd = wgid % NXCD, off = wgid / NXCD; wgid = (xcd < r ? xcd * (q + 1) : r * (q + 1) + (xcd - r) * q) + off; }
        const int nig = wgm * nN, gid = wgid / nig, fm = gid * wgm, gsz = (nM - fm) < wgm ? (nM - fm) : wgm;
        u.pm = fm + ((wgid % nig) % gsz); u.pn = (wgid % nig) / gsz; u.kx = 0; return true;
    }
    __device__ __forceinline__ void a_ready(const Unit&) const {}
    __device__ __forceinline__ void done(const Unit&) const {}
};
__device__ __forceinline__ unsigned cvt_pk_bf16(float lo, float hi) { unsigned r; asm volatile("v_cvt_pk_bf16_f32 %0, %1, %2" : "=v"(r) : "v"(lo), "v"(hi)); return r; }
typedef float f32x2 __attribute__((ext_vector_type(2)));
template <class Epi, class Sched, bool ALIGN_EPI = false, bool SP2 = false>
__device__ __forceinline__ void gemm_phase(PG8_LAS unsigned char* lds, const Gemm g, const Sched& S, const Epi& E) {
    const int tid = threadIdx.x, wid = __builtin_amdgcn_readfirstlane(tid >> 6), lane = tid & 63, wr = wid >> 2, wc = wid & 3, fr = lane & 15, fq = lane >> 4;
    const int K = g.K;
    unsigned voffA[2], voffB[2];
#pragma unroll
    for (int i = 0; i < 2; ++i) { int R, C; stage_rc(tid * 16 + i * 8192, R, C); const int Rb = Epi::PERM ? ((R & ~31) + perm32(R & 31)) : R;
        voffA[i] = (unsigned)(R * K + C) * 2u; voffB[i] = (unsigned)(Rb * K + C) * 2u; }
    const size_t kstep = (size_t)(BK * 2);
    const size_t hstep = (size_t)HALF * K * 2;
    const size_t tstep = 2 * hstep;
    const unsigned ldsw = (unsigned)wid * 1024u;
    const int aoff = lds_byte(wr * 64 + fr, fq * 8), boff = lds_byte(wc * 32 + fr, fq * 8);
#define PG8_SA(b, h) (((b) * 2 + (h)) * HTB)
#define PG8_SB(b, h) ((4 + (b) * 2 + (h)) * HTB)
#define PG8_STAGE(bufoff, gbase, voff) do { _Pragma("unroll") for (int _i = 0; _i < 2; ++_i) \
        __builtin_amdgcn_global_load_lds((const unsigned*)((const char*)(gbase) + (voff)[_i]), (PG8_LAS unsigned*)(lds + (bufoff) + ldsw + _i * 8192), 16, 0, 0); } while (0)
#define PG8_LDA(dst, b, h) do { _Pragma("unroll") for (int m = 0; m < 4; ++m) _Pragma("unroll") for (int k = 0; k < 2; ++k) dst[m][k] = *(const PG8_LAS bf16x8*)(lds + PG8_SA(b, h) + aoff + m * 2048 + k * 1024); } while (0)
#define PG8_LDB(dst, b, h) do { _Pragma("unroll") for (int n = 0; n < 2; ++n) _Pragma("unroll") for (int k = 0; k < 2; ++k) dst[n][k] = *(const PG8_LAS bf16x8*)(lds + PG8_SB(b, h) + boff + n * 2048 + k * 1024); } while (0)
#define PG8_MMA(ai, bj, At, Bt) do { __builtin_amdgcn_s_setprio(1); _Pragma("unroll") for (int m = 0; m < 4; ++m) _Pragma("unroll") for (int n = 0; n < 2; ++n) _Pragma("unroll") for (int k = 0; k < 2; ++k) \
        acc[ai][bj][m][n] = __builtin_amdgcn_mfma_f32_16x16x32_bf16(Bt[n][k], At[m][k], acc[ai][bj][m][n], 0, 0, 0); __builtin_amdgcn_s_setprio(0); } while (0)
#define PG8_WAIT_V(n) asm volatile("s_waitcnt vmcnt(" #n ")" ::: "memory")
#define PG8_WAIT_L(n) asm volatile("s_waitcnt lgkmcnt(" #n ")" ::: "memory")
#define PG8_BAR __builtin_amdgcn_s_barrier()
#define PG8_SCHED __builtin_amdgcn_sched_barrier(0)
    Unit cur, nxt; int ui = 0;
    if (!S.first(cur)) return;
    f32x4 acc[2][2][4][2];
#pragma unroll
    for (int a = 0; a < 2; ++a)
#pragma unroll
        for (int b = 0; b < 2; ++b)
#pragma unroll
            for (int m = 0; m < 4; ++m)
#pragma unroll
                for (int n = 0; n < 2; ++n) acc[a][b][m][n] = (f32x4){0.f, 0.f, 0.f, 0.f};
    bf16x8 At[4][2], B0[2][2], B1[2][2];
    const char* cA = (const char*)g.A + (size_t)cur.pm * tstep + (size_t)cur.kt0() * (BK * 2); const char* cB = (const char*)g.Bt + (size_t)cur.pn * tstep + (size_t)cur.kt0() * (BK * 2);
    int nt = cur.kx ? cur.knt() : K / BK;
    S.a_ready(cur);
    if constexpr (SP2) {
        PG8_STAGE(PG8_SB(0, 0), cB, voffB); PG8_STAGE(PG8_SB(0, 1), cB + hstep, voffB); PG8_STAGE(PG8_SA(0, 0), cA, voffA); PG8_STAGE(PG8_SA(0, 1), cA + hstep, voffA);
        if (wr == 1) PG8_BAR;
        PG8_WAIT_V(2); PG8_BAR;
        PG8_STAGE(PG8_SB(1, 0), cB + kstep, voffB); PG8_STAGE(PG8_SA(1, 0), cA + kstep, voffA); PG8_STAGE(PG8_SB(1, 1), cB + hstep + kstep, voffB);
        PG8_WAIT_V(6); PG8_BAR;
    } else {
        PG8_STAGE(PG8_SB(0, 0), cB, voffB); PG8_STAGE(PG8_SA(0, 0), cA, voffA); PG8_STAGE(PG8_SB(0, 1), cB + hstep, voffB); PG8_STAGE(PG8_SA(0, 1), cA + hstep, voffA);
        if (wr == 1) PG8_BAR;
        PG8_WAIT_V(4); PG8_BAR;
        PG8_STAGE(PG8_SB(1, 0), cB + kstep, voffB); PG8_STAGE(PG8_SA(1, 0), cA + kstep, voffA); PG8_STAGE(PG8_SB(1, 1), cB + hstep + kstep, voffB);
        PG8_WAIT_V(6); PG8_BAR;
    }
    for (;;) {
        bool pend = false; bool has_next = S.peek(ui + 1, nxt, pend);
        const char* nA = has_next ? (const char*)g.A + (size_t)nxt.pm * tstep + (size_t)nxt.kt0() * (BK * 2) : cA; const char* nB = has_next ? (const char*)g.Bt + (size_t)nxt.pn * tstep + (size_t)nxt.kt0() * (BK * 2) : cB;
        const int tf = nt > 4 ? nt - 4 : 0;
        for (int t = 0; t < nt; t += 2) {
            if (pend && t == tf) {
                pend = false; has_next = S.fetch(nxt);
                if (has_next) { nA = (const char*)g.A + (size_t)nxt.pm * tstep + (size_t)nxt.kt0() * (BK * 2); nB = (const char*)g.Bt + (size_t)nxt.pn * tstep + (size_t)nxt.kt0() * (BK * 2); }
            }
            const bool last = (t == nt - 2);
            const char* a1 = cA + (size_t)(t + 1) * kstep;
            const char* a2 = last ? nA : cA + (size_t)(t + 2) * kstep; const char* b2 = last ? nB : cB + (size_t)(t + 2) * kstep;
            const char* a3 = a2 + kstep; const char* b3 = b2 + kstep;
            if (last && has_next) S.a_ready(nxt);
            if constexpr (SP2) {
            PG8_LDB(B0, 0, 0); PG8_LDB(B1, 0, 1); PG8_SCHED; PG8_LDA(At, 0, 0); PG8_STAGE(PG8_SA(1, 1), a1 + hstep, voffA);
            PG8_WAIT_V(8); PG8_WAIT_L(0); PG8_BAR; PG8_MMA(0, 0, At, B0); PG8_MMA(0, 1, At, B1); PG8_BAR; PG8_SCHED;
            PG8_LDA(At, 0, 1); PG8_STAGE(PG8_SB(0, 0), b2, voffB); PG8_STAGE(PG8_SB(0, 1), b2 + hstep, voffB); PG8_STAGE(PG8_SA(0, 0), a2, voffA);
            PG8_WAIT_V(8); PG8_WAIT_L(0); PG8_BAR; PG8_MMA(1, 0, At, B0); PG8_MMA(1, 1, At, B1); PG8_BAR; PG8_SCHED;
            PG8_LDB(B0, 1, 0); PG8_LDB(B1, 1, 1); PG8_SCHED; PG8_LDA(At, 1, 0); PG8_STAGE(PG8_SA(0, 1), a2 + hstep, voffA);
            PG8_WAIT_V(8); PG8_WAIT_L(0); PG8_BAR; PG8_MMA(0, 0, At, B0); PG8_MMA(0, 1, At, B1); PG8_BAR; PG8_SCHED;
            PG8_LDA(At, 1, 1); PG8_STAGE(PG8_SB(1, 0), b3, voffB); PG8_STAGE(PG8_SB(1, 1), b3 + hstep, voffB); PG8_STAGE(PG8_SA(1, 0), a3, voffA);
            PG8_WAIT_V(8); PG8_WAIT_L(0); PG8_BAR; PG8_MMA(1, 0, At, B0); PG8_MMA(1, 1, At, B1); PG8_BAR; PG8_SCHED;
            } else {
            PG8_LDB(B0, 0, 0); PG8_SCHED; PG8_LDA(At, 0, 0); PG8_STAGE(PG8_SA(1, 1), a1 + hstep, voffA);
            PG8_WAIT_L(8); PG8_BAR; PG8_WAIT_L(0); PG8_MMA(0, 0, At, B0); PG8_BAR; PG8_SCHED;
            PG8_LDB(B1, 0, 1); PG8_STAGE(PG8_SB(0, 0), b2, voffB);
            PG8_BAR; PG8_WAIT_L(0); PG8_MMA(0, 1, At, B1); PG8_BAR;
            PG8_LDA(At, 0, 1); PG8_STAGE(PG8_SA(0, 0), a2, voffA);
            PG8_BAR; PG8_WAIT_L(0); PG8_MMA(1, 0, At, B0); PG8_BAR; PG8_SCHED;
            PG8_STAGE(PG8_SB(0, 1), b2 + hstep, voffB);
            PG8_WAIT_V(6); PG8_BAR; PG8_MMA(1, 1, At, B1); PG8_BAR;
            PG8_LDB(B0, 1, 0); PG8_SCHED; PG8_LDA(At, 1, 0); PG8_STAGE(PG8_SA(0, 1), a2 + hstep, voffA);
            PG8_WAIT_L(8); PG8_BAR; PG8_WAIT_L(0); PG8_MMA(0, 0, At, B0); PG8_BAR; PG8_SCHED;
            PG8_LDB(B1, 1, 1); PG8_STAGE(PG8_SB(1, 0), b3, voffB);
            PG8_BAR; PG8_WAIT_L(0); PG8_MMA(0, 1, At, B1); PG8_BAR;
            PG8_LDA(At, 1, 1); PG8_STAGE(PG8_SA(1, 0), a3, voffA);
            PG8_BAR; PG8_WAIT_L(0); PG8_MMA(1, 0, At, B0); PG8_BAR; PG8_SCHED;
            PG8_STAGE(PG8_SB(1, 1), b3 + hstep, voffB);
            PG8_WAIT_V(6); PG8_BAR; PG8_MMA(1, 1, At, B1); PG8_BAR;
            }
        }
        if constexpr (ALIGN_EPI) { if (wr == 0) PG8_BAR; }
        if constexpr (!Epi::AFTER_DRAIN) { E(acc, cur, wr, wc, fr, fq);
#if PROBE_EPI2
            if constexpr (Epi::IDEMP) { asm volatile("" ::: "memory"); E(acc, cur, wr, wc, fr, fq); }
#endif
            S.done(cur); }
        if (!has_next) break;
#pragma unroll
        for (int a = 0; a < 2; ++a)
#pragma unroll
            for (int b = 0; b < 2; ++b)
#pragma unroll
                for (int m = 0; m < 4; ++m)
#pragma unroll
                    for (int n = 0; n < 2; ++n) acc[a][b][m][n] = (f32x4){0.f, 0.f, 0.f, 0.f};
        cur = nxt; cA = nA; cB = nB; ++ui; nt = cur.kx ? cur.knt() : K / BK;
        if constexpr (ALIGN_EPI) { if (wr == 1) PG8_BAR; }
    }
    PG8_WAIT_V(0);
    if constexpr (!ALIGN_EPI) { if (wr == 0) PG8_BAR; }
    PG8_BAR;
    if constexpr (Epi::AFTER_DRAIN) { E.fused(acc, cur, wr, wc, fr, fq, lds, wid, lane); S.done(cur); }
#undef PG8_SA
#undef PG8_SB
#undef PG8_STAGE
#undef PG8_LDA
#undef PG8_LDB
#undef PG8_MMA
#undef PG8_WAIT_V
#undef PG8_WAIT_L
#undef PG8_BAR
#undef PG8_SCHED
}
}
#define GAS __attribute__((address_space(1)))
#define LAS __attribute__((address_space(3)))
typedef unsigned short bf16;
typedef unsigned v4u __attribute__((ext_vector_type(4)));
typedef float f32x4 __attribute__((ext_vector_type(4)));
typedef short bf16x8 __attribute__((ext_vector_type(8)));
typedef GAS unsigned gu32;
typedef GAS unsigned long long gu64;
#define RLX_AGENT __ATOMIC_RELAXED, __HIP_MEMORY_SCOPE_AGENT
#define LDS_WAIT() asm volatile("s_waitcnt lgkmcnt(0)" ::: "memory")
#define VM_WAIT() asm volatile("s_waitcnt vmcnt(0)" ::: "memory")
__device__ __forceinline__ unsigned long long rt() { return __builtin_amdgcn_s_memrealtime(); }
__device__ __forceinline__ unsigned f2bf(float f) { unsigned u = __builtin_bit_cast(unsigned, f); return (u + 0x7fffu + ((u >> 16) & 1u)) >> 16; }
__device__ __forceinline__ unsigned pk2(float lo, float hi) { return f2bf(lo) | (f2bf(hi) << 16); }

#define XB_TMO      128
#define XB_XCNT(j)  (256  + 64 * (j))
#define XB_XSUB(j)  (1280 + 64 * (j))
#define XB_XGEN(j)  (2304 + 64 * (j))
#define XB_TOP      3328
#define XB_TOPGEN   3392
#define XCD_BAR_WORDS 3456
#define XB_SPIN_CAP (1u << 18)

__device__ __forceinline__ unsigned xb_ld(unsigned* p)              { return __hip_atomic_load(p, __ATOMIC_RELAXED, __HIP_MEMORY_SCOPE_AGENT); }
__device__ __forceinline__ unsigned xb_add(unsigned* p, unsigned v) { return __hip_atomic_fetch_add(p, v, __ATOMIC_RELAXED, __HIP_MEMORY_SCOPE_AGENT); }
__device__ __forceinline__ unsigned xb_xcc_id() { return (unsigned)__builtin_amdgcn_s_getreg((3 << 11) | 20) & 0xFu; }
#define XB_SPIN(cond, bar) do { unsigned _sp = 0; while (cond) { __builtin_amdgcn_s_sleep(1); \
    if ((++_sp & 255u) == 0u) { if (xb_ld(&(bar)[XB_TMO])) break; if (_sp > XB_SPIN_CAP) { atomicAdd(&(bar)[XB_TMO], 1u); break; } } } } while (0)

struct XcdBarrier {
    unsigned* bar; unsigned x;
    volatile LAS unsigned* st;
};

__device__ __forceinline__ XcdBarrier xcd_barrier_post(unsigned* bar, volatile LAS unsigned* st) {
    XcdBarrier b; b.bar = bar; b.x = xb_xcc_id(); b.st = st;
    if (threadIdx.x == 0) (void)xb_add(&bar[XB_XCNT(b.x)], 1u);
    return b;
}
__device__ __forceinline__ void xcd_barrier_complete(unsigned* bar, unsigned x, unsigned& nloc, unsigned& nx) {
    const unsigned G = gridDim.x * gridDim.y * gridDim.z;
    unsigned sum, cnt, mine, sp = 0u;
    for (;;) {
        sum = 0u; cnt = 0u; mine = 0u;
#pragma unroll
        for (unsigned j = 0; j < 16; ++j) { const unsigned c = xb_ld(&bar[XB_XCNT(j)]); sum += c; cnt += (c > 0u) ? 1u : 0u; mine = (j == x) ? c : mine; }
        if (sum == G) break;
        __builtin_amdgcn_s_sleep(1);
        if ((++sp & 255u) == 0u) { if (xb_ld(&bar[XB_TMO])) break; if (sp > XB_SPIN_CAP) { atomicAdd(&bar[XB_TMO], 1u); break; } }
    }
    nloc = mine > 0u ? mine : 1u; nx = cnt > 0u ? cnt : 1u;
}

__device__ __forceinline__ void xcd_barrier(const XcdBarrier& b) {
    asm volatile("s_waitcnt vmcnt(0)" ::: "memory");
    __syncthreads();
    if (threadIdx.x == 0) {
        unsigned* bar = b.bar;
        __builtin_amdgcn_s_waitcnt(0);
        unsigned nloc = b.st[0], nx = b.st[1];
        if (nloc == 0u) { xcd_barrier_complete(bar, b.x, nloc, nx); b.st[0] = nloc; b.st[1] = nx; }
        const unsigned old = xb_add(&bar[XB_XSUB(b.x)], 1u);
        const unsigned gen = old / nloc;
        if (old + 1u == (gen + 1u) * nloc) {
            __builtin_amdgcn_fence(__ATOMIC_RELEASE, "agent");
            asm volatile("s_waitcnt vmcnt(0)" ::: "memory");
            const unsigned og = xb_add(&bar[XB_TOP], 1u);
            const unsigned tg = og / nx;
            if (og + 1u == (tg + 1u) * nx) xb_add(&bar[XB_TOPGEN], 1u);
            else XB_SPIN(xb_ld(&bar[XB_TOPGEN]) == tg, bar);
            __builtin_amdgcn_fence(__ATOMIC_ACQUIRE, "agent");
            xb_add(&bar[XB_XGEN(b.x)], 1u);
            asm volatile("s_waitcnt vmcnt(0)" ::: "memory");
        } else {
            XB_SPIN(xb_ld(&bar[XB_XGEN(b.x)]) == gen, bar);
            __builtin_amdgcn_fence(__ATOMIC_ACQUIRE, "agent");
            asm volatile("s_waitcnt vmcnt(0)" ::: "memory");
        }
    }
    __syncthreads();
}

typedef float f32x16 __attribute__((ext_vector_type(16)));
typedef float f32x2v __attribute__((ext_vector_type(2)));
typedef short s16x4 __attribute__((ext_vector_type(4)));
typedef short v4i16_t __attribute__((ext_vector_type(4)));
typedef unsigned u32x2 __attribute__((ext_vector_type(2)));
typedef LAS unsigned char* ldsp;
typedef const LAS unsigned char* ldscp;

constexpr int NWAVES = 8, NTHR = 512;
#ifndef MK_ONE_LAUNCH
#define MK_ONE_LAUNCH 1
#endif

constexpr int DM = 2048, DFF = 5632, SEQ = 8192, NBP = 4, NPT = NBP * SEQ, NBS = 32, DSEQ = 32, NST = NBS * DSEQ, PAST = 1024;
constexpr int MT = NPT + NST;
constexpr int MEMR = 1024, MA = MT + MEMR;
constexpr int INW = 10256;
constexpr int NCHUNK = NPT / 64 + NBS;
constexpr float EPS = 1e-6f, LOG2E = 1.4426950408889634f, LN2 = 0.6931471805599453f;
constexpr float C_SB = 0.08838834764831845f * LOG2E;
constexpr float C_MEM = 0.0625f * LOG2E;
constexpr float C_GQ = 0.0625f;
constexpr float SB_THR = 8.470329472543003e-22f;

enum { I_XP = 0, I_XS, I_MEMP, I_CSBK, I_CSBV, I_SGLA, I_CMK, I_CMV, I_F1PRE, I_F1GU, I_F1D, I_F1POST, I_MIXPRE, I_WIN, I_WA2, I_BA2, I_GLANG, I_MEMNG,
       I_WMEMKV, I_WSB, I_WGLA, I_WMEM, I_WGATE, I_BGATE, I_WOUT, I_MIXPOST, I_F2PRE, I_F2GU, I_F2D, I_F2POST, N_IN };
constexpr size_t O_Y = 0, O_SBK_P = (size_t)MT * DM, O_SBV_P = O_SBK_P + (size_t)NPT * 1024, O_GLA_P = O_SBV_P + (size_t)NPT * 1024,
                 O_MEMK_P = O_GLA_P + (size_t)NBP * 4 * 256 * 512, O_MEMV_P = O_MEMK_P + (size_t)MEMR * 1024, O_SBK_S = O_MEMV_P + (size_t)MEMR * 1024,
                 O_SBV_S = O_SBK_S + (size_t)NST * 1024, O_GLA_S = O_SBV_S + (size_t)NST * 1024, O_END = O_GLA_S + (size_t)NBS * 4 * 256 * 512;
static_assert(O_END == 159383552ull, "d_out size");

constexpr size_t MiB = 1ull << 20;
constexpr size_t WS_CTL = 0, CTL_ZERO_BYTES = 1 * MiB;
constexpr size_t WS_WGU = 1 * MiB;
constexpr size_t WS_WD = 45 * MiB;
constexpr size_t WS_WIN = 67 * MiB;
constexpr size_t WS_WGATE = 116 * MiB;
constexpr size_t WS_WSB = 140 * MiB, WS_WGLA = 144 * MiB, WS_WMEM = 152 * MiB, WS_WOUT = 156 * MiB;
constexpr size_t WS_A = 164 * MiB;
constexpr size_t WS_HID = 300 * MiB;
constexpr size_t WS_F = 663 * MiB;
constexpr size_t WS_OINTRA = 300 * MiB;
constexpr size_t WS_SBQ = 432 * MiB, WS_SBK = 498 * MiB, WS_SBV = 564 * MiB, WS_GQ = 630 * MiB, WS_GK = 696 * MiB, WS_GV = 762 * MiB, WS_GR = 894 * MiB, WS_MQ = 1026 * MiB;
constexpr size_t WS_GA = 1092 * MiB;
constexpr size_t WS_EB = 1095 * MiB;
constexpr size_t WS_MKB = 1098 * MiB, WS_MVB = 1100 * MiB, WS_END = 1110 * MiB;
constexpr size_t WS_MRG = 164 * MiB;
constexpr size_t WS_G0 = WS_SBK, WS_G1 = WS_GQ, WS_G2 = WS_GV;
constexpr size_t WS_MERGED = WS_OINTRA;
constexpr size_t WS_FO = 762 * MiB;
static_assert(WS_A + (size_t)MA * DM * 2 <= WS_HID && WS_HID + (size_t)MT * DFF * 2 <= WS_F && WS_F + (size_t)MT * DM * 4 <= WS_GA, "ws map 1");
static_assert(WS_OINTRA + (size_t)MT * DM * 2 <= WS_SBQ && WS_MQ + (size_t)MT * 1024 * 2 <= WS_GA && WS_GA + (size_t)MT * 64 <= WS_EB && WS_EB + (size_t)NCHUNK * 4096 <= WS_MKB, "ws map 2");
static_assert(WS_MRG + (size_t)MT * DM * 4 <= WS_SBQ && WS_FO + (size_t)MT * DM * 4 <= WS_MQ && WS_WIN + 12544ull * 4096 <= WS_WGATE && WS_WGU + 11264ull * 4096 <= WS_WD && WS_WD + 2048ull * 11264 <= WS_WIN, "ws map 3");
constexpr size_t FRAG_KETF = (size_t)MT * DM, FRAG_QEF = FRAG_KETF + 512ull * 4 * 16384;
constexpr size_t WS_KETF_S = 1102 * MiB, WS_QEF_S = 1106 * MiB;
static_assert((FRAG_QEF + 512ull * 4 * 16384) * 2 <= (size_t)MT * DM * 4, "fragment buffers fit in the y rows");
constexpr size_t WS_H2 = 894 * MiB;
constexpr size_t WS_SLAB_F = 1026 * MiB;
constexpr size_t WS_SLAB_O = 1026 * MiB;
static_assert(WS_SLAB_F + 8ull * NST * DM * 4 <= WS_GA && WS_SLAB_O + 8ull * NST * DM * 4 <= WS_GA && WS_F + (size_t)MT * DM * 2 <= WS_H2 && WS_FO + (size_t)MT * DM * 2 <= WS_H2 && WS_H2 + (size_t)MT * DM * 2 <= WS_SLAB_F && WS_HID + (size_t)MT * DFF * 2 <= WS_F, "slabs / H2");
constexpr int CW_TMO = 0, CW_BAR = 4096, CW_Q = 32768, CW_ITEM = 65536, CW_IRS0 = 98304, CW_IRS1 = 163840, CW_IRS2 = 198656;

constexpr int LDS_BYTES = 155648;
constexpr int LDSCTL_OFF = 151552;
constexpr int MISC_OFF = LDSCTL_OFF + 320;

__device__ __forceinline__ float wave_sum(float v) {
#pragma unroll
    for (int o = 1; o < 64; o <<= 1) v += __shfl_xor(v, o);
    return v;
}
__device__ __forceinline__ float fexp2(float x) { return __builtin_amdgcn_exp2f(x); }
__device__ __forceinline__ float flog2(float x) { return __builtin_amdgcn_logf(x); }
__device__ __forceinline__ float frcp(float x) { return __builtin_amdgcn_rcpf(x); }
__device__ __forceinline__ float sigmoidf_(float x) { return frcp(1.0f + fexp2(-x * LOG2E)); }
typedef __bf16 bf16x2_t __attribute__((ext_vector_type(2)));
__device__ __forceinline__ unsigned cvtpk(float lo, float hi) { f32x2v v = {lo, hi}; bf16x2_t b = __builtin_convertvector(v, bf16x2_t); return __builtin_bit_cast(unsigned, b); }
__device__ __forceinline__ float bf2f(unsigned short b) { return __uint_as_float(((unsigned)b) << 16); }
__device__ __forceinline__ float bflo(unsigned w) { return __uint_as_float(w << 16); }
__device__ __forceinline__ float bfhi(unsigned w) { return __uint_as_float(w & 0xffff0000u); }
__device__ __forceinline__ s16x4 vtr(ldscp p) { return __builtin_bit_cast(s16x4, __builtin_amdgcn_ds_read_tr16_b64_v4i16((LAS v4i16_t*)p)); }
__device__ __forceinline__ int crow(int r, int hi) { return (r & 3) + 8 * (r >> 2) + 4 * hi; }
__device__ __forceinline__ bf16x8 ld8_bf(const bf16* p) { return *(const bf16x8*)p; }
__device__ __forceinline__ bf16x8 ld8_f32(const float* p) { const f32x4 a = *(const f32x4*)p, b = *(const f32x4*)(p + 4); v4u w = {cvtpk(a.x, a.y), cvtpk(a.z, a.w), cvtpk(b.x, b.y), cvtpk(b.z, b.w)}; return __builtin_bit_cast(bf16x8, w); }
#define PK4(P, BASE, OUT) do { unsigned a0_ = cvtpk(P[BASE + 0], P[BASE + 1]), a1_ = cvtpk(P[BASE + 2], P[BASE + 3]); \
    unsigned b0_ = cvtpk(P[BASE + 4], P[BASE + 5]), b1_ = cvtpk(P[BASE + 6], P[BASE + 7]); \
    auto r0_ = __builtin_amdgcn_permlane32_swap(a0_, b0_, false, false); auto r1_ = __builtin_amdgcn_permlane32_swap(a1_, b1_, false, false); \
    v4u w_ = {r0_[0], r1_[0], r0_[1], r1_[1]}; OUT = __builtin_bit_cast(bf16x8, w_); } while (0)

__device__ __forceinline__ void cvt_block(const float* W, int ldw, int k0, int srccol, int nvalid, bf16* WT, int K, int dstrow, LAS float* scr, int lane, const float* kgain = nullptr) {
    const int n = lane & 31;
#pragma unroll 8
    for (int i = 0; i < 32; ++i) { const int kk = 2 * i + (lane >> 5); scr[kk * 33 + n] = (n < nvalid) ? __builtin_nontemporal_load(W + (size_t)(k0 + kk) * ldw + srccol + n) : 0.f; }
    LDS_WAIT(); asm volatile("" ::: "memory");
    const int c = lane & 7;
    f32x4 ga = {1.f, 1.f, 1.f, 1.f}, gb = ga;
    if (kgain) { ga = *(const f32x4*)(kgain + k0 + 8 * c); gb = *(const f32x4*)(kgain + k0 + 8 * c + 4); }
#pragma unroll
    for (int j = 0; j < 4; ++j) { const int nn = (lane >> 3) + 8 * j; const LAS float* s = scr + (8 * c) * 33 + nn;
        v4u o; o.x = cvtpk(s[0 * 33] * ga.x, s[1 * 33] * ga.y); o.y = cvtpk(s[2 * 33] * ga.z, s[3 * 33] * ga.w); o.z = cvtpk(s[4 * 33] * gb.x, s[5 * 33] * gb.y); o.w = cvtpk(s[6 * 33] * gb.z, s[7 * 33] * gb.w);
        *(v4u*)(WT + (size_t)(dstrow + nn) * K + k0 + 8 * c) = o; }
    LDS_WAIT(); asm volatile("" ::: "memory");
}
__device__ __forceinline__ void cvt_item(const float* W, int K, int ldw, bf16* WT, int mode, int nblk, int item, LAS float* scr, int lane, const float* kgain = nullptr) {
    const int kb = item / nblk, db = item - kb * nblk; int src = 32 * db, nvalid = 32;
    if (mode == 1) { const int t = db >> 3, j = db & 7; src = (j < 4) ? 128 * t + 32 * j : DFF + 128 * t + 32 * (j - 4); }
    if (mode == 2) { if (db >= 288 && db < 320) src = 9232 + 32 * (db - 288); else if (db == 320) { src = 9216; nvalid = 16; } else if (db > 320) { src = 0; nvalid = 0; } }
    cvt_block(W, ldw, 64 * kb, src, nvalid, WT, K, 32 * db, scr, lane, kgain);
}

__device__ __forceinline__ void load_gain(const float* g, f32x4 (&v)[8], int lane) {
#pragma unroll
    for (int j = 0; j < 8; ++j) v[j] = *(const f32x4*)(g + 4 * lane + 256 * j);
}
template <bool HAS_F, bool ST_H, bool ST_A, int NF = 1, bool BASE_BF = false, bool HOUT_BF = false, bool ST_N = false>
__device__ __forceinline__ void thin_row(const void* basev, const void* fsrc, float s, const f32x4 (&gpost)[8], void* houtv, const f32x4 (&gpre)[8], bf16* aout, int lane, bool wr = true, float* rout = nullptr, float bscale = 1.0f) {
    f32x4 h[8];
    if constexpr (BASE_BF) { const bf16* bb = (const bf16*)basev;
#pragma unroll
        for (int j = 0; j < 8; ++j) { const u32x2 w = __builtin_nontemporal_load((const u32x2*)(bb + 4 * lane + 256 * j)); h[j] = (f32x4){bflo(w.x), bfhi(w.x), bflo(w.y), bfhi(w.y)} * bscale; } }
    else { const float* base = (const float*)basev;
#pragma unroll
        for (int j = 0; j < 8; ++j) h[j] = __builtin_nontemporal_load((const f32x4*)(base + 4 * lane + 256 * j)); }
    if (HAS_F) {
        f32x4 fv[8]; float ss = 0.f;
        if constexpr (NF == 1) {
            const bf16* fb = (const bf16*)fsrc;
#pragma unroll
            for (int j = 0; j < 8; ++j) { const u32x2 w = __builtin_nontemporal_load((const u32x2*)(fb + 4 * lane + 256 * j)); fv[j] = (f32x4){bflo(w.x), bfhi(w.x), bflo(w.y), bfhi(w.y)}; }
        } else {
            const float* f = (const float*)fsrc;
#pragma unroll
            for (int j = 0; j < 8; ++j) fv[j] = __builtin_nontemporal_load((const f32x4*)(f + 4 * lane + 256 * j));
#pragma unroll 1
            for (int k = 1; k < NF; ++k) {
#pragma unroll
                for (int j = 0; j < 8; ++j) fv[j] = fv[j] + __builtin_nontemporal_load((const f32x4*)(f + (size_t)k * NST * DM + 4 * lane + 256 * j)); }
        }
#pragma unroll
        for (int j = 0; j < 8; ++j) ss += (fv[j].x * fv[j].x + fv[j].y * fv[j].y) + (fv[j].z * fv[j].z + fv[j].w * fv[j].w);
        const float r = s * __builtin_amdgcn_rsqf(wave_sum(ss) * (1.0f / DM) + EPS);
#pragma unroll
        for (int j = 0; j < 8; ++j) h[j] = h[j] + fv[j] * gpost[j] * r;
    }
    if (ST_H && wr) {
        if constexpr (HOUT_BF) { bf16* hb = (bf16*)houtv;
#pragma unroll
            for (int j = 0; j < 8; ++j) { u32x2 w; w.x = cvtpk(h[j].x, h[j].y); w.y = cvtpk(h[j].z, h[j].w); __builtin_nontemporal_store(w, (u32x2*)(hb + 4 * lane + 256 * j)); } }
        else { float* hout = (float*)houtv;
#pragma unroll
            for (int j = 0; j < 8; ++j) __builtin_nontemporal_store(h[j], (f32x4*)(hout + 4 * lane + 256 * j)); }
    }
    if constexpr (ST_N) {
        float ss = 0.f;
#pragma unroll
        for (int j = 0; j < 8; ++j) ss += (h[j].x * h[j].x + h[j].y * h[j].y) + (h[j].z * h[j].z + h[j].w * h[j].w);
        const float ms = wave_sum(ss) * (1.0f / DM) + EPS, r = __builtin_amdgcn_rsqf(ms);
        if (wr) {
#pragma unroll
            for (int j = 0; j < 8; ++j) { const f32x4 a = h[j] * r; u32x2 w; w.x = cvtpk(a.x, a.y); w.y = cvtpk(a.z, a.w); *(u32x2*)(aout + 4 * lane + 256 * j) = w; }
            if (lane == 0) *rout = ms * r;
        }
    }
    if (ST_A) {
        float ss = 0.f;
#pragma unroll
        for (int j = 0; j < 8; ++j) ss += (h[j].x * h[j].x + h[j].y * h[j].y) + (h[j].z * h[j].z + h[j].w * h[j].w);
        const float r = __builtin_amdgcn_rsqf(wave_sum(ss) * (1.0f / DM) + EPS);
#pragma unroll
        for (int j = 0; j < 8; ++j) { const f32x4 a = h[j] * gpre[j] * r; u32x2 w; w.x = cvtpk(a.x, a.y); w.y = cvtpk(a.z, a.w); *(u32x2*)(aout + 4 * lane + 256 * j) = w; }
    }
}

#ifndef PROBE_EPI2
#define PROBE_EPI2 0
#endif
struct EpiGU {
    static constexpr bool PERM = true, AFTER_DRAIN = false, IDEMP = (PROBE_EPI2 == 1);
    bf16* H;
    __device__ __forceinline__ void operator()(const pg8::f32x4 (&acc)[2][2][4][2], const pg8::Unit& u, int wr, int wc, int fr, int fq) const {
        const int row0 = u.pm * 256 + wr * 64 + fr, col0 = u.pn * 128 + wc * 32 + 8 * fq;
#pragma unroll
        for (int ai = 0; ai < 2; ++ai)
#pragma unroll
            for (int m = 0; m < 4; ++m) {
                float o[8];
#pragma unroll
                for (int n = 0; n < 2; ++n)
#pragma unroll
                    for (int i = 0; i < 4; ++i) { const float g = acc[ai][0][m][n][i], uu = acc[ai][1][m][n][i]; o[4 * n + i] = g * uu * frcp(1.0f + fexp2(-g * LOG2E)); }
                v4u w; w.x = cvtpk(o[0], o[1]); w.y = cvtpk(o[2], o[3]); w.z = cvtpk(o[4], o[5]); w.w = cvtpk(o[6], o[7]);
                *(v4u*)(H + (size_t)(row0 + ai * 128 + m * 16) * DFF + col0) = w;
            }
    }
};
struct EpiF32 {
    static constexpr bool PERM = false, AFTER_DRAIN = false, IDEMP = (PROBE_EPI2 == 2);
    bf16* C; float* SLAB;
    __device__ __forceinline__ void operator()(const pg8::f32x4 (&acc)[2][2][4][2], const pg8::Unit& u, int wr, int wc, int fr, int fq) const {
        const int row0 = u.pm * 256 + wr * 64 + fr, col0 = u.pn * 256 + wc * 32 + 4 * fq;
        if (u.kx == 0) {
#pragma unroll
            for (int ai = 0; ai < 2; ++ai)
#pragma unroll
                for (int m = 0; m < 4; ++m) { bf16* rowp = C + (size_t)(row0 + ai * 128 + m * 16) * DM + col0;
#pragma unroll
                    for (int bj = 0; bj < 2; ++bj)
#pragma unroll
                        for (int n = 0; n < 2; ++n) { const pg8::f32x4 v = acc[ai][bj][m][n]; u32x2 w; w.x = cvtpk(v[0], v[1]); w.y = cvtpk(v[2], v[3]); *(u32x2*)(rowp + bj * 128 + n * 16) = w; } }
        } else {
            float* base = SLAB + (size_t)u.sl() * NST * DM - (size_t)NPT * DM;
#pragma unroll
            for (int ai = 0; ai < 2; ++ai)
#pragma unroll
                for (int m = 0; m < 4; ++m) { float* rowp = base + (size_t)(row0 + ai * 128 + m * 16) * DM + col0;
#pragma unroll
                    for (int bj = 0; bj < 2; ++bj)
#pragma unroll
                        for (int n = 0; n < 2; ++n) *(pg8::f32x4*)(rowp + bj * 128 + n * 16) = acc[ai][bj][m][n]; }
        }
    }
};
struct EpiIN {
    static constexpr bool PERM = true, AFTER_DRAIN = false, IDEMP = (PROBE_EPI2 == 3);
    unsigned char* ws; float* out;
    __device__ __forceinline__ void operator()(const pg8::f32x4 (&acc)[2][2][4][2], const pg8::Unit& u, int wr, int wc, int fr, int fq) const {
        const int pn = u.pn, rowb = u.pm * 256 + wr * 64 + fr, cw = wc * 32 + 8 * fq;
        if (pn == 40) {
            if (wc == 0 && fq < 2) {
                float* GA = (float*)(ws + WS_GA);
#pragma unroll
                for (int ai = 0; ai < 2; ++ai)
#pragma unroll
                    for (int m = 0; m < 4; ++m) { float* p = GA + (size_t)(rowb + ai * 128 + m * 16) * 16 + 8 * fq; *(pg8::f32x4*)p = acc[ai][0][m][0]; *(pg8::f32x4*)(p + 4) = acc[ai][0][m][1]; }
            }
            return;
        }
        bf16* bb; int ld, c0; float sc = 1.0f; float* fo = nullptr; int act = 0;
        const bool samp = (u.pm >= 128);
        if (pn >= 41) {
            const int t = pn - 41; ld = 1024;
            if (t < 4) { bb = (bf16*)(ws + WS_MKB); c0 = t * 256; fo = out + O_MEMK_P; } else { bb = (bf16*)(ws + WS_MVB); c0 = (t - 4) * 256; fo = out + O_MEMV_P; }
        } else if (pn < 4) { bb = (bf16*)(ws + WS_SBQ); ld = 1024; c0 = pn * 256; sc = C_SB; }
        else if (pn < 8) { bb = (bf16*)(ws + WS_SBK); ld = 1024; c0 = (pn - 4) * 256; fo = samp ? out + O_SBK_S : out + O_SBK_P; }
        else if (pn < 12) { bb = (bf16*)(ws + WS_SBV); ld = 1024; c0 = (pn - 8) * 256; fo = samp ? out + O_SBV_S : out + O_SBV_P; }
        else if (pn < 16) { bb = (bf16*)(ws + WS_GQ); ld = 1024; c0 = (pn - 12) * 256; sc = C_GQ; }
        else if (pn < 20) { bb = (bf16*)(ws + WS_GK); ld = 1024; c0 = (pn - 16) * 256; }
        else if (pn < 28) { bb = (bf16*)(ws + WS_GV); ld = 2048; c0 = (pn - 20) * 256; }
        else if (pn < 36) { bb = (bf16*)(ws + WS_GR); ld = 2048; c0 = (pn - 28) * 256; act = 1; }
        else { bb = (bf16*)(ws + WS_MQ); ld = 1024; c0 = (pn - 36) * 256; sc = C_MEM; }
        const int rb_b = (pn >= 41) ? rowb - MT : rowb;
        const int rb_f = (pn >= 41) ? rowb - MT : (samp ? rowb - NPT : rowb);
#pragma unroll
        for (int ai = 0; ai < 2; ++ai)
#pragma unroll
            for (int m = 0; m < 4; ++m)
#pragma unroll
                for (int bj = 0; bj < 2; ++bj) {
                    pg8::f32x4 v0 = acc[ai][bj][m][0], v1 = acc[ai][bj][m][1];
                    const int cc = c0 + bj * 128 + cw; const int ro = ai * 128 + m * 16;
                    if (fo) { float* p = fo + (size_t)(rb_f + ro) * 1024 + cc; __builtin_nontemporal_store(v0, (pg8::f32x4*)p); __builtin_nontemporal_store(v1, (pg8::f32x4*)(p + 4)); }
                    if (act) {
#pragma unroll
                        for (int i = 0; i < 4; ++i) { v0[i] = v0[i] * frcp(1.0f + fexp2(-v0[i] * LOG2E)); v1[i] = v1[i] * frcp(1.0f + fexp2(-v1[i] * LOG2E)); }
                    }
                    v0 = v0 * sc; v1 = v1 * sc;
                    v4u w; w.x = cvtpk(v0[0], v0[1]); w.y = cvtpk(v0[2], v0[3]); w.z = cvtpk(v1[0], v1[1]); w.w = cvtpk(v1[2], v1[3]);
                    *(v4u*)(bb + (size_t)(rb_b + ro) * ld + cc) = w;
                }
    }
};
struct EpiGate {
    static constexpr bool PERM = true, AFTER_DRAIN = false, IDEMP = (PROBE_EPI2 == 4);
    unsigned char* ws; const float* bias;
    __device__ __forceinline__ void operator()(const pg8::f32x4 (&acc)[2][2][4][2], const pg8::Unit& u, int wr, int wc, int fr, int fq) const {
        const int br = u.pn >> 3, rowb = u.pm * 256 + wr * 64 + fr, cw = wc * 32 + 8 * fq, c0 = (u.pn & 7) * 256;
        unsigned char* G = ws + (br == 0 ? WS_G0 : (br == 1 ? WS_G1 : WS_G2));
        pg8::f32x4 bv[2][2];
#pragma unroll
        for (int bj = 0; bj < 2; ++bj)
#pragma unroll
            for (int n = 0; n < 2; ++n) bv[bj][n] = *(const pg8::f32x4*)(bias + u.pn * 256 + bj * 128 + cw + 4 * n);
#pragma unroll
        for (int ai = 0; ai < 2; ++ai)
#pragma unroll
            for (int m = 0; m < 4; ++m)
#pragma unroll
                for (int bj = 0; bj < 2; ++bj) {
                    float o[8];
#pragma unroll
                    for (int n = 0; n < 2; ++n)
#pragma unroll
                        for (int i = 0; i < 4; ++i) o[4 * n + i] = sigmoidf_(acc[ai][bj][m][n][i] + bv[bj][n][i]);
                    unsigned q[8];
#pragma unroll
                    for (int k = 0; k < 8; ++k) q[k] = (unsigned)(o[k] * 255.0f + 0.5f);
                    u32x2 w; w.x = q[0] | (q[1] << 8) | (q[2] << 16) | (q[3] << 24); w.y = q[4] | (q[5] << 8) | (q[6] << 16) | (q[7] << 24);
                    *(u32x2*)(G + (size_t)(rowb + ai * 128 + m * 16) * DM + c0 + bj * 128 + cw) = w;
                }
    }
};
template <int MODE> struct EpiBR {
    static constexpr bool PERM = false, AFTER_DRAIN = false, IDEMP = false;
    const unsigned char* G; bf16* MRG; bf16* OUTB;
    __device__ __forceinline__ void operator()(const pg8::f32x4 (&acc)[2][2][4][2], const pg8::Unit& u, int wr, int wc, int fr, int fq) const {
        const int row0 = u.pm * 256 + wr * 64 + fr, col0 = u.pn * 256 + wc * 32 + 4 * fq;
#pragma unroll
        for (int ai = 0; ai < 2; ++ai)
#pragma unroll
            for (int m = 0; m < 4; ++m) { const size_t ro = (size_t)(row0 + ai * 128 + m * 16) * DM + col0;
#pragma unroll
                for (int bj = 0; bj < 2; ++bj)
#pragma unroll
                    for (int n = 0; n < 2; ++n) { const size_t o = ro + bj * 128 + n * 16; const unsigned gw = *(const unsigned*)(G + o);
                        pg8::f32x4 g = {(float)(gw & 0xffu), (float)((gw >> 8) & 0xffu), (float)((gw >> 16) & 0xffu), (float)(gw >> 24)}; pg8::f32x4 v = (g * (1.0f / 255.0f)) * acc[ai][bj][m][n];
                        if (MODE >= 1) { const u32x2 mw = *(const u32x2*)(MRG + o); v = v + (pg8::f32x4){bflo(mw.x), bfhi(mw.x), bflo(mw.y), bfhi(mw.y)}; }
                        u32x2 w; w.x = cvtpk(v[0], v[1]); w.y = cvtpk(v[2], v[3]);
                        *(u32x2*)((MODE <= 1 ? MRG : OUTB) + o) = w; }
            }
    }
};
#ifndef WGM_A
#define WGM_A 4
#endif
#ifndef WGM_B
#define WGM_B 4
#endif
#ifndef WGM_C
#define WGM_C 4
#endif
struct OrderIN {
    pg8::StaticOrder S; int G, c;
    __device__ void init(int G_, int c_) { S.init(MT, 41 * 256, G_, c_, WGM_A); G = G_; c = c_; }
    __device__ __forceinline__ int total() const { return S.nwg + 32; }
    __device__ bool map(long L, pg8::Unit& u) const {
        if (L < S.nwg) return S.map(L, u);
        const int j = (int)(L - S.nwg); if (j >= 32) return false;
        u.pm = MT / 256 + (j & 3); u.pn = 41 + (j >> 2); u.kx = 0; return true;
    }
    __device__ bool next(int i, pg8::Unit& u) const { return map((long)i * G + c, u); }
    __device__ __forceinline__ void a_ready(const pg8::Unit&) const {}
    __device__ __forceinline__ void done(const pg8::Unit&) const {}
};

constexpr int NSPLIT = 4;
struct OrderSplit {
    pg8::StaticOrder S; int G, c, ntk;
    __device__ void init(int G_, int c_, int ntk_) { S.init(NPT, DM, G_, c_, WGM_B); G = G_; c = c_; ntk = ntk_; }
    __device__ __forceinline__ int total() const { return S.nwg + 32 * NSPLIT; }
    __device__ bool next(int i, pg8::Unit& u) const { return map((long)i * G + c, u); }
    __device__ bool map(long L, pg8::Unit& u) const {
        if (L < S.nwg) return S.map(L, u);
        const int j = (int)(L - S.nwg); if (j >= 32 * NSPLIT) return false;
        const int tile = j / NSPLIT, sl = j % NSPLIT;
        u.pm = NPT / 256 + (tile >> 3); u.pn = tile & 7;
        int n, t0;
        n = ntk / NSPLIT; t0 = n * sl;
        u.kx = t0 | (n << 12) | ((sl + 1) << 24);
        return true;
    }
    __device__ __forceinline__ void a_ready(const pg8::Unit&) const {}
    __device__ __forceinline__ void done(const pg8::Unit&) const {}
};

#ifndef DYN_ROUNDS
#define DYN_ROUNDS 3
#endif
template <class Map> struct DynTail {
    Map M; int G, c, nstatic, Ls, Ltot; gu32* heads; volatile LAS unsigned* qw;
    __device__ void init(const Map& m, int G_, int c_, gu32* heads_, volatile LAS unsigned* qw_) {
        M = m; G = G_; c = c_; heads = heads_; qw = qw_; Ltot = M.total();
        const int R = (Ltot + G - 1) / G; nstatic = R > DYN_ROUNDS ? R - DYN_ROUNDS : 0; Ls = nstatic * G;
    }
    __device__ __forceinline__ bool fetch(pg8::Unit& u) const {
        if (__builtin_amdgcn_readfirstlane((int)(threadIdx.x >> 6)) == 0) {
            if ((threadIdx.x & 63) == 0) {
                unsigned L = 0xffffffffu;
                for (int s = 0; s < 8; ++s) {
                    const int x = (c + s) & 7;
                    const unsigned k = __hip_atomic_fetch_add((unsigned*)heads + x * 256, 1u, __ATOMIC_RELAXED, __HIP_MEMORY_SCOPE_AGENT);
                    const unsigned cand = (unsigned)Ls + (unsigned)((x - Ls) & 7) + 8u * k;
                    if (cand < (unsigned)Ltot) { L = cand; break; }
                }
                *qw = L;
            }
            asm volatile("s_waitcnt lgkmcnt(0)" ::: "memory");
        }
        asm volatile("" ::: "memory"); __builtin_amdgcn_s_barrier(); asm volatile("" ::: "memory");
        const unsigned L = __builtin_amdgcn_readfirstlane(*qw);
        if (L == 0xffffffffu) return false;
        return M.map((long)L, u);
    }
    __device__ __forceinline__ bool first(pg8::Unit& u) const { if (nstatic > 0) return M.map((long)c, u); return fetch(u); }
    __device__ __forceinline__ bool peek(int i, pg8::Unit& u, bool& pend) const {
        if (i < nstatic) { pend = false; return M.map((long)i * G + c, u); }
        pend = true; return false;
    }
    __device__ __forceinline__ void a_ready(const pg8::Unit&) const {}
    __device__ __forceinline__ void done(const pg8::Unit&) const {}
};
__device__ __forceinline__ unsigned wave_ticket(gu32* cnt, unsigned n, int lane) {
    unsigned b = 0; if (lane == 0) b = __hip_atomic_fetch_add((unsigned*)cnt, n, __ATOMIC_RELAXED, __HIP_MEMORY_SCOPE_AGENT);
    return __builtin_amdgcn_readfirstlane(b);
}

constexpr int SB_KP = 272, SB_VP = 288, SB_VOFF = 64 * SB_KP, SB_FLAG = SB_VOFF + 64 * SB_VP;
__device__ __forceinline__ void sb_weights(f32x16& p0, f32x16& p1, float& Rin, int kpos0, int qpos, bool mask, int hi) {
#pragma unroll
    for (int r = 0; r < 16; ++r) { p0[r] = frcp(1.0f + fexp2(p0[r])); p1[r] = frcp(1.0f + fexp2(p1[r])); }
    if (mask) {
#pragma unroll
        for (int r = 0; r < 16; ++r) { const int kp = kpos0 + crow(r, hi); if (kp >= qpos) p0[r] = 1.0f; if (kp + 32 >= qpos) p1[r] = 1.0f; }
    }
    float TG[16];
#pragma unroll
    for (int i = 0; i < 4; ++i) {
        const float t0 = (p0[4 * i] * p0[4 * i + 1]) * (p0[4 * i + 2] * p0[4 * i + 3]), t1 = (p1[4 * i] * p1[4 * i + 1]) * (p1[4 * i + 2] * p1[4 * i + 3]);
        auto a = __builtin_amdgcn_permlane32_swap(__float_as_uint(t0), __float_as_uint(t0), false, false);
        auto b = __builtin_amdgcn_permlane32_swap(__float_as_uint(t1), __float_as_uint(t1), false, false);
        TG[2 * i] = __uint_as_float(a[0]); TG[2 * i + 1] = __uint_as_float(a[1]); TG[8 + 2 * i] = __uint_as_float(b[0]); TG[8 + 2 * i + 1] = __uint_as_float(b[1]);
    }
    float E[17]; E[16] = Rin;
#pragma unroll
    for (int g = 15; g >= 0; --g) E[g] = E[g + 1] * TG[g];
#pragma unroll
    for (int i = 0; i < 4; ++i) {
        { const float st = hi ? E[2 * i + 2] : E[2 * i + 1];
          const float R3 = st * p0[4 * i + 3], R2 = R3 * p0[4 * i + 2], R1 = R2 * p0[4 * i + 1], R0 = R1 * p0[4 * i];
          p0[4 * i + 3] = st - R3; p0[4 * i + 2] = R3 - R2; p0[4 * i + 1] = R2 - R1; p0[4 * i] = R1 - R0; }
        { const float st = hi ? E[8 + 2 * i + 2] : E[8 + 2 * i + 1];
          const float R3 = st * p1[4 * i + 3], R2 = R3 * p1[4 * i + 2], R1 = R2 * p1[4 * i + 1], R0 = R1 * p1[4 * i];
          p1[4 * i + 3] = st - R3; p1[4 * i + 2] = R3 - R2; p1[4 * i + 1] = R2 - R1; p1[4 * i] = R1 - R0; }
    }
    Rin = E[0];
}
template <bool SAMPLE>
__device__ __forceinline__ void sb_unit(ldsp lds, int b, int h, int qb, const bf16* SBQ, const bf16* SBK, const bf16* SBV, bf16* OSB, const float* cK, const float* cV, int tid, int wid, int lane, bool wr) {
    const int r32 = lane & 31, hi = lane >> 5;
    const int nwv = SAMPLE ? 1 : 8;
    const size_t qrow0 = SAMPLE ? (size_t)NPT + b * 32 : (size_t)b * SEQ + qb * 256;
    const int qpos0 = SAMPLE ? PAST : qb * 256;
    const bool wact = wid < nwv;
    const int qmin = qpos0 + 32 * wid, qpos = qmin + r32, qmax = qmin + 31;
    bf16x8 qr[8];
    if (wact) {
        const bf16* qp = SBQ + (qrow0 + 32 * wid + r32) * 1024 + h * 128 + hi * 8;
#pragma unroll
        for (int d0 = 0; d0 < 8; ++d0) qr[d0] = ld8_bf(qp + d0 * 16);
    } else {
#pragma unroll
        for (int d0 = 0; d0 < 8; ++d0) qr[d0] = (bf16x8){0, 0, 0, 0, 0, 0, 0, 0};
    }
    f32x16 o[4];
#pragma unroll
    for (int d = 0; d < 4; ++d)
#pragma unroll
        for (int r = 0; r < 16; ++r) o[d][r] = 0.f;
    float Rin = 1.0f;
    const int sr = tid >> 4, sc = (tid & 15) * 8;
    volatile LAS int* flags = (volatile LAS int*)(lds + SB_FLAG);
    const int kt_last = SAMPLE ? (PAST + DSEQ - 1) / 64 : (qpos0 + 255) / 64;
    bf16x8 k0v, k1v, v0v, v1v;
#define SB_LOAD(KT) do { const int kt_ = (KT); \
        if (!SAMPLE) { const size_t base = ((size_t)b * SEQ + kt_ * 64) * 1024 + h * 128 + sc; \
            k0v = ld8_bf(SBK + base + (size_t)sr * 1024); k1v = ld8_bf(SBK + base + (size_t)(sr + 32) * 1024); \
            v0v = ld8_bf(SBV + base + (size_t)sr * 1024); v1v = ld8_bf(SBV + base + (size_t)(sr + 32) * 1024); } \
        else if (kt_ * 64 < PAST) { const size_t base = ((size_t)b * PAST + kt_ * 64) * 1024 + h * 128 + sc; \
            k0v = ld8_f32(cK + base + (size_t)sr * 1024); k1v = ld8_f32(cK + base + (size_t)(sr + 32) * 1024); \
            v0v = ld8_f32(cV + base + (size_t)sr * 1024); v1v = ld8_f32(cV + base + (size_t)(sr + 32) * 1024); } \
        else { const size_t base = ((size_t)NPT + b * 32) * 1024 + h * 128 + sc;     \
            k0v = ld8_bf(SBK + base + (size_t)sr * 1024); v0v = ld8_bf(SBV + base + (size_t)sr * 1024); \
            k1v = (bf16x8){0, 0, 0, 0, 0, 0, 0, 0}; v1v = k1v; } } while (0)
    SB_LOAD(kt_last);
    for (int kt = kt_last; kt >= 0; --kt) {
        *(LAS bf16x8*)(lds + sr * SB_KP + sc * 2) = k0v; *(LAS bf16x8*)(lds + (sr + 32) * SB_KP + sc * 2) = k1v;
        *(LAS bf16x8*)(lds + SB_VOFF + sr * SB_VP + sc * 2) = v0v; *(LAS bf16x8*)(lds + SB_VOFF + (sr + 32) * SB_VP + sc * 2) = v1v;
        if (kt > 0) SB_LOAD(kt - 1);
        __syncthreads();
        int alive = 0;
        if (wact) {
            alive = 1;
            const int kpos0 = kt * 64;
            if (kpos0 < qmax && __any(Rin >= SB_THR)) {
                f32x16 p0, p1;
#pragma unroll
                for (int r = 0; r < 16; ++r) { p0[r] = 0.f; p1[r] = 0.f; }
                {
                    bf16x8 a0[8], a1[8];
#pragma unroll
                    for (int d0 = 0; d0 < 8; ++d0) { a0[d0] = *(const LAS bf16x8*)(lds + r32 * SB_KP + (d0 * 16 + hi * 8) * 2); a1[d0] = *(const LAS bf16x8*)(lds + (32 + r32) * SB_KP + (d0 * 16 + hi * 8) * 2); }
                    __builtin_amdgcn_sched_barrier(0);
#pragma unroll
                    for (int d0 = 0; d0 < 8; ++d0) { p0 = __builtin_amdgcn_mfma_f32_32x32x16_bf16(a0[d0], qr[d0], p0, 0, 0, 0); p1 = __builtin_amdgcn_mfma_f32_32x32x16_bf16(a1[d0], qr[d0], p1, 0, 0, 0); }
                }
                sb_weights(p0, p1, Rin, kpos0, qpos, kpos0 + 63 >= qmin, hi);
                bf16x8 pa[4]; PK4(p0, 0, pa[0]); PK4(p0, 8, pa[1]); PK4(p1, 0, pa[2]); PK4(p1, 8, pa[3]);
                const int vrow = 8 * hi + ((lane & 15) >> 2), vcol = 16 * ((lane >> 4) & 1) + 4 * (lane & 3);
                {
                    s16x4 cl[4], ch[4], nl[4], nh[4];
                    ldscp vp0 = lds + SB_VOFF + vrow * SB_VP + vcol * 2;
#pragma unroll
                    for (int d0 = 0; d0 < 4; ++d0) { cl[d0] = vtr(vp0 + 64 * d0); ch[d0] = vtr(vp0 + 64 * d0 + 4 * SB_VP); }
#pragma unroll
                    for (int ks = 0; ks < 4; ++ks) {
                        if (ks < 3) {
#pragma unroll
                            for (int d0 = 0; d0 < 4; ++d0) { nl[d0] = vtr(vp0 + 16 * (ks + 1) * SB_VP + 64 * d0); nh[d0] = vtr(vp0 + 16 * (ks + 1) * SB_VP + 64 * d0 + 4 * SB_VP); }
                        }
                        __builtin_amdgcn_sched_barrier(0);
#pragma unroll
                        for (int d0 = 0; d0 < 4; ++d0) { const bf16x8 vb = {cl[d0][0], cl[d0][1], cl[d0][2], cl[d0][3], ch[d0][0], ch[d0][1], ch[d0][2], ch[d0][3]};
                            o[d0] = __builtin_amdgcn_mfma_f32_32x32x16_bf16(pa[ks], vb, o[d0], 0, 0, 0); }
                        __builtin_amdgcn_sched_barrier(0);
#pragma unroll
                        for (int d0 = 0; d0 < 4; ++d0) { cl[d0] = nl[d0]; ch[d0] = nh[d0]; }
                    }
                }
            }
            alive = __any(Rin >= SB_THR) ? 1 : 0;
        }
        if (lane == 0) flags[wid] = alive;
        __syncthreads();
        int any_alive = 0;
#pragma unroll
        for (int w = 0; w < 8; ++w) any_alive |= flags[w];
        if (!any_alive) break;
    }
#undef SB_LOAD
    __syncthreads();
    if (wact && wr) {
        bf16* op = OSB + (qrow0 + 32 * wid) * 1024 + h * 128 + r32;
#pragma unroll
        for (int r = 0; r < 16; ++r) { const int qq = crow(r, hi);
#pragma unroll
            for (int d0 = 0; d0 < 4; ++d0) op[(size_t)qq * 1024 + d0 * 32] = (bf16)(cvtpk(o[d0][r], 0.f) & 0xffffu); }
    }
}

constexpr int MEM_P = 544;
template <bool SAMPLE>
__device__ __forceinline__ void mem_unit(ldsp lds, int b, int h, int qblk, bf16* MQ, const bf16* MKB, const bf16* MVB, const float* cK, const float* cV, int tid, int wid, int lane, bool wr) {
    const int l15 = lane & 15, g = lane >> 4;
    const size_t qrow0 = SAMPLE ? (size_t)NPT + b * 32 : (size_t)b * SEQ + qblk * 128;
    const bool wact = SAMPLE ? (wid < 2) : true;
    bf16x8 qf[8];
    if (wact) { const bf16* qp = MQ + (qrow0 + 16 * wid + l15) * 1024 + h * 256 + 8 * g;
#pragma unroll
        for (int s = 0; s < 8; ++s) qf[s] = ld8_bf(qp + 32 * s); }
    else {
#pragma unroll
        for (int s = 0; s < 8; ++s) qf[s] = (bf16x8){0, 0, 0, 0, 0, 0, 0, 0}; }
    f32x4 st[4][4];
#pragma unroll
    for (int a = 0; a < 4; ++a)
#pragma unroll
        for (int c = 0; c < 4; ++c) st[a][c] = (f32x4){0.f, 0.f, 0.f, 0.f};
    const int sx = tid & 31, sr0 = tid >> 5;
    const size_t kvbase = (size_t)b * 256 * 1024 + h * 256 + 8 * sx;
    bf16x8 tv[4];
#define MEM_LOAD(SRCF, SRCB, KT) do { _Pragma("unroll") for (int c = 0; c < 4; ++c) { const size_t so_ = kvbase + (size_t)((KT) * 64 + sr0 + 16 * c) * 1024; \
        tv[c] = SAMPLE ? ld8_f32((SRCF) + so_) : ld8_bf((SRCB) + so_); } } while (0)
    MEM_LOAD(cK, MKB, 0);
#pragma unroll
    for (int kt = 0; kt < 4; ++kt) {
        __syncthreads();
#pragma unroll
        for (int c = 0; c < 4; ++c) *(LAS bf16x8*)(lds + (sr0 + 16 * c) * MEM_P + sx * 16) = tv[c];
        if (kt < 3) MEM_LOAD(cK, MKB, kt + 1); else MEM_LOAD(cV, MVB, 0);
        __syncthreads();
        if (wact) {
            bf16x8 ac[4], an[4];
#pragma unroll
            for (int t4 = 0; t4 < 4; ++t4) ac[t4] = *(const LAS bf16x8*)(lds + (16 * t4 + l15) * MEM_P + (8 * g) * 2);
#pragma unroll
            for (int s = 0; s < 8; ++s) {
                if (s < 7) {
#pragma unroll
                    for (int t4 = 0; t4 < 4; ++t4) an[t4] = *(const LAS bf16x8*)(lds + (16 * t4 + l15) * MEM_P + (32 * (s + 1) + 8 * g) * 2);
                }
                __builtin_amdgcn_sched_barrier(0);
#pragma unroll
                for (int t4 = 0; t4 < 4; ++t4) st[kt][t4] = __builtin_amdgcn_mfma_f32_16x16x32_bf16(ac[t4], qf[s], st[kt][t4], 0, 0, 0);
                __builtin_amdgcn_sched_barrier(0);
#pragma unroll
                for (int t4 = 0; t4 < 4; ++t4) ac[t4] = an[t4];
            }
        }
    }
    float mx = -3.0e38f;
#pragma unroll
    for (int a = 0; a < 4; ++a)
#pragma unroll
        for (int c = 0; c < 4; ++c)
#pragma unroll
            for (int i = 0; i < 4; ++i) mx = fmaxf(mx, st[a][c][i]);
    mx = fmaxf(mx, __shfl_xor(mx, 16)); mx = fmaxf(mx, __shfl_xor(mx, 32));
    float sm = 0.f;
#pragma unroll
    for (int a = 0; a < 4; ++a)
#pragma unroll
        for (int c = 0; c < 4; ++c)
#pragma unroll
            for (int i = 0; i < 4; ++i) { st[a][c][i] = fexp2(st[a][c][i] - mx); sm += st[a][c][i]; }
    sm += __shfl_xor(sm, 16); sm += __shfl_xor(sm, 32);
    const float inv = 1.0f / sm;
    f32x4 o[16];
#pragma unroll
    for (int c = 0; c < 16; ++c) o[c] = (f32x4){0.f, 0.f, 0.f, 0.f};
#pragma unroll
    for (int kt = 0; kt < 4; ++kt) {
        __syncthreads();
#pragma unroll
        for (int c = 0; c < 4; ++c) *(LAS bf16x8*)(lds + (sr0 + 16 * c) * MEM_P + sx * 16) = tv[c];
        if (kt < 3) MEM_LOAD(cV, MVB, kt + 1);
        __syncthreads();
        if (wact) {
#pragma unroll
            for (int s2 = 0; s2 < 2; ++s2) {
                const f32x4 x0 = st[kt][2 * s2] * inv, x1 = st[kt][2 * s2 + 1] * inv;
                v4u pw = {cvtpk(x0[0], x0[1]), cvtpk(x0[2], x0[3]), cvtpk(x1[0], x1[1]), cvtpk(x1[2], x1[3])};
                const bf16x8 pa = __builtin_bit_cast(bf16x8, pw);
                ldscp vp0 = lds + (32 * s2 + 4 * g + (l15 >> 2)) * MEM_P + (4 * (lane & 3)) * 2;
                s16x4 cl[4], ch[4], nl[4], nh[4];
#pragma unroll
                for (int i = 0; i < 4; ++i) { cl[i] = vtr(vp0 + 32 * i); ch[i] = vtr(vp0 + 32 * i + 16 * MEM_P); }
#pragma unroll
                for (int grp = 0; grp < 4; ++grp) {
                    if (grp < 3) {
#pragma unroll
                        for (int i = 0; i < 4; ++i) { nl[i] = vtr(vp0 + 32 * (4 * grp + 4 + i)); nh[i] = vtr(vp0 + 32 * (4 * grp + 4 + i) + 16 * MEM_P); }
                    }
                    __builtin_amdgcn_sched_barrier(0);
#pragma unroll
                    for (int i = 0; i < 4; ++i) { const bf16x8 vb = {cl[i][0], cl[i][1], cl[i][2], cl[i][3], ch[i][0], ch[i][1], ch[i][2], ch[i][3]};
                        o[4 * grp + i] = __builtin_amdgcn_mfma_f32_16x16x32_bf16(pa, vb, o[4 * grp + i], 0, 0, 0); }
                    __builtin_amdgcn_sched_barrier(0);
#pragma unroll
                    for (int i = 0; i < 4; ++i) { cl[i] = nl[i]; ch[i] = nh[i]; }
                }
            }
        }
    }
    if (wact && wr) {
        bf16* op = MQ + (qrow0 + 16 * wid + 4 * g) * 1024 + h * 256 + l15;
#pragma unroll
        for (int cb = 0; cb < 16; ++cb)
#pragma unroll
            for (int i = 0; i < 4; ++i) op[(size_t)i * 1024 + cb * 16] = (bf16)(cvtpk(o[cb][i], 0.f) & 0xffffu);
    }
#undef MEM_LOAD
    __syncthreads();
}

constexpr int GP_VP = 1056, GP_QP = 528, GP_QE = 67584, GP_KD = 101376, GP_ATT = 135168, GP_AP = 144, GP_BP = 260;
__device__ __forceinline__ void gla_pre_item(ldsp lds, int cid, int h, unsigned char* ws, bf16* frag, const float* wa2, const float* ba2, int tid, int wid, int lane, bool wr) {
    const bool samp = cid >= NPT / 64; const int L = samp ? 32 : 64;
    const size_t row0 = samp ? (size_t)NPT + (cid - NPT / 64) * 32 : (size_t)cid * 64;
    bf16* GQ = (bf16*)(ws + WS_GQ); bf16* GK = (bf16*)(ws + WS_GK); const bf16* GV = (const bf16*)(ws + WS_GV); const float* GA = (const float*)(ws + WS_GA);
    float* EB = (float*)(ws + WS_EB); bf16* OI = (bf16*)(ws + WS_OINTRA);
    bf16* const qef = samp ? (bf16*)(ws + WS_QEF_S) + (size_t)((cid - NPT / 64) * 4 + h) * 16384 : frag + FRAG_QEF + (size_t)(cid * 4 + h) * 16384;
    bf16* const ketf = samp ? (bf16*)(ws + WS_KETF_S) + (size_t)((cid - NPT / 64) * 4 + h) * 16384 : frag + FRAG_KETF + (size_t)(cid * 4 + h) * 16384;
    LAS float* bl = (LAS float*)lds; LAS float* gal = (LAS float*)(lds + GP_ATT);
    const int dk = tid & 255, half = tid >> 8;
    const int cx = tid & 31, tg = tid >> 5;
    bf16x8 qin[4], kin[4];
#pragma unroll
    for (int j = 0; j < 4; ++j) { const int t = tg + 16 * j; qin[j] = (bf16x8){0, 0, 0, 0, 0, 0, 0, 0}; kin[j] = qin[j];
        if (t < L) { qin[j] = ld8_bf(GQ + (row0 + t) * 1024 + h * 256 + 8 * cx); kin[j] = ld8_bf(GK + (row0 + t) * 1024 + h * 256 + 8 * cx); } }
    __syncthreads();
    for (int i = tid; i < 64 * 16; i += NTHR) { const int t = i >> 4; gal[i] = (t < L) ? GA[(row0 + t) * 16 + (i & 15)] : 0.f; }
    float w[16];
#pragma unroll
    for (int r = 0; r < 16; ++r) w[r] = wa2[r * 1024 + h * 256 + dk];
    const float bias = ba2[h * 256 + dk];
    __syncthreads();
    float cum = 0.f;
#pragma unroll 4
    for (int tt = 0; tt < 32; ++tt) {
        const int t = half * 32 + tt; float x = bias;
#pragma unroll
        for (int r = 0; r < 16; ++r) x += gal[t * 16 + r] * w[r];
        const float ls = fminf(x, 0.f) - LN2 * flog2(1.0f + fexp2(-fabsf(x) * LOG2E));
        if (t < L) cum += ls * (1.0f / 16.0f);
        bl[t * GP_BP + dk] = cum;
    }
    __syncthreads();
    const float add = half ? bl[31 * GP_BP + dk] : 0.f;
    if (half) {
#pragma unroll 8
        for (int tt = 0; tt < 32; ++tt) bl[(32 + tt) * GP_BP + dk] += add;
    }
    __syncthreads();
    {
        const f32x4 l0 = *(const LAS f32x4*)(bl + 63 * GP_BP + 8 * cx), l1 = *(const LAS f32x4*)(bl + 63 * GP_BP + 8 * cx + 4);
#pragma unroll
        for (int j = 0; j < 4; ++j) {
            const int t = tg + 16 * j;
            const f32x4 b0 = *(const LAS f32x4*)(bl + t * GP_BP + 8 * cx), b1 = *(const LAS f32x4*)(bl + t * GP_BP + 8 * cx + 4);
            float qe[8], kd[8];
#pragma unroll
            for (int i = 0; i < 8; ++i) {
                const float bb = (i < 4 ? b0[i] : b1[i - 4]) * LOG2E;
                const float q = bf2f((unsigned short)qin[j][i]), k = bf2f((unsigned short)kin[j][i]);
                qe[i] = q * fexp2(bb); kd[i] = k * fexp2(-bb);
            }
            *(LAS v4u*)(lds + GP_QE + t * GP_QP + cx * 16) = (v4u){cvtpk(qe[0], qe[1]), cvtpk(qe[2], qe[3]), cvtpk(qe[4], qe[5]), cvtpk(qe[6], qe[7])};
            *(LAS v4u*)(lds + GP_KD + t * GP_QP + cx * 16) = (v4u){cvtpk(kd[0], kd[1]), cvtpk(kd[2], kd[3]), cvtpk(kd[4], kd[5]), cvtpk(kd[6], kd[7])};
        }
        if (tg == 0) { float* e = EB + (size_t)cid * 1024 + h * 256 + 8 * cx;
            *(f32x4*)e = (f32x4){fexp2(l0[0] * LOG2E), fexp2(l0[1] * LOG2E), fexp2(l0[2] * LOG2E), fexp2(l0[3] * LOG2E)};
            *(f32x4*)(e + 4) = (f32x4){fexp2(l1[0] * LOG2E), fexp2(l1[1] * LOG2E), fexp2(l1[2] * LOG2E), fexp2(l1[3] * LOG2E)}; }
    }
    __syncthreads();
    { const int l15 = lane & 15, g = lane >> 4;
#pragma unroll
      for (int tt = 0; tt < 4; ++tt) *(v4u*)(qef + ((size_t)((tt * 8 + wid) * 64 + lane)) * 8) = *(const LAS v4u*)(lds + GP_QE + (16 * tt + l15) * GP_QP + (32 * wid + 8 * g) * 2); }
    { const int r32_ = lane & 31, hi_ = lane >> 5;
      const float ebl = fexp2(bl[63 * GP_BP + 32 * wid + r32_] * LOG2E);
      const int trow = 8 * hi_ + ((lane & 15) >> 2), tcol = 16 * ((lane >> 4) & 1) + 4 * (lane & 3);
      s16x4 kl[4], kh[4];
#pragma unroll
      for (int ks = 0; ks < 4; ++ks) { ldscp kp = lds + GP_KD + (16 * ks + trow) * GP_QP + (32 * wid + tcol) * 2; kl[ks] = vtr(kp); kh[ks] = vtr(kp + 4 * GP_QP); }
#pragma unroll
      for (int ks = 0; ks < 4; ++ks) {
          float e[8];
#pragma unroll
          for (int j = 0; j < 4; ++j) { e[j] = bf2f((unsigned short)kl[ks][j]) * ebl; e[4 + j] = bf2f((unsigned short)kh[ks][j]) * ebl; }
          *(v4u*)(ketf + ((size_t)((wid * 4 + ks) * 64 + lane)) * 8) = (v4u){cvtpk(e[0], e[1]), cvtpk(e[2], e[3]), cvtpk(e[4], e[5]), cvtpk(e[6], e[7])};
      } }
    __syncthreads();
    { const int vx = tid & 63, vr0 = tid >> 6;
      bf16x8 vv[8];
#pragma unroll
      for (int p = 0; p < 8; ++p) { const int vr = vr0 + 8 * p; vv[p] = (bf16x8){0, 0, 0, 0, 0, 0, 0, 0}; if (vr < L) vv[p] = ld8_bf(GV + (row0 + vr) * 2048 + h * 512 + 8 * vx); }
#pragma unroll
      for (int p = 0; p < 8; ++p) *(LAS bf16x8*)(lds + (vr0 + 8 * p) * GP_VP + vx * 16) = vv[p]; }
    const int r32 = lane & 31, hi = lane >> 5;
    if (wid < 3) {
        const int sb = (wid == 2) ? 1 : 0, tb = (wid >= 1) ? 1 : 0;
        f32x16 p;
#pragma unroll
        for (int r = 0; r < 16; ++r) p[r] = 0.f;
#pragma unroll
        for (int kb = 0; kb < 4; ++kb) {
            bf16x8 a[4], bq[4];
#pragma unroll
            for (int k4 = 0; k4 < 4; ++k4) { const int ks = 4 * kb + k4;
                a[k4] = *(const LAS bf16x8*)(lds + GP_KD + (32 * sb + r32) * GP_QP + (16 * ks + 8 * hi) * 2);
                bq[k4] = *(const LAS bf16x8*)(lds + GP_QE + (32 * tb + r32) * GP_QP + (16 * ks + 8 * hi) * 2); }
            __builtin_amdgcn_sched_barrier(0);
#pragma unroll
            for (int k4 = 0; k4 < 4; ++k4) p = __builtin_amdgcn_mfma_f32_32x32x16_bf16(a[k4], bq[k4], p, 0, 0, 0);
        }
        const int t = 32 * tb + r32;
#pragma unroll
        for (int i = 0; i < 4; ++i) {
            float v[4];
#pragma unroll
            for (int j = 0; j < 4; ++j) { const int s = 32 * sb + 8 * i + 4 * hi + j; v[j] = (s <= t) ? p[4 * i + j] : 0.f; }
            u32x2 wv; wv.x = cvtpk(v[0], v[1]); wv.y = cvtpk(v[2], v[3]);
            *(LAS u32x2*)(lds + GP_ATT + t * GP_AP + (32 * sb + 8 * i + 4 * hi) * 2) = wv;
        }
    } else if (wid == 3) {
        for (int i = lane; i < 32 * 4; i += 64) { const int t = i >> 2, c = i & 3; *(LAS v4u*)(lds + GP_ATT + t * GP_AP + 64 + c * 16) = (v4u){0u, 0u, 0u, 0u}; }
    }
    __syncthreads();
    {
        bf16x8 af[2][4];
#pragma unroll
        for (int tb = 0; tb < 2; ++tb)
#pragma unroll
            for (int ks = 0; ks < 4; ++ks) af[tb][ks] = *(const LAS bf16x8*)(lds + GP_ATT + (32 * tb + r32) * GP_AP + (16 * ks + 8 * hi) * 2);
        const int vrow = 8 * hi + ((lane & 15) >> 2), vcol = 16 * ((lane >> 4) & 1) + 4 * (lane & 3);
#pragma unroll
        for (int cbi = 0; cbi < 2; ++cbi) {
            const int cb = 2 * wid + cbi;
            f32x16 o0, o1;
#pragma unroll
            for (int r = 0; r < 16; ++r) { o0[r] = 0.f; o1[r] = 0.f; }
            s16x4 lo[4], hh[4];
#pragma unroll
            for (int ks = 0; ks < 4; ++ks) { ldscp vp = lds + (16 * ks + vrow) * GP_VP + (32 * cb + vcol) * 2; lo[ks] = vtr(vp); hh[ks] = vtr(vp + 4 * GP_VP); }
            __builtin_amdgcn_sched_barrier(0);
#pragma unroll
            for (int ks = 0; ks < 4; ++ks) {
                const bf16x8 vb = {lo[ks][0], lo[ks][1], lo[ks][2], lo[ks][3], hh[ks][0], hh[ks][1], hh[ks][2], hh[ks][3]};
                if (ks < 2) o0 = __builtin_amdgcn_mfma_f32_32x32x16_bf16(af[0][ks], vb, o0, 0, 0, 0);
                o1 = __builtin_amdgcn_mfma_f32_32x32x16_bf16(af[1][ks], vb, o1, 0, 0, 0);
            }
            bf16* op = OI + row0 * 2048 + h * 512 + 32 * cb + r32;
#pragma unroll
            for (int r = 0; r < 16; ++r) { const int t = crow(r, hi);
                if (t < L) op[(size_t)t * 2048] = (bf16)(cvtpk(o0[r], 0.f) & 0xffffu);
                if (t + 32 < L) op[(size_t)(t + 32) * 2048] = (bf16)(cvtpk(o1[r], 0.f) & 0xffffu); }
        }
    }
    __syncthreads();
}

constexpr int GC_SP = 528, GC_SB = 32 * GC_SP, GC_VOFF = 2 * GC_SB, GC_VB = 4096;
constexpr int GC_XOFF = GC_VOFF + 2 * GC_VB, GC_XB = 8192;
struct GcQ { bf16x8 qa[4]; unsigned short oi[4]; };
struct GcK { bf16x8 ka[4]; f32x4 eb[4]; u32x2 vn; };
struct GcCtx { const bf16* QE; const bf16* KT; const bf16* GV; const float* EB; bf16* OI; size_t row0; int cid0, blk0, h, sl; };
template <int L> __device__ __forceinline__ void gc_load_q(GcQ& Q, const GcCtx& X, int c, int wid, int lane) {
    const int l15 = lane & 15, g = lane >> 4, tt = (L == 64) ? (wid & 3) : (wid & 1), kh = wid >> 2;
    const size_t r = X.row0 + (size_t)c * 64 + 16 * tt;
#pragma unroll
    for (int i = 0; i < 4; ++i) Q.qa[i] = ld8_bf(X.QE + (size_t)(X.blk0 + 4 * c) * 16384 + ((size_t)((tt * 8 + 4 * kh + i) * 64 + lane)) * 8);
#pragma unroll
    for (int i = 0; i < 4; ++i) Q.oi[i] = X.OI[(r + 4 * g + i) * 2048 + X.h * 512 + X.sl * 32 + 16 * kh + l15];
}
template <int L> __device__ __forceinline__ void gc_load_k(GcK& Kx, const GcCtx& X, int c, int cv, int tid, int wid, int lane) {
    const int hi = lane >> 5; const int cid = X.cid0 + c;
    { const int vr = (L == 64) ? (tid >> 3) : ((tid >> 3) & 31), vc = (tid & 7) * 4;
      Kx.vn = *(const u32x2*)(X.GV + (X.row0 + (size_t)cv * 64 + vr) * 2048 + X.h * 512 + X.sl * 32 + vc); }
#pragma unroll
    for (int i = 0; i < 4; ++i) Kx.eb[i] = *(const f32x4*)(X.EB + (size_t)cid * 1024 + X.h * 256 + 32 * wid + 8 * i + 4 * hi);
#pragma unroll
    for (int ks = 0; ks < 4; ++ks) Kx.ka[ks] = ld8_bf(X.KT + (size_t)(X.blk0 + 4 * c) * 16384 + ((size_t)((wid * 4 + ks) * 64 + lane)) * 8);
}
template <int L> __device__ __forceinline__ void gc_write_v(ldsp lds, int buf, u32x2 v, int tid) {
    const int vr = tid >> 3, vc = (tid & 7) * 4;
    if (L == 32 && vr >= 32) v = (u32x2){0u, 0u};
    *(LAS u32x2*)(lds + GC_VOFF + buf * GC_VB + vr * 64 + vc * 2) = v;
}
template <int L> __device__ __forceinline__ void gc_finish(ldsp lds, const f32x4& own, const GcCtx& X, int c, int wid, int lane, bool wr) {
    const int l15 = lane & 15, g = lane >> 4, tt = wid & 3, kh = wid >> 2;
    const f32x4 o = own + *(const LAS f32x4*)(lds + GC_XOFF + (c & 1) * GC_XB + ((wid ^ 4) * 64 + lane) * 16);
    if (wr && 16 * tt < L) { bf16* op = X.OI + (X.row0 + (size_t)c * 64 + 16 * tt + 4 * g) * 2048 + X.h * 512 + X.sl * 32 + 16 * kh + l15;
#pragma unroll
        for (int i = 0; i < 4; ++i) op[(size_t)i * 2048] = (bf16)(cvtpk(o[i], 0.f) & 0xffffu); }
}
template <int L, int VAR = 0, bool FIRST = false> __device__ __forceinline__ void gc_step(ldsp lds, f32x16& S, GcK& Kx, GcQ& Q, f32x4& own, const GcCtx& X, int c, int nsteps, int tid, int wid, int lane, bool wr) {
    const int r32 = lane & 31, hi = lane >> 5, l15 = lane & 15, g = lane >> 4, kh = wid >> 2, p = c & 1;
    const int c2 = (c + 2 < nsteps) ? c + 2 : nsteps - 1, c3 = (c + 3 < nsteps) ? c + 3 : nsteps - 1;
#pragma unroll
    for (int i = 0; i < 4; ++i) { u32x2 w; w.x = cvtpk(S[4 * i], S[4 * i + 1]); w.y = cvtpk(S[4 * i + 2], S[4 * i + 3]);
        *(LAS u32x2*)(lds + p * GC_SB + r32 * GC_SP + (32 * wid + 8 * i + 4 * hi) * 2) = w; }
    gc_write_v<L>(lds, p ^ 1, Kx.vn, tid);
    { const int trow = 8 * hi + ((lane & 15) >> 2), tcol = 16 * ((lane >> 4) & 1) + 4 * (lane & 3);
      s16x4 vl[4], vh[4];
#pragma unroll
      for (int ks = 0; ks < 4; ++ks) { ldscp vp = lds + GC_VOFF + p * GC_VB + (16 * ks + trow) * 64 + tcol * 2; vl[ks] = vtr(vp); vh[ks] = vtr(vp + 4 * 64); }
#pragma unroll
      for (int i = 0; i < 4; ++i)
#pragma unroll
          for (int j = 0; j < 4; ++j) S[4 * i + j] *= Kx.eb[i][j];
      __builtin_amdgcn_sched_barrier(0);
#pragma unroll
      for (int ks = 0; ks < 4; ++ks) { const bf16x8 vb = {vl[ks][0], vl[ks][1], vl[ks][2], vl[ks][3], vh[ks][0], vh[ks][1], vh[ks][2], vh[ks][3]};
          S = __builtin_amdgcn_mfma_f32_32x32x16_bf16(Kx.ka[ks], vb, S, 0, 0, 0); } }
    if (!(VAR & 1)) gc_load_k<L>(Kx, X, c2, c3, tid, wid, lane);
    __syncthreads();
    if constexpr (!FIRST) gc_finish<L>(lds, own, X, c - 1, wid, lane, wr);
    {
        bf16x8 b0[4], b1[4];
#pragma unroll
        for (int i = 0; i < 4; ++i) { b0[i] = *(const LAS bf16x8*)(lds + p * GC_SB + l15 * GC_SP + (32 * (4 * kh + i) + 8 * g) * 2);
                                      b1[i] = *(const LAS bf16x8*)(lds + p * GC_SB + (16 + l15) * GC_SP + (32 * (4 * kh + i) + 8 * g) * 2); }
        __builtin_amdgcn_sched_barrier(0);
        f32x4 pa = (f32x4){0.f, 0.f, 0.f, 0.f}, pb = pa;
#pragma unroll
        for (int i = 0; i < 4; ++i) { pa = __builtin_amdgcn_mfma_f32_16x16x32_bf16(Q.qa[i], b0[i], pa, 0, 0, 0); pb = __builtin_amdgcn_mfma_f32_16x16x32_bf16(Q.qa[i], b1[i], pb, 0, 0, 0); }
        const f32x4 oiv = (f32x4){bf2f(Q.oi[0]), bf2f(Q.oi[1]), bf2f(Q.oi[2]), bf2f(Q.oi[3])};
        own = (kh ? pb : pa) + oiv;
        *(LAS f32x4*)(lds + GC_XOFF + p * GC_XB + (wid * 64 + lane) * 16) = kh ? pa : pb;
    }
    if (!(VAR & 2)) gc_load_q<L>(Q, X, c2, wid, lane);
}
template <int L, int VAR = 0> __device__ __forceinline__ void gc_run(ldsp lds, f32x16& S, const GcCtx& X, int nsteps, int tid, int wid, int lane, bool wr) {
    GcK Ka, Kb; GcQ Qa, Qb; f32x4 own = (f32x4){0.f, 0.f, 0.f, 0.f};
    const int c1 = (1 < nsteps) ? 1 : 0, c2 = (2 < nsteps) ? 2 : nsteps - 1;
    { const int vr = (L == 64) ? (tid >> 3) : ((tid >> 3) & 31), vc = (tid & 7) * 4;
      const u32x2 v0 = *(const u32x2*)(X.GV + (X.row0 + vr) * 2048 + X.h * 512 + X.sl * 32 + vc);
      gc_load_k<L>(Ka, X, 0, c1, tid, wid, lane); gc_load_q<L>(Qa, X, 0, wid, lane);
      __syncthreads();
      gc_write_v<L>(lds, 0, v0, tid); }
    if (L == 64) { gc_load_k<L>(Kb, X, c1, c2, tid, wid, lane); gc_load_q<L>(Qb, X, c1, wid, lane); }
    __syncthreads();
    if (L == 64) {
        gc_step<L, VAR, true>(lds, S, Ka, Qa, own, X, 0, nsteps, tid, wid, lane, wr); gc_step<L, VAR>(lds, S, Kb, Qb, own, X, 1, nsteps, tid, wid, lane, wr);
        for (int c = 2; c < nsteps; c += 2) { gc_step<L, VAR>(lds, S, Ka, Qa, own, X, c, nsteps, tid, wid, lane, wr); gc_step<L, VAR>(lds, S, Kb, Qb, own, X, c + 1, nsteps, tid, wid, lane, wr); }
    } else gc_step<L, VAR, true>(lds, S, Ka, Qa, own, X, 0, 1, tid, wid, lane, wr);
    __syncthreads();
    gc_finish<L>(lds, own, X, nsteps - 1, wid, lane, wr);
}

struct Args { const float* in[N_IN]; float* out; unsigned char* ws; int ph_lo, ph_hi, dup, pad; };
static_assert(sizeof(Args) == N_IN * 8 + 8 + 8 + 16, "Args has no padding");
#ifndef PROBE_SUB
#define PROBE_SUB 7
#endif
#ifndef PROBE_DUP
#define PROBE_DUP 0
#endif
constexpr int N_PHASES = 16;

template <int K, int SUB = 7> __device__ __forceinline__ void run_phase(const Args& args, const ldsp lds, const int tid, const int lane, const int wid, const int G, const int cu, const bool wr) {
    const int gw = cu * NWAVES + wid, NGW = G * NWAVES; (void)gw; (void)NGW; (void)wr;
    unsigned char* const ws = args.ws; float* const out = args.out;
    gu32* const ctl = (gu32*)(ws + WS_CTL); (void)ctl;
    volatile LAS unsigned* const QW = (volatile LAS unsigned*)(lds + MISC_OFF + 64); (void)QW;
    bf16* const A = (bf16*)(ws + WS_A); (void)A;
    float* const H = out + O_Y; (void)H;
    bf16* const H1 = (bf16*)(out + O_Y); (void)H1;
    bf16* const H2 = (bf16*)(ws + WS_H2); (void)H2;
    if constexpr (K == 0) {
        LAS float* scr = (LAS float*)(lds + wid * 8448);
        constexpr int I0 = 32 * 352, I1 = 88 * 64, I2 = 32 * 328, I3 = 32 * 64, I4 = 32 * 192, I5 = 16 * 64, I6 = 32 * 64, I7 = 16 * 64, I8 = 32 * 64;
        constexpr int NIT = I0 + I1 + I2 + I3 + I4 + I5 + I6 + I7 + I8;
        (void)NIT; (void)I1; (void)I4; (void)I5; (void)I6; (void)I7; (void)I8;
        for (int it = gw; it < I0 + I2 + I3; it += NGW) {
            int r = it;
            if (r < I0) { cvt_item(args.in[I_F1GU], 2048, 2 * DFF, (bf16*)(ws + WS_WGU), 1, 352, r, scr, lane, args.in[I_F1PRE]); continue; } r -= I0;
            if (r < I2) { cvt_item(args.in[I_WIN], 2048, INW, (bf16*)(ws + WS_WIN), 2, 328, r, scr, lane, args.in[I_MIXPRE]); continue; } r -= I2;
            cvt_item(args.in[I_WMEMKV], 2048, 2048, (bf16*)(ws + WS_WIN) + (size_t)10496 * 2048, 0, 64, r, scr, lane);
        }
        f32x4 g1[8], gm[8];
        load_gain(args.in[I_F1PRE], g1, lane); load_gain(args.in[I_MEMNG], gm, lane);
        for (int m = gw; m < MA; m += NGW) {
            if (m < MT) { const float* xr = (m < NPT) ? args.in[I_XP] + (size_t)m * DM : args.in[I_XS] + (size_t)(m - NPT) * DM;
                thin_row<false, false, false, 1, false, true, true>(xr, nullptr, 0.f, g1, nullptr, g1, A + (size_t)m * DM, lane, true, (float*)(ctl + CW_IRS0) + m); }
            else thin_row<false, false, true>(args.in[I_MEMP] + (size_t)(m - MT) * DM, nullptr, 0.f, gm, nullptr, gm, A + (size_t)m * DM, lane);
        }
    }
    if constexpr (K == 1) {
        pg8::Gemm g{A, (const bf16*)(ws + WS_WGU), MT, 2 * DFF, DM}; pg8::StaticOrder S0; S0.init(MT, 2 * DFF, G, cu, WGM_A);
        DynTail<pg8::StaticOrder> S; S.init(S0, G, cu, ctl + CW_Q + 2048 * (K == 1 ? 0 : 5), QW);
        EpiGU E{(bf16*)(ws + WS_HID)};
        pg8::gemm_phase<EpiGU, DynTail<pg8::StaticOrder>, true, true>(lds, g, S, E);
        { __syncthreads();
          LAS float* scr = (LAS float*)(lds + wid * 8448);
          for (int it = gw; it < 88 * 64; it += NGW) cvt_item(args.in[I_F1D], DFF, DM, (bf16*)(ws + WS_WD), 0, 64, it, scr, lane); }
    }
    if constexpr (K == 2) {
        pg8::Gemm g{(const bf16*)(ws + WS_HID), (const bf16*)(ws + WS_WD), MT, DM, DFF}; OrderSplit S0; S0.init(G, cu, DFF / 64);
        DynTail<OrderSplit> S; S.init(S0, G, cu, ctl + CW_Q + 2048 * (K == 2 ? 1 : 6), QW);
        EpiF32 E{(bf16*)(ws + WS_F), (float*)(ws + WS_SLAB_F)};
        pg8::gemm_phase<EpiF32, DynTail<OrderSplit>, true, true>(lds, g, S, E);
    }
    if constexpr (K == 3) {
        f32x4 gp[8], gn[8];
        load_gain(args.in[I_F1POST], gp, lane); load_gain(args.in[I_MIXPRE], gn, lane);
        const bf16* F = (const bf16*)(ws + WS_F);
        float* const IRS1 = (float*)(ctl + CW_IRS1); const float* const IRS0 = (const float*)(ctl + CW_IRS0);
        for (int m = gw; m < NPT; m += NGW)
            thin_row<true, false, false, 1, true, true, true>(A + (size_t)m * DM, F + (size_t)m * DM, 0.5f, gp, nullptr, gn, A + (size_t)m * DM, lane, true, IRS1 + m, IRS0[m]);
        for (int m = NPT + gw; m < MT; m += NGW)
            thin_row<true, false, false, NSPLIT, true, true, true>(A + (size_t)m * DM, (const float*)(ws + WS_SLAB_F) + (size_t)(m - NPT) * DM, 0.5f, gp, nullptr, gn, A + (size_t)m * DM, lane, true, IRS1 + m, IRS0[m]);
    }
    if constexpr (K == 4) {
        pg8::Gemm g{A, (const bf16*)(ws + WS_WIN), MA, 49 * 256, DM}; OrderIN S0; S0.init(G, cu);
        DynTail<OrderIN> S; S.init(S0, G, cu, ctl + CW_Q + 2048 * 2, QW);
        EpiIN E{ws, out};
        pg8::gemm_phase<EpiIN, DynTail<OrderIN>, true, true>(lds, g, S, E);
    }
    if constexpr (K == 5) {
        const bf16* SBQ = (const bf16*)(ws + WS_SBQ); const bf16* SBK = (const bf16*)(ws + WS_SBK); const bf16* SBV = (const bf16*)(ws + WS_SBV);
        constexpr int NSBP = NBP * 8 * 32, NSBS = NBS * 8;
        if (SUB & 1) {
        for (int it = cu; it < NSBP; it += G) { const int qb = 31 - (it & 31), bh = it >> 5; sb_unit<false>(lds, bh >> 3, bh & 7, qb, SBQ, SBK, SBV, (bf16*)(ws + WS_SBQ), nullptr, nullptr, tid, wid, lane, wr); }
        for (int it = cu; it < NSBS; it += G) sb_unit<true>(lds, it >> 3, it & 7, 0, SBQ, SBK, SBV, (bf16*)(ws + WS_SBQ), args.in[I_CSBK], args.in[I_CSBV], tid, wid, lane, wr);
        }
        constexpr int NMP = NBP * 4 * 64, NMS = NBS * 4;
        if (SUB & 2) {
        for (int it = cu; it < NMP; it += G) { const int blk = it & 63, bh = it >> 6; mem_unit<false>(lds, bh >> 2, bh & 3, blk, (bf16*)(ws + WS_MQ), (const bf16*)(ws + WS_MKB), (const bf16*)(ws + WS_MVB), nullptr, nullptr, tid, wid, lane, wr); }
        for (int it = (cu + G - (NCHUNK * 4) % G) % G; it < NMS; it += G) mem_unit<true>(     lds, it >> 2, it & 3, 0, (bf16*)(ws + WS_MQ), nullptr, nullptr, args.in[I_CMK], args.in[I_CMV], tid, wid, lane, wr);
        }
        if (SUB & 4)
        for (int it = cu; it < NCHUNK * 4; it += G) gla_pre_item(lds, it >> 2, it & 3, ws, (bf16*)out, args.in[I_WA2], args.in[I_BA2], tid, wid, lane, wr);
    }
    if constexpr (K == 6) {
        const int r32 = lane & 31, hi = lane >> 5;
        GcCtx X; X.GV = (const bf16*)(ws + WS_GV); X.EB = (const float*)(ws + WS_EB); X.OI = (bf16*)(ws + WS_OINTRA);
        for (int it = cu; it < NBP * 4 * 16; it += G) {
            const int slot = it >> 3, bh = (it & 7) * 2 + (slot >> 4);
            const int sl = slot & 15, h = bh & 3, b = bh >> 2;
            f32x16 S;
#pragma unroll
            for (int r = 0; r < 16; ++r) S[r] = 0.f;
            X.QE = (const bf16*)out + FRAG_QEF; X.KT = (const bf16*)out + FRAG_KETF; X.row0 = (size_t)b * SEQ; X.cid0 = b * (SEQ / 64); X.blk0 = X.cid0 * 4 + h; X.h = h; X.sl = sl;
            gc_run<64, (SUB >> 3) & 3>(lds, S, X, SEQ / 64, tid, wid, lane, wr);
            float* so = out + O_GLA_P + ((size_t)(b * 4 + h) * 256 + 32 * wid) * 512 + sl * 32 + r32;
#pragma unroll
            for (int r = 0; r < 16; ++r) so[(size_t)crow(r, hi) * 512] = S[r];
        }
        for (int it = cu; it < NBS * 4 * 16; it += G) {
            const int sl = it & 15, h = (it >> 4) & 3, b = it >> 6;
            const float* si = args.in[I_SGLA] + ((size_t)(b * 4 + h) * 256 + 32 * wid) * 512 + sl * 32 + r32;
            f32x16 S;
#pragma unroll
            for (int r = 0; r < 16; ++r) S[r] = si[(size_t)crow(r, hi) * 512];
            X.QE = (const bf16*)(ws + WS_QEF_S); X.KT = (const bf16*)(ws + WS_KETF_S); X.row0 = (size_t)NPT + b * 32; X.cid0 = NPT / 64 + b; X.blk0 = b * 4 + h; X.h = h; X.sl = sl;
            gc_run<32>(lds, S, X, 1, tid, wid, lane, wr);
            float* so = out + O_GLA_S + ((size_t)(b * 4 + h) * 256 + 32 * wid) * 512 + sl * 32 + r32;
#pragma unroll
            for (int r = 0; r < 16; ++r) so[(size_t)crow(r, hi) * 512] = S[r];
        }
        __syncthreads();
        { LAS float* scr = (LAS float*)(lds + wid * 8448);
          constexpr int I4 = 32 * 192, I5 = 16 * 64, I6 = 32 * 64, I7 = 16 * 64, I8 = 32 * 64;
          for (int it = gw; it < I4 + I5 + I6 + I7 + I8; it += NGW) {
              int r = it;
              if (r < I4) { cvt_item(args.in[I_WGATE], 2048, 6144, (bf16*)(ws + WS_WGATE), 0, 192, r, scr, lane, args.in[I_MIXPRE]); continue; } r -= I4;
              if (r < I5) { cvt_item(args.in[I_WSB], 1024, 2048, (bf16*)(ws + WS_WSB), 0, 64, r, scr, lane); continue; } r -= I5;
              if (r < I6) { cvt_item(args.in[I_WGLA], 2048, 2048, (bf16*)(ws + WS_WGLA), 0, 64, r, scr, lane); continue; } r -= I6;
              if (r < I7) { cvt_item(args.in[I_WMEM], 1024, 2048, (bf16*)(ws + WS_WMEM), 0, 64, r, scr, lane); continue; } r -= I7;
              cvt_item(args.in[I_WOUT], 2048, 2048, (bf16*)(ws + WS_WOUT), 0, 64, r, scr, lane);
          }
          constexpr int J0 = 32 * 352, J1 = 88 * 64;
          for (int it = gw; it < J0 + J1; it += NGW) {
              if (it < J0) cvt_item(args.in[I_F2GU], 2048, 2 * DFF, (bf16*)(ws + WS_WGU), 1, 352, it, scr, lane, args.in[I_F2PRE]);
              else cvt_item(args.in[I_F2D], DFF, DM, (bf16*)(ws + WS_WD), 0, 64, it - J0, scr, lane);
          } }
    }
    if constexpr (K == 7) {
        const bf16* OI = (const bf16*)(ws + WS_OINTRA); bf16* GR = (bf16*)(ws + WS_GR);
        pg8::Gemm g{A, (const bf16*)(ws + WS_WGATE), MT, 3 * DM, DM}; pg8::StaticOrder S0; S0.init(MT, 3 * DM, G, cu, WGM_A);
        DynTail<pg8::StaticOrder> S; S.init(S0, G, cu, ctl + CW_Q + 2048 * 3, QW);
        EpiGate E{ws, args.in[I_BGATE]};
        pg8::gemm_phase<EpiGate, DynTail<pg8::StaticOrder>, true, true>(lds, g, S, E);
        __syncthreads();
        f32x4 gg0 = *(const f32x4*)(args.in[I_GLANG] + 8 * lane), gg1 = *(const f32x4*)(args.in[I_GLANG] + 8 * lane + 4);
        for (;;) {
        const unsigned mb = wave_ticket(ctl + CW_ITEM + 64, 8u, lane); if (mb >= (unsigned)MT) break;
#pragma unroll 1
        for (int m = (int)mb; m < (int)mb + 8; ++m) {
#pragma unroll
            for (int hh = 0; hh < 4; ++hh) {
                const size_t o = (size_t)m * 2048 + hh * 512 + 8 * lane;
                const v4u ow = __builtin_nontemporal_load((const v4u*)(OI + o)), rw = *(const v4u*)(GR + o);
                float x[8] = {bflo(ow.x), bfhi(ow.x), bflo(ow.y), bfhi(ow.y), bflo(ow.z), bfhi(ow.z), bflo(ow.w), bfhi(ow.w)};
                const float rr[8] = {bflo(rw.x), bfhi(rw.x), bflo(rw.y), bfhi(rw.y), bflo(rw.z), bfhi(rw.z), bflo(rw.w), bfhi(rw.w)};
                float ss = 0.f;
#pragma unroll
                for (int i = 0; i < 8; ++i) ss += x[i] * x[i];
                const float rs = __builtin_amdgcn_rsqf(wave_sum(ss) * (1.0f / 512.0f) + EPS);
#pragma unroll
                for (int i = 0; i < 8; ++i) x[i] = x[i] * rs * (i < 4 ? gg0[i] : gg1[i - 4]) * rr[i];
                v4u w; w.x = cvtpk(x[0], x[1]); w.y = cvtpk(x[2], x[3]); w.z = cvtpk(x[4], x[5]); w.w = cvtpk(x[6], x[7]);
                if (wr) *(v4u*)(GR + o) = w;
            }
        }
        }
    }
    if constexpr (K == 8) {
        { pg8::Gemm g{(const bf16*)(ws + WS_GR), (const bf16*)(ws + WS_WGLA), MT, DM, 2048}; pg8::StaticOrder S; S.init(MT, DM, G, cu, WGM_C);
          EpiBR<0> E{(const unsigned char*)(ws + WS_G1), (bf16*)(out + O_Y), nullptr};
          pg8::gemm_phase<EpiBR<0>, pg8::StaticOrder, true, true>(lds, g, S, E); }
        { pg8::Gemm g{(const bf16*)(ws + WS_SBQ), (const bf16*)(ws + WS_WSB), MT, DM, 1024}; pg8::StaticOrder S; S.init(MT, DM, G, cu, WGM_C);
          EpiBR<1> E{(const unsigned char*)(ws + WS_G0), (bf16*)(out + O_Y), nullptr};
          pg8::gemm_phase<EpiBR<1>, pg8::StaticOrder, true, true>(lds, g, S, E); }
    }
    if constexpr (K == 9) {
        pg8::Gemm g{(const bf16*)(ws + WS_MQ), (const bf16*)(ws + WS_WMEM), MT, DM, 1024}; pg8::StaticOrder S; S.init(MT, DM, G, cu, WGM_C);
        EpiBR<2> E{(const unsigned char*)(ws + WS_G2), (bf16*)(out + O_Y), (bf16*)(ws + WS_MERGED)};
        pg8::gemm_phase<EpiBR<2>, pg8::StaticOrder, true, true>(lds, g, S, E);
    }
    if constexpr (K == 10) {
        pg8::Gemm g{(const bf16*)(ws + WS_MERGED), (const bf16*)(ws + WS_WOUT), MT, DM, DM}; OrderSplit S0; S0.init(G, cu, DM / 64);
        DynTail<OrderSplit> S; S.init(S0, G, cu, ctl + CW_Q + 2048 * 4, QW);
        EpiF32 E{(bf16*)(ws + WS_FO), (float*)(ws + WS_SLAB_O)};
        pg8::gemm_phase<EpiF32, DynTail<OrderSplit>, true, true>(lds, g, S, E);
    }
    if constexpr (K == 11) {
        f32x4 gp[8], gn[8];
        load_gain(args.in[I_MIXPOST], gp, lane); load_gain(args.in[I_F2PRE], gn, lane);
        const bf16* F = (const bf16*)(ws + WS_FO);
        const float* const IRS1 = (const float*)(ctl + CW_IRS1); float* const IRS2 = (float*)(ctl + CW_IRS2);
        for (int m = gw; m < NPT; m += NGW) thin_row<true, false, false, 1, true, true, true>(A + (size_t)m * DM, F + (size_t)m * DM, 1.0f, gp, nullptr, gn, A + (size_t)m * DM, lane, wr, IRS2 + m, IRS1[m]);
        for (int m = NPT + gw; m < MT; m += NGW) thin_row<true, false, false, NSPLIT, true, true, true>(A + (size_t)m * DM, (const float*)(ws + WS_SLAB_O) + (size_t)(m - NPT) * DM, 1.0f, gp, nullptr, gn, A + (size_t)m * DM, lane, wr, IRS2 + m, IRS1[m]);
    }
    if constexpr (K == 12) {
        pg8::Gemm g{A, (const bf16*)(ws + WS_WGU), MT, 2 * DFF, DM}; pg8::StaticOrder S0; S0.init(MT, 2 * DFF, G, cu, WGM_A);
        DynTail<pg8::StaticOrder> S; S.init(S0, G, cu, ctl + CW_Q + 2048 * (K == 1 ? 0 : 5), QW);
        EpiGU E{(bf16*)(ws + WS_HID)};
        pg8::gemm_phase<EpiGU, DynTail<pg8::StaticOrder>, true, true>(lds, g, S, E);
    }
    if constexpr (K == 13) {
        pg8::Gemm g{(const bf16*)(ws + WS_HID), (const bf16*)(ws + WS_WD), MT, DM, DFF}; OrderSplit S0; S0.init(G, cu, DFF / 64);
        DynTail<OrderSplit> S; S.init(S0, G, cu, ctl + CW_Q + 2048 * (K == 2 ? 1 : 6), QW);
        EpiF32 E{(bf16*)(ws + WS_F), (float*)(ws + WS_SLAB_F)};
        pg8::gemm_phase<EpiF32, DynTail<OrderSplit>, true, true>(lds, g, S, E);
    }
    if constexpr (K == 14) {
        f32x4 gp[8];
        load_gain(args.in[I_F2POST], gp, lane);
        const bf16* F = (const bf16*)(ws + WS_F);
        const float* const IRS2 = (const float*)(ctl + CW_IRS2);
        for (int m = gw; m < NPT; m += NGW) thin_row<true, true, false, 1, true, false>(A + (size_t)m * DM, F + (size_t)m * DM, 0.5f, gp, H + (size_t)m * DM, gp, nullptr, lane, wr, nullptr, IRS2[m]);
        for (int m = NPT + gw; m < MT; m += NGW) thin_row<true, true, false, NSPLIT, true, false>(A + (size_t)m * DM, (const float*)(ws + WS_SLAB_F) + (size_t)(m - NPT) * DM, 0.5f, gp, H + (size_t)m * DM, gp, nullptr, lane, wr, nullptr, IRS2[m]);
    }
}

__global__ void __launch_bounds__(NTHR, 2) fwd_kernel(Args args) {
    extern __shared__ __attribute__((aligned(16))) unsigned char lds_raw[];
    const ldsp lds = (ldsp)lds_raw;
    volatile LAS unsigned* MISC = (volatile LAS unsigned*)(lds + MISC_OFF);
    const int tid = threadIdx.x, lane = tid & 63, wid = __builtin_amdgcn_readfirstlane(tid >> 6);
    const int G = gridDim.x, cu = blockIdx.x;
    gu32* ctl = (gu32*)(args.ws + WS_CTL);
    for (int u = tid; u < (LDS_BYTES - LDSCTL_OFF) / 4; u += NTHR) ((LAS unsigned*)(lds + LDSCTL_OFF))[u] = 0u;
    __syncthreads();
    XcdBarrier bar; bar.bar = (unsigned*)(ctl + CW_BAR); bar.x = 0; bar.st = nullptr;
    bar = xcd_barrier_post((unsigned*)(ctl + CW_BAR), MISC + 8);
    const int lo = args.ph_lo, hi_ph = args.ph_hi;
#define IN(k) (lo <= (k) && (k) < hi_ph)
#define PHASE(k) do { if (IN(k)) { if constexpr ((PROBE_DUP >> (k)) & 1) { run_phase<k, PROBE_SUB>(args, lds, tid, lane, wid, G, cu, args.pad != 0); xcd_barrier(bar); } \
        run_phase<k>(args, lds, tid, lane, wid, G, cu, true); } } while (0)
#if defined(PROBE_BWMASK)
    long long bw_sum = 0;
#define SEAM(k) do { const long long b0_ = wall_clock64(); xcd_barrier(bar); if ((PROBE_BWMASK >> (k)) & 1) bw_sum += wall_clock64() - b0_; } while (0)
#else
#define SEAM(k) xcd_barrier(bar)
#endif
    PHASE(0); SEAM(0); PHASE(1); SEAM(1); PHASE(2); SEAM(2); PHASE(3); SEAM(3); PHASE(4); SEAM(4); PHASE(5); SEAM(5); PHASE(6); SEAM(6); PHASE(7); SEAM(7);
    PHASE(8); PHASE(9); SEAM(9); PHASE(10); SEAM(10); PHASE(11); SEAM(11); PHASE(12); SEAM(12); PHASE(13); SEAM(13); PHASE(14);
#if defined(PROBE_BWMASK)
    if (tid == 0) atomicAdd((unsigned long long*)(args.ws + WS_CTL + 786432), (unsigned long long)bw_sum);
    xcd_barrier(bar);
    if (blockIdx.x == 0 && tid == 0) {
        const unsigned long long tot = __hip_atomic_load((unsigned long long*)(args.ws + WS_CTL + 786432), __ATOMIC_RELAXED, __HIP_MEMORY_SCOPE_AGENT);
        const long long spin_ticks = (long long)(tot / gridDim.x) * 10;
        const long long s0 = wall_clock64();
        while (wall_clock64() - s0 < spin_ticks) __builtin_amdgcn_s_sleep(8);
    }
#endif
#undef SEAM
#undef PHASE
#undef IN
}

extern "C" void kernel_launch(void* const* d_in, const int* in_sizes, int n_in, void* d_out, int out_size, void* d_ws, size_t ws_size, hipStream_t stream) {
    static int grid = 0;
    if (grid == 0) {
        if (n_in != N_IN || (size_t)out_size != O_END || ws_size < WS_END) { fprintf(stderr, "kernel_launch: unexpected sizes (n_in %d, out %d, ws %zu)\n", n_in, out_size, ws_size); grid = -1; return; }
        int dev = 0, cus = 0, per_cu = 0;
        if (hipGetDevice(&dev) != hipSuccess || hipDeviceGetAttribute(&cus, hipDeviceAttributeMultiprocessorCount, dev) != hipSuccess) { grid = -1; return; }
        if (hipFuncSetAttribute((const void*)fwd_kernel, hipFuncAttributeMaxDynamicSharedMemorySize, LDS_BYTES) != hipSuccess) { fprintf(stderr, "kernel_launch: hipFuncSetAttribute failed\n"); grid = -1; return; }
        if (hipOccupancyMaxActiveBlocksPerMultiprocessor(&per_cu, (const void*)fwd_kernel, NTHR, LDS_BYTES) != hipSuccess || per_cu < 1) fprintf(stderr, "kernel_launch: occupancy query says %d\n", per_cu);
        (void)hipGetLastError();
        grid = cus;
    }
    if (grid < 0) return;
    (void)hipMemsetAsync((char*)d_ws + WS_CTL, 0, CTL_ZERO_BYTES, stream);
    Args a{};
    for (int i = 0; i < N_IN; ++i) a.in[i] = (const float*)d_in[i];
    a.out = (float*)d_out; a.ws = (unsigned char*)d_ws;
    a.dup = PROBE_DUP; a.pad = 0;
    a.ph_lo = 0; a.ph_hi = N_PHASES;
    hipLaunchKernelGGL(fwd_kernel, dim3(grid), dim3(NTHR), LDS_BYTES, stream, a);
}
```
